# Optimizing an MI355X kernel written in HIP

```python
import math
import jax, jax.numpy as jnp
from jax import lax
import numpy as np

D_MODEL = 1024
BATCH = 4
SEQ = 8192
DEPTH = 1

D_MIX = 2 * D_MODEL
GLA_HEADS = 4
GLA_DV = D_MIX // 2
GLA_DK = GLA_DV // 2
GLA_HEAD_K = GLA_DK // GLA_HEADS
GLA_HEAD_V = GLA_DV // GLA_HEADS
GLA_GATE_RANK = 16
GLA_GATE_TAU = 16.0
GLA_CHUNK = 64
SSD_DINNER = D_MIX - GLA_DV
SSD_HEADDIM = 64
SSD_HEADS = SSD_DINNER // SSD_HEADDIM
SSD_GROUPS = 2
SSD_HPG = SSD_HEADS // SSD_GROUPS
SSD_STATE = 64
SSD_CONV = 4
SSD_CHUNK = 64
SSD_CONV_DIM = SSD_DINNER + 2 * SSD_GROUPS * SSD_STATE
IN_SIZES = (GLA_DK, GLA_DK, GLA_DV, GLA_DV, GLA_GATE_RANK, SSD_DINNER, SSD_CONV_DIM, SSD_HEADS)
D_IN_PROJ = GLA_DK * 2 + GLA_DV * 2 + GLA_GATE_RANK + SSD_DINNER + SSD_CONV_DIM + SSD_HEADS
MEM_LEN = 256
MEM_HEADS = 4
MEM_HEAD_DIM = D_MODEL // MEM_HEADS
PEER_HEADS = 8
PEER_N_KEYS = 128
PEER_EXPERTS = PEER_N_KEYS * PEER_N_KEYS
PEER_KEY_DIM = 128
PEER_HALF = PEER_KEY_DIM // 2
PEER_TOPK = 16
PEER_BLOCK = 64
DEEPNORM_ALPHA = (2.0 * DEPTH) ** 0.25
DEEPNORM_BETA = (8.0 * DEPTH) ** -0.25
LN_EPS = 1e-5
RMS_EPS = 1e-6

kernel_name = 'hybrid_gla_ssd_peer_deepnorm'


def _split_points(sizes):
    pts, acc = [], 0
    for s in sizes[:-1]:
        acc += s
        pts.append(acc)
    return pts


def layer_norm(x, g, b):
    xf = x.astype(jnp.float32)
    mu = xf.mean(-1, keepdims=True)
    var = jnp.square(xf - mu).mean(-1, keepdims=True)
    return ((xf - mu) * lax.rsqrt(var + LN_EPS) * g + b).astype(x.dtype)


def rms_normalize(x):
    xf = x.astype(jnp.float32)
    return xf * lax.rsqrt(jnp.mean(jnp.square(xf), -1, keepdims=True) + RMS_EPS)


def causal_depthwise_conv(x, w, b):
    c = x.shape[-1]
    y = lax.conv_general_dilated(x, w[:, None, :], window_strides=(1,),
                                 padding=[(SSD_CONV - 1, 0)],
                                 dimension_numbers=('NWC', 'WIO', 'NWC'),
                                 feature_group_count=c)
    return y + b


def gla_chunked(q, k, v, log_a):
    bsz, s, nh, dk = q.shape
    dv = v.shape[-1]
    L = GLA_CHUNK
    nc = s // L

    def to_chunks(t):
        return t.reshape(bsz, nc, L, nh, t.shape[-1]).transpose(1, 0, 3, 2, 4)

    qc, kc, vc, gc = to_chunks(q), to_chunks(k), to_chunks(v), to_chunks(log_a)
    causal = jnp.tril(jnp.ones((L, L), dtype=bool))

    def step(state, inp):
        qi, ki, vi, gi = inp
        b = jnp.cumsum(gi.astype(jnp.float32), axis=2)
        diff = b[:, :, :, None, :] - b[:, :, None, :, :]
        decay = jnp.exp(jnp.where(causal[:, :, None], diff, -jnp.inf))
        scores = jnp.einsum('bhtd,bhsd,bhtsd->bhts', qi, ki, decay)
        o = (jnp.einsum('bhts,bhse->bhte', scores, vi)
             + jnp.einsum('bhtd,bhde->bhte', qi * jnp.exp(b), state))
        b_last = b[:, :, -1:, :]
        state = (jnp.exp(b_last[:, :, 0, :, None]) * state
                 + jnp.einsum('bhsd,bhse->bhde', ki * jnp.exp(b_last - b), vi))
        return state, o

    state0 = jnp.zeros((bsz, nh, dk, dv), jnp.float32)
    _, o = lax.scan(step, state0, (qc, kc, vc, gc))
    return o.transpose(1, 0, 3, 2, 4).reshape(bsz, s, nh, dv)


def segsum(a):
    L = a.shape[-1]
    cs = jnp.cumsum(a, -1)
    diff = cs[..., :, None] - cs[..., None, :]
    mask = jnp.tril(jnp.ones((L, L), dtype=bool))
    return jnp.where(mask, diff, -jnp.inf)


def ssd_chunked(x, dt, a_neg, bm, cm):
    bsz, s, ng, nr, p = x.shape
    n = bm.shape[-1]
    L = SSD_CHUNK
    nc = s // L
    x = x.reshape(bsz, nc, L, ng, nr, p)
    dt = dt.reshape(bsz, nc, L, ng, nr)
    bm = bm.reshape(bsz, nc, L, ng, n)
    cm = cm.reshape(bsz, nc, L, ng, n)
    a = (dt * a_neg).transpose(0, 1, 3, 4, 2)
    a_cum = jnp.cumsum(a, -1)
    lmat = jnp.exp(segsum(a))
    xdt = x * dt[..., None]
    cb = jnp.einsum('bclgn,bcsgn->bcgls', cm, bm)
    y_diag = jnp.einsum('bcgls,bcgrls,bcsgrp->bclgrp', cb, lmat, xdt)
    decay_states = jnp.exp(a_cum[..., -1:] - a_cum)
    states = jnp.einsum('bcsgn,bcgrs,bcsgrp->bcgrpn', bm, decay_states, xdt)
    chunk_decay = jnp.exp(a_cum[..., -1])

    def step(h, inp):
        st, dec = inp
        return dec[..., None, None] * h + st, h

    h0 = jnp.zeros((bsz, ng, nr, p, n), jnp.float32)
    _, h_prev = lax.scan(step, h0, (states.transpose(1, 0, 2, 3, 4, 5), chunk_decay.transpose(1, 0, 2, 3)))
    h_prev = h_prev.transpose(1, 0, 2, 3, 4, 5)
    y_off = jnp.einsum('bclgn,bcgrpn,bcgrl->bclgrp', cm, h_prev, jnp.exp(a_cum))
    return (y_diag + y_off).reshape(bsz, s, ng, nr, p)


def hybrid_mixer(h, w_in, gla_wg2, gla_bg, gla_norm_g, conv_w, conv_b, dt_bias, a_log, d_skip,
                 ssd_norm_g, w_out):
    bsz, s, _ = h.shape
    proj = h @ w_in
    q, k, v, r, g_low, z, xbc, dt_raw = jnp.split(proj, _split_points(IN_SIZES), axis=-1)
    q = q.reshape(bsz, s, GLA_HEADS, GLA_HEAD_K) * (GLA_HEAD_K ** -0.5)
    k = k.reshape(bsz, s, GLA_HEADS, GLA_HEAD_K)
    v = v.reshape(bsz, s, GLA_HEADS, GLA_HEAD_V)
    log_a = jax.nn.log_sigmoid((g_low @ gla_wg2 + gla_bg).astype(jnp.float32)) / GLA_GATE_TAU
    log_a = log_a.reshape(bsz, s, GLA_HEADS, GLA_HEAD_K)
    o = gla_chunked(q, k, v, log_a)
    o = rms_normalize(o) * gla_norm_g * jax.nn.silu(r.reshape(bsz, s, GLA_HEADS, GLA_HEAD_V).astype(jnp.float32))
    o = o.reshape(bsz, s, GLA_DV).astype(h.dtype)
    xbc = jax.nn.silu(causal_depthwise_conv(xbc, conv_w, conv_b))
    xs, bm, cm = jnp.split(xbc, [SSD_DINNER, SSD_DINNER + SSD_GROUPS * SSD_STATE], axis=-1)
    xs = xs.reshape(bsz, s, SSD_GROUPS, SSD_HPG, SSD_HEADDIM)
    bm = bm.reshape(bsz, s, SSD_GROUPS, SSD_STATE)
    cm = cm.reshape(bsz, s, SSD_GROUPS, SSD_STATE)
    dt = jax.nn.softplus((dt_raw + dt_bias).astype(jnp.float32)).reshape(bsz, s, SSD_GROUPS, SSD_HPG)
    a_neg = -jnp.exp(a_log.astype(jnp.float32)).reshape(SSD_GROUPS, SSD_HPG)
    y = ssd_chunked(xs, dt, a_neg, bm, cm) + d_skip.reshape(SSD_GROUPS, SSD_HPG)[..., None] * xs
    y = y.reshape(bsz, s, SSD_DINNER) * jax.nn.silu(z.astype(jnp.float32))
    y = rms_normalize(y.reshape(bsz, s, SSD_GROUPS, SSD_DINNER // SSD_GROUPS)).reshape(bsz, s, SSD_DINNER)
    y = (y * ssd_norm_g).astype(h.dtype)
    return jnp.concatenate([o, y], axis=-1) @ w_out


def memory_cross_attention(h, mem, wq, wk, wv, wo):
    bsz, s, _ = h.shape
    m = mem.shape[1]
    q = (h @ wq).reshape(bsz, s, MEM_HEADS, MEM_HEAD_DIM)
    k = (mem @ wk).reshape(bsz, m, MEM_HEADS, MEM_HEAD_DIM)
    v = (mem @ wv).reshape(bsz, m, MEM_HEADS, MEM_HEAD_DIM)
    scores = jnp.einsum('bshd,bmhd->bhsm', q, k).astype(jnp.float32) * (MEM_HEAD_DIM ** -0.5)
    p = jax.nn.softmax(scores, axis=-1).astype(v.dtype)
    o = jnp.einsum('bhsm,bmhd->bshd', p, v).reshape(bsz, s, MEM_HEADS * MEM_HEAD_DIM)
    return o @ wo


def peer_ffn(h, w_q, sub_keys, u, v):
    bsz, s, d = h.shape
    q = (h @ w_q).reshape(bsz, s, PEER_HEADS, 2, PEER_HALF).astype(jnp.float32)
    scores = jnp.einsum('bshpd,pkd->bshpk', q, sub_keys.astype(jnp.float32))
    s_top, i_top = lax.top_k(scores, PEER_TOPK)
    cand = (s_top[..., 0, :, None] + s_top[..., 1, None, :]).reshape(bsz, s, PEER_HEADS, PEER_TOPK * PEER_TOPK)
    best, c_idx = lax.top_k(cand, PEER_TOPK)
    i1 = jnp.take_along_axis(i_top[..., 0, :], c_idx // PEER_TOPK, axis=-1)
    i2 = jnp.take_along_axis(i_top[..., 1, :], c_idx % PEER_TOPK, axis=-1)
    expert = i1 * PEER_N_KEYS + i2
    gates = jax.nn.softmax(best, axis=-1)
    nb = s // PEER_BLOCK

    def blocks(t):
        return t.reshape(bsz, nb, PEER_BLOCK, *t.shape[2:]).swapaxes(0, 1)

    def per_block(inp):
        xb, eb, gb = inp
        act = jnp.einsum('bthkd,btd->bthk', u[eb], xb).astype(jnp.float32)
        w = (gb * jax.nn.gelu(act, approximate=False)).astype(v.dtype)
        return jnp.einsum('bthk,bthkd->btd', w, v[eb])

    out = lax.map(per_block, (blocks(h), blocks(expert), blocks(gates)))
    return out.swapaxes(0, 1).reshape(bsz, s, d)


def setup_inputs(seed: int = 0) -> dict:
    key = jax.random.key(seed)
    ks = jax.random.split(key, 32)
    f32 = jnp.float32

    def nrm(k, shape, scale):
        return jax.random.normal(k, shape, f32) * scale

    def gain(k, n):
        return 1.0 + nrm(k, (DEPTH, n), 0.02)

    dt0 = jnp.exp(jax.random.uniform(ks[7], (DEPTH, SSD_HEADS), f32, math.log(1e-3), math.log(1e-1)))
    return {
        'x': nrm(ks[0], (BATCH, SEQ, D_MODEL), 1.0),
        'mem': nrm(ks[1], (BATCH, MEM_LEN, D_MODEL), 1.0),
        'w_in': nrm(ks[2], (DEPTH, D_MODEL, D_IN_PROJ), D_MODEL ** -0.5),
        'gla_wg2': nrm(ks[3], (DEPTH, GLA_GATE_RANK, GLA_DK), GLA_GATE_RANK ** -0.5),
        'gla_bg': nrm(ks[4], (DEPTH, GLA_DK), 0.1),
        'gla_norm_g': gain(ks[5], GLA_HEAD_V),
        'ssd_conv_w': nrm(ks[6], (DEPTH, SSD_CONV, SSD_CONV_DIM), SSD_CONV ** -0.5),
        'ssd_conv_b': nrm(ks[8], (DEPTH, SSD_CONV_DIM), 0.02),
        'ssd_dt_bias': dt0 + jnp.log(-jnp.expm1(-dt0)),
        'ssd_a_log': jnp.log(jax.random.uniform(ks[9], (DEPTH, SSD_HEADS), f32, 1.0, 16.0)),
        'ssd_d': 1.0 + nrm(ks[10], (DEPTH, SSD_HEADS), 0.02),
        'ssd_norm_g': gain(ks[11], SSD_DINNER),
        'w_out': nrm(ks[12], (DEPTH, D_MIX, D_MODEL), DEEPNORM_BETA * D_MIX ** -0.5),
        'ln1_g': gain(ks[13], D_MODEL),
        'ln1_b': nrm(ks[14], (DEPTH, D_MODEL), 0.02),
        'ca_wq': nrm(ks[15], (DEPTH, D_MODEL, D_MODEL), D_MODEL ** -0.5),
        'ca_wk': nrm(ks[16], (DEPTH, D_MODEL, D_MODEL), D_MODEL ** -0.5),
        'ca_wv': nrm(ks[17], (DEPTH, D_MODEL, D_MODEL), D_MODEL ** -0.5),
        'ca_wo': nrm(ks[18], (DEPTH, D_MODEL, D_MODEL), DEEPNORM_BETA * D_MODEL ** -0.5),
        'ln2_g': gain(ks[19], D_MODEL),
        'ln2_b': nrm(ks[20], (DEPTH, D_MODEL), 0.02),
        'peer_wq': nrm(ks[21], (DEPTH, D_MODEL, PEER_HEADS * PEER_KEY_DIM), D_MODEL ** -0.5),
        'peer_keys': nrm(ks[22], (DEPTH, 2, PEER_N_KEYS, PEER_HALF), PEER_HALF ** -0.5),
        'peer_u': nrm(ks[23], (DEPTH, PEER_EXPERTS, D_MODEL), D_MODEL ** -0.5),
        'peer_v': nrm(ks[24], (DEPTH, PEER_EXPERTS, D_MODEL), DEEPNORM_BETA),
        'ln3_g': gain(ks[25], D_MODEL),
        'ln3_b': nrm(ks[26], (DEPTH, D_MODEL), 0.02),
    }


def reference(x, mem, w_in, gla_wg2, gla_bg, gla_norm_g, ssd_conv_w, ssd_conv_b, ssd_dt_bias,
              ssd_a_log, ssd_d, ssd_norm_g, w_out, ln1_g, ln1_b, ca_wq, ca_wk, ca_wv, ca_wo,
              ln2_g, ln2_b, peer_wq, peer_keys, peer_u, peer_v, ln3_g, ln3_b):
    h = x
    for l in range(DEPTH):
        mix = hybrid_mixer(h, w_in[l], gla_wg2[l], gla_bg[l], gla_norm_g[l], ssd_conv_w[l],
                           ssd_conv_b[l], ssd_dt_bias[l], ssd_a_log[l], ssd_d[l], ssd_norm_g[l], w_out[l])
        h = layer_norm(DEEPNORM_ALPHA * h + mix, ln1_g[l], ln1_b[l])
        ca = memory_cross_attention(h, mem, ca_wq[l], ca_wk[l], ca_wv[l], ca_wo[l])
        h = layer_norm(DEEPNORM_ALPHA * h + ca, ln2_g[l], ln2_b[l])
        ff = peer_ffn(h, peer_wq[l], peer_keys[l], peer_u[l], peer_v[l])
        h = layer_norm(DEEPNORM_ALPHA * h + ff, ln3_g[l], ln3_b[l])
    return h
```

```cpp
#include <hip/hip_runtime.h>
#include <cmath>
#define HD __device__ __forceinline__
namespace cfg {
#ifdef SMALL
constexpr int D_MODEL = 128, BATCH = 2, SEQ = 64, GLA_HEADS = 4, GLA_GATE_RANK = 4, SSD_HEADDIM = 16, SSD_GROUPS = 2, SSD_STATE = 16, SSD_CONV = 4,
              MEM_LEN = 16, MEM_HEADS = 2, PEER_HEADS = 2, PEER_N_KEYS = 16, PEER_KEY_DIM = 16, PEER_TOPK = 4;
#else
constexpr int D_MODEL = 1024, BATCH = 4, SEQ = 8192, GLA_HEADS = 4, GLA_GATE_RANK = 16, SSD_HEADDIM = 64, SSD_GROUPS = 2, SSD_STATE = 64, SSD_CONV = 4,
              MEM_LEN = 256, MEM_HEADS = 4, PEER_HEADS = 8, PEER_N_KEYS = 128, PEER_KEY_DIM = 128, PEER_TOPK = 16;
#endif
constexpr int D_MIX = 2 * D_MODEL, GLA_DV = D_MIX / 2, GLA_DK = GLA_DV / 2, GLA_HEAD_K = GLA_DK / GLA_HEADS, GLA_HEAD_V = GLA_DV / GLA_HEADS;
constexpr float GLA_GATE_TAU = 16.0f;
constexpr int SSD_DINNER = D_MIX - GLA_DV, SSD_HEADS = SSD_DINNER / SSD_HEADDIM, SSD_HPG = SSD_HEADS / SSD_GROUPS, SSD_CONV_DIM = SSD_DINNER + 2 * SSD_GROUPS * SSD_STATE;
constexpr int D_IN_PROJ = GLA_DK * 2 + GLA_DV * 2 + GLA_GATE_RANK + SSD_DINNER + SSD_CONV_DIM + SSD_HEADS;
constexpr int MEM_HEAD_DIM = D_MODEL / MEM_HEADS, PEER_EXPERTS = PEER_N_KEYS * PEER_N_KEYS, PEER_HALF = PEER_KEY_DIM / 2;
constexpr float ALPHA = 1.189207115002721f;
constexpr float LN_EPS = 1e-5f, RMS_EPS = 1e-6f;
constexpr int NTOK = BATCH * SEQ;
}
namespace nv {
using namespace cfg;

struct Bufs {
    float *proj, *loga, *xbcc, *dt, *oraw, *yraw, *oy, *h1, *qc, *kc, *vc, *sc, *att, *h2, *pq, *psc, *stop, *gates, *wgt, *ff;
    int *itop, *eid;
};
struct In { const float* p[27]; };

HD float sigmoidf_(float x) { return 1.0f / (1.0f + expf(-x)); }
HD float siluf_(float x) { return x * sigmoidf_(x); }
HD float logsigmoidf_(float x) { return x < 0.f ? x - log1pf(expf(x)) : -log1pf(expf(-x)); }
HD float softplusf_(float x) { return x > 0.f ? x + log1pf(expf(-x)) : log1pf(expf(x)); }
HD float geluf_(float x) { return 0.5f * x * (1.0f + erff(x * 0.70710678118654752f)); }

HD void gemm(const float* A, int lda, const float* B, int ldb, float* C, int ldc, int M, int N, int K, long gtid, long nthr) {
    const long total = (long)(M / 4) * N;
    for (long i = gtid; i < total; i += nthr) {
        const int n = (int)(i % N); const long m0 = (i / N) * 4;
        float a0 = 0.f, a1 = 0.f, a2 = 0.f, a3 = 0.f;
        const float* Ap = A + m0 * lda;
        for (int k = 0; k < K; ++k) { const float b = B[(long)k * ldb + n]; a0 += Ap[k] * b; a1 += Ap[lda + k] * b; a2 += Ap[2 * (long)lda + k] * b; a3 += Ap[3 * (long)lda + k] * b; }
        C[(m0 + 0) * ldc + n] = a0; C[(m0 + 1) * ldc + n] = a1; C[(m0 + 2) * ldc + n] = a2; C[(m0 + 3) * ldc + n] = a3;
    }
}
HD void lnrows(const float* base, const float* add, float* out, const float* g, const float* b, int rows, long gtid, long nthr) {
    for (long r = gtid; r < rows; r += nthr) {
        const float* x = base + r * D_MODEL; const float* a = add + r * D_MODEL; float* o = out + r * D_MODEL;
        float mu = 0.f; for (int c = 0; c < D_MODEL; ++c) mu += ALPHA * x[c] + a[c]; mu /= D_MODEL;
        float var = 0.f; for (int c = 0; c < D_MODEL; ++c) { const float d = ALPHA * x[c] + a[c] - mu; var += d * d; } var /= D_MODEL;
        const float rs = 1.0f / sqrtf(var + LN_EPS);
        for (int c = 0; c < D_MODEL; ++c) o[c] = (ALPHA * x[c] + a[c] - mu) * rs * g[c] + b[c];
    }
}

constexpr int OFF_Q = 0, OFF_K = OFF_Q + GLA_DK, OFF_V = OFF_K + GLA_DK, OFF_R = OFF_V + GLA_DV, OFF_G = OFF_R + GLA_DV, OFF_Z = OFF_G + GLA_GATE_RANK,
              OFF_XBC = OFF_Z + SSD_DINNER, OFF_DT = OFF_XBC + SSD_CONV_DIM;
static_assert(OFF_DT + SSD_HEADS == D_IN_PROJ, "proj layout");

HD void phase(const In& in, const Bufs& w, float* out, int ph, int b, long gtid, long nthr) {
    const float* x = in.p[0] + (long)b * SEQ * D_MODEL;
    const float* mem = in.p[1] + (long)b * MEM_LEN * D_MODEL;
    const int S = SEQ;
    switch (ph) {
    case 0: gemm(x, D_MODEL, in.p[2], D_IN_PROJ, w.proj, D_IN_PROJ, S, D_IN_PROJ, D_MODEL, gtid, nthr); break;
    case 1: {
        for (long i = gtid; i < (long)S * GLA_DK; i += nthr) { const int s = (int)(i / GLA_DK), j = (int)(i % GLA_DK);
            float a = in.p[4][j]; for (int r = 0; r < GLA_GATE_RANK; ++r) a += w.proj[(long)s * D_IN_PROJ + OFF_G + r] * in.p[3][r * GLA_DK + j];
            w.loga[i] = logsigmoidf_(a) / GLA_GATE_TAU; }
        for (long i = gtid; i < (long)S * SSD_CONV_DIM; i += nthr) { const int s = (int)(i / SSD_CONV_DIM), c = (int)(i % SSD_CONV_DIM);
            float a = in.p[7][c];
            for (int k = 0; k < SSD_CONV; ++k) { const int t = s - (SSD_CONV - 1) + k; if (t >= 0) a += in.p[6][k * SSD_CONV_DIM + c] * w.proj[(long)t * D_IN_PROJ + OFF_XBC + c]; }
            w.xbcc[i] = siluf_(a); }
        for (long i = gtid; i < (long)S * SSD_HEADS; i += nthr) { const int s = (int)(i / SSD_HEADS), hd = (int)(i % SSD_HEADS);
            w.dt[i] = softplusf_(w.proj[(long)s * D_IN_PROJ + OFF_DT + hd] + in.p[8][hd]); }
    } break;
    case 2: {
        const int NG = GLA_HEADS * GLA_HEAD_V, NS = SSD_HEADS * SSD_HEADDIM;
        for (long i = gtid; i < NG + NS; i += nthr) {
            if (i < NG) {
                const int h = (int)(i / GLA_HEAD_V), e = (int)(i % GLA_HEAD_V);
                float St[GLA_HEAD_K];
#pragma unroll
                for (int d = 0; d < GLA_HEAD_K; ++d) St[d] = 0.f;
                const float qs = 1.0f / sqrtf((float)GLA_HEAD_K);
                for (int t = 0; t < S; ++t) {
                    const float* pr = w.proj + (long)t * D_IN_PROJ; const float* la = w.loga + (long)t * GLA_DK + h * GLA_HEAD_K;
                    const float vv = pr[OFF_V + h * GLA_HEAD_V + e]; float o = 0.f;
#pragma unroll
                    for (int d = 0; d < GLA_HEAD_K; ++d) { St[d] = expf(la[d]) * St[d] + pr[OFF_K + h * GLA_HEAD_K + d] * vv; o += pr[OFF_Q + h * GLA_HEAD_K + d] * qs * St[d]; }
                    w.oraw[(long)t * GLA_DV + h * GLA_HEAD_V + e] = o;
                }
            } else {
                const int j = (int)(i - NG), hd = j / SSD_HEADDIM, p = j % SSD_HEADDIM, g = hd / SSD_HPG;
                float Hs[SSD_STATE];
#pragma unroll
                for (int n = 0; n < SSD_STATE; ++n) Hs[n] = 0.f;
                const float an = -expf(in.p[9][hd]), dsk = in.p[10][hd];
                for (int t = 0; t < S; ++t) {
                    const float* xc = w.xbcc + (long)t * SSD_CONV_DIM; const float dtv = w.dt[(long)t * SSD_HEADS + hd];
                    const float dec = expf(dtv * an), xv = xc[hd * SSD_HEADDIM + p], dx = dtv * xv; float y = 0.f;
#pragma unroll
                    for (int n = 0; n < SSD_STATE; ++n) { Hs[n] = dec * Hs[n] + dx * xc[SSD_DINNER + g * SSD_STATE + n]; y += Hs[n] * xc[SSD_DINNER + SSD_GROUPS * SSD_STATE + g * SSD_STATE + n]; }
                    w.yraw[(long)t * SSD_DINNER + hd * SSD_HEADDIM + p] = y + dsk * xv;
                }
            }
        }
    } break;
    case 3: {
        for (long i = gtid; i < (long)S * GLA_HEADS; i += nthr) { const int s = (int)(i / GLA_HEADS), h = (int)(i % GLA_HEADS);
            const float* o = w.oraw + (long)s * GLA_DV + h * GLA_HEAD_V; float ms = 0.f; for (int e = 0; e < GLA_HEAD_V; ++e) ms += o[e] * o[e];
            const float rs = 1.0f / sqrtf(ms / GLA_HEAD_V + RMS_EPS);
            for (int e = 0; e < GLA_HEAD_V; ++e) w.oy[(long)s * D_MIX + h * GLA_HEAD_V + e] = o[e] * rs * in.p[5][e] * siluf_(w.proj[(long)s * D_IN_PROJ + OFF_R + h * GLA_HEAD_V + e]); }
        constexpr int GW = SSD_DINNER / SSD_GROUPS;
        for (long i = gtid; i < (long)S * SSD_GROUPS; i += nthr) { const int s = (int)(i / SSD_GROUPS), g = (int)(i % SSD_GROUPS);
            float ms = 0.f; for (int c = 0; c < GW; ++c) { const int ch = g * GW + c; const float y = w.yraw[(long)s * SSD_DINNER + ch] * siluf_(w.proj[(long)s * D_IN_PROJ + OFF_Z + ch]); ms += y * y; }
            const float rs = 1.0f / sqrtf(ms / GW + RMS_EPS);
            for (int c = 0; c < GW; ++c) { const int ch = g * GW + c; const float y = w.yraw[(long)s * SSD_DINNER + ch] * siluf_(w.proj[(long)s * D_IN_PROJ + OFF_Z + ch]);
                w.oy[(long)s * D_MIX + GLA_DV + ch] = y * rs * in.p[11][ch]; } }
    } break;
    case 4: gemm(w.oy, D_MIX, in.p[12], D_MODEL, w.h1, D_MODEL, S, D_MODEL, D_MIX, gtid, nthr); break;
    case 5: lnrows(x, w.h1, w.h1, in.p[13], in.p[14], S, gtid, nthr); break;
    case 6: gemm(w.h1, D_MODEL, in.p[15], D_MODEL, w.qc, D_MODEL, S, D_MODEL, D_MODEL, gtid, nthr);
            gemm(mem, D_MODEL, in.p[16], D_MODEL, w.kc, D_MODEL, MEM_LEN, D_MODEL, D_MODEL, gtid, nthr);
            gemm(mem, D_MODEL, in.p[17], D_MODEL, w.vc, D_MODEL, MEM_LEN, D_MODEL, D_MODEL, gtid, nthr); break;
    case 7: {
        const float scl = 1.0f / sqrtf((float)MEM_HEAD_DIM);
        for (long i = gtid; i < (long)S * MEM_HEADS * MEM_LEN; i += nthr) { const int m = (int)(i % MEM_LEN), h = (int)((i / MEM_LEN) % MEM_HEADS); const long s = i / ((long)MEM_LEN * MEM_HEADS);
            float a = 0.f; for (int d = 0; d < MEM_HEAD_DIM; ++d) a += w.qc[s * D_MODEL + h * MEM_HEAD_DIM + d] * w.kc[(long)m * D_MODEL + h * MEM_HEAD_DIM + d];
            w.sc[i] = a * scl; }
    } break;
    case 8: for (long i = gtid; i < (long)S * MEM_HEADS; i += nthr) { float* r = w.sc + i * MEM_LEN; float mx = r[0]; for (int m = 1; m < MEM_LEN; ++m) mx = fmaxf(mx, r[m]);
                float sum = 0.f; for (int m = 0; m < MEM_LEN; ++m) { r[m] = expf(r[m] - mx); sum += r[m]; } const float inv = 1.0f / sum; for (int m = 0; m < MEM_LEN; ++m) r[m] *= inv; } break;
    case 9: for (long i = gtid; i < (long)S * D_MODEL; i += nthr) { const int c = (int)(i % D_MODEL), h = c / MEM_HEAD_DIM; const long s = i / D_MODEL;
                const float* p = w.sc + (s * MEM_HEADS + h) * MEM_LEN; float a = 0.f; for (int m = 0; m < MEM_LEN; ++m) a += p[m] * w.vc[(long)m * D_MODEL + c]; w.att[i] = a; } break;
    case 10: gemm(w.att, D_MODEL, in.p[18], D_MODEL, w.h2, D_MODEL, S, D_MODEL, D_MODEL, gtid, nthr); break;
    case 11: lnrows(w.h1, w.h2, w.h2, in.p[19], in.p[20], S, gtid, nthr); break;
    case 12: gemm(w.h2, D_MODEL, in.p[21], PEER_HEADS * PEER_KEY_DIM, w.pq, PEER_HEADS * PEER_KEY_DIM, S, PEER_HEADS * PEER_KEY_DIM, D_MODEL, gtid, nthr); break;
    case 13: for (long i = gtid; i < (long)S * PEER_HEADS * 2 * PEER_N_KEYS; i += nthr) { const int k = (int)(i % PEER_N_KEYS), p = (int)((i / PEER_N_KEYS) % 2), hh = (int)((i / (2 * PEER_N_KEYS)) % PEER_HEADS); const long s = i / ((long)2 * PEER_N_KEYS * PEER_HEADS);
                 const float* q = w.pq + s * (PEER_HEADS * PEER_KEY_DIM) + hh * PEER_KEY_DIM + p * PEER_HALF; const float* ky = in.p[22] + ((long)p * PEER_N_KEYS + k) * PEER_HALF;
                 float a = 0.f; for (int d = 0; d < PEER_HALF; ++d) a += q[d] * ky[d]; w.psc[i] = a; } break;
    case 14: for (long i = gtid; i < (long)S * PEER_HEADS * 2; i += nthr) { const float* sc = w.psc + i * PEER_N_KEYS; float pv = 0.f; int pi = -1;
                 for (int j = 0; j < PEER_TOPK; ++j) { float bv = 0.f; int bi = -1;
                     for (int k = 0; k < PEER_N_KEYS; ++k) { const float v = sc[k]; const bool elig = (pi < 0) || (v < pv) || (v == pv && k > pi); if (elig && (bi < 0 || v > bv)) { bv = v; bi = k; } }
                     w.stop[i * PEER_TOPK + j] = bv; w.itop[i * PEER_TOPK + j] = bi; pv = bv; pi = bi; } } break;
    case 15: for (long i = gtid; i < (long)S * PEER_HEADS; i += nthr) { const float* s1 = w.stop + (i * 2) * PEER_TOPK; const float* s2 = s1 + PEER_TOPK; const int* i1 = w.itop + (i * 2) * PEER_TOPK; const int* i2 = i1 + PEER_TOPK;
                 float pv = 0.f; int pi = -1; float best0 = 0.f, sum = 0.f;
                 for (int j = 0; j < PEER_TOPK; ++j) { float bv = 0.f; int bi = -1;
                     for (int c = 0; c < PEER_TOPK * PEER_TOPK; ++c) { const float v = s1[c / PEER_TOPK] + s2[c % PEER_TOPK]; const bool elig = (pi < 0) || (v < pv) || (v == pv && c > pi); if (elig && (bi < 0 || v > bv)) { bv = v; bi = c; } }
                     if (j == 0) best0 = bv; const float e = expf(bv - best0); sum += e;
                     w.gates[i * PEER_TOPK + j] = e; w.eid[i * PEER_TOPK + j] = i1[bi / PEER_TOPK] * PEER_N_KEYS + i2[bi % PEER_TOPK]; pv = bv; pi = bi; }
                 for (int j = 0; j < PEER_TOPK; ++j) w.gates[i * PEER_TOPK + j] /= sum; } break;
    case 16: for (long i = gtid; i < (long)S * PEER_HEADS * PEER_TOPK; i += nthr) { const long s = i / (PEER_HEADS * PEER_TOPK); const float* u = in.p[23] + (long)w.eid[i] * D_MODEL; const float* hx = w.h2 + s * D_MODEL;
                 float a = 0.f; for (int c = 0; c < D_MODEL; ++c) a += u[c] * hx[c]; w.wgt[i] = w.gates[i] * geluf_(a); } break;
    case 17: for (long i = gtid; i < (long)S * D_MODEL; i += nthr) { const int c = (int)(i % D_MODEL); const long s = i / D_MODEL; float a = 0.f;
                 for (int j = 0; j < PEER_HEADS * PEER_TOPK; ++j) a += w.wgt[s * PEER_HEADS * PEER_TOPK + j] * in.p[24][(long)w.eid[s * PEER_HEADS * PEER_TOPK + j] * D_MODEL + c]; w.ff[i] = a; } break;
    case 18: lnrows(w.h2, w.ff, out + (long)b * SEQ * D_MODEL, in.p[25], in.p[26], S, gtid, nthr); break;
    default: break;
    }
}
constexpr int NPH = 19;

static inline long carve(Bufs& w, float* base) {
    long o = 0; const long S = SEQ;
    auto take = [&](long n) { float* p = base + o; o += (n + 63) / 64 * 64; return p; };
    w.proj = take(S * D_IN_PROJ);
    { float* q = w.proj; auto sub = [&](long n) { float* p = q; q += (n + 63) / 64 * 64; return p; };
      w.qc = sub(S * D_MODEL); w.sc = sub(S * MEM_HEADS * MEM_LEN); w.att = sub(S * D_MODEL); w.h2 = sub(S * D_MODEL); w.pq = sub(S * PEER_HEADS * PEER_KEY_DIM); }
    static_assert((long)D_IN_PROJ >= 3L * D_MODEL + MEM_HEADS * MEM_LEN + PEER_HEADS * PEER_KEY_DIM + 8, "overlay A fits");
    w.loga = take(S * GLA_DK); w.xbcc = take(S * SSD_CONV_DIM); w.dt = take(S * SSD_HEADS);
    w.oraw = take(S * GLA_DV); w.yraw = take(S * SSD_DINNER); w.ff = w.yraw;
    w.oy = take(S * D_MIX); w.psc = w.oy; static_assert(D_MIX >= PEER_HEADS * 2 * PEER_N_KEYS, "overlay psc fits");
    w.h1 = take(S * D_MODEL);
    w.kc = take((long)MEM_LEN * D_MODEL); w.vc = take((long)MEM_LEN * D_MODEL);
    w.stop = take(S * PEER_HEADS * 2 * PEER_TOPK); w.gates = take(S * PEER_HEADS * PEER_TOPK);
    w.wgt = take(S * PEER_HEADS * PEER_TOPK);
    w.itop = (int*)take(S * PEER_HEADS * 2 * PEER_TOPK); w.eid = (int*)take(S * PEER_HEADS * PEER_TOPK);
    return o;
}
}
struct NArgs { nv::In in; nv::Bufs w; float* out; int ph, b; };
__global__ void __launch_bounds__(256) nv_kernel(NArgs a) {
    const long gtid = (long)blockIdx.x * 256 + threadIdx.x;
    nv::phase(a.in, a.w, a.out, a.ph, a.b, gtid, (long)gridDim.x * 256);
}
extern "C" void kernel_launch(void* const* d_in, const int* in_sizes, int n_in, void* d_out, int out_size, void* d_ws, size_t ws_size, hipStream_t stream) {
    NArgs a{};
    for (int i = 0; i < 27; ++i) a.in.p[i] = (const float*)d_in[i];
    nv::carve(a.w, (float*)d_ws);
    a.out = (float*)d_out;
    for (int b = 0; b < cfg::BATCH; ++b)
        for (int ph = 0; ph < nv::NPH; ++ph) { a.ph = ph; a.b = b; hipLaunchKernelGGL(nv_kernel, dim3(2048), dim3(256), 0, stream, a); }
}
```

```cpp
#include <hip/hip_runtime.h>
#include <cmath>
#include <cstdio>
#include <cstdint>
#define HD __device__ __forceinline__
namespace cfg {
#ifdef SMALL
constexpr int D_MODEL = 128, BATCH = 2, SEQ = 64, GLA_HEADS = 4, GLA_GATE_RANK = 4, SSD_HEADDIM = 16, SSD_GROUPS = 2, SSD_STATE = 16, SSD_CONV = 4,
              MEM_LEN = 16, MEM_HEADS = 2, PEER_HEADS = 2, PEER_N_KEYS = 16, PEER_KEY_DIM = 16, PEER_TOPK = 4;
#else
constexpr int D_MODEL = 1024, BATCH = 4, SEQ = 8192, GLA_HEADS = 4, GLA_GATE_RANK = 16, SSD_HEADDIM = 64, SSD_GROUPS = 2, SSD_STATE = 64, SSD_CONV = 4,
              MEM_LEN = 256, MEM_HEADS = 4, PEER_HEADS = 8, PEER_N_KEYS = 128, PEER_KEY_DIM = 128, PEER_TOPK = 16;
#endif
constexpr int D_MIX = 2 * D_MODEL, GLA_DV = D_MIX / 2, GLA_DK = GLA_DV / 2, GLA_HEAD_K = GLA_DK / GLA_HEADS, GLA_HEAD_V = GLA_DV / GLA_HEADS;
constexpr float GLA_GATE_TAU = 16.0f;
constexpr int SSD_DINNER = D_MIX - GLA_DV, SSD_HEADS = SSD_DINNER / SSD_HEADDIM, SSD_HPG = SSD_HEADS / SSD_GROUPS, SSD_CONV_DIM = SSD_DINNER + 2 * SSD_GROUPS * SSD_STATE;
constexpr int D_IN_PROJ = GLA_DK * 2 + GLA_DV * 2 + GLA_GATE_RANK + SSD_DINNER + SSD_CONV_DIM + SSD_HEADS;
constexpr int MEM_HEAD_DIM = D_MODEL / MEM_HEADS, PEER_EXPERTS = PEER_N_KEYS * PEER_N_KEYS, PEER_HALF = PEER_KEY_DIM / 2;
constexpr float ALPHA = 1.189207115002721f;
constexpr float LN_EPS = 1e-5f, RMS_EPS = 1e-6f;
constexpr int NTOK = BATCH * SEQ;
}
namespace pg8 {
#define PG8_LAS __attribute__((address_space(3)))
typedef unsigned short bf16_t;
typedef short bf16x8 __attribute__((ext_vector_type(8)));
typedef float f32x4 __attribute__((ext_vector_type(4)));
typedef unsigned u32x4 __attribute__((ext_vector_type(4)));
constexpr int BM = 256, BK = 64, HALF = 128, HTB = HALF * BK * 2  , STAGE_BYTES = 8 * HTB, NXCD = 8, WGM = 8;

__host__ __device__ __forceinline__ int lds_byte(int r, int c) { const int st = (r >> 4) * 2 + (c >> 5), rr = r & 15, cc = c & 31, ob = rr * 64 + cc * 2; return st * 1024 + (ob ^ (((ob >> 9) & 1) << 5)); }
__host__ __device__ __forceinline__ void stage_rc(int b, int& R, int& C) { const int st = b / 1024, sb = b % 1024, swz = sb ^ (((sb >> 9) & 1) << 5); R = (st >> 1) * 16 + swz / 64; C = (st & 1) * 32 + (swz % 64) / 2; }
__host__ __device__ __forceinline__ int perm32(int rho) { const int n = rho >> 4, i = rho & 15; return 8 * (i >> 2) + 4 * n + (i & 3); }

struct Unit { int pm, pn; };
struct Gemm { const bf16_t* A; const bf16_t* Bt; int M, N, K; };

struct StaticOrder {
    int nM, nN, nwg, G, c;
    __host__ __device__ void init(int M, int N, int G_, int c_) { nM = M / BM; nN = N / BM; nwg = nM * nN; G = G_; c = c_; }
    __host__ __device__ bool next(int i, Unit& u) const {
        const long L = (long)i * G + c; if (L >= nwg) return false;
        int wgid = (int)L; { const int q = nwg / NXCD, r = nwg % NXCD, xcd = wgid % NXCD, off = wgid / NXCD; wgid = (xcd < r ? xcd * (q + 1) : r * (q + 1) + (xcd - r) * q) + off; }
        const int nig = WGM * nN, gid = wgid / nig, fm = gid * WGM, gsz = (nM - fm) < WGM ? (nM - fm) : WGM;
        u.pm = fm + ((wgid % nig) % gsz); u.pn = (wgid % nig) / gsz; return true;
    }
    __device__ __forceinline__ void a_ready(const Unit&) const {}
    __device__ __forceinline__ void done(const Unit&) const {}
};

__device__ __forceinline__ unsigned cvt_pk_bf16(float lo, float hi) { unsigned r; asm volatile("v_cvt_pk_bf16_f32 %0, %1, %2" : "=v"(r) : "v"(lo), "v"(hi)); return r; }
typedef float f32x2 __attribute__((ext_vector_type(2)));
struct EpiF32 {
    static constexpr bool PERM = false, AFTER_DRAIN = false;
    float* C; int ldc; int ncols;
    __device__ __forceinline__ void operator()(const f32x4 (&acc)[2][2][4][2], const Unit& u, int wr, int wc, int fr, int fq) const {
        const int row0 = u.pm * BM + wr * 64 + fr, col0 = u.pn * BM + wc * 32 + 4 * fq;
#pragma unroll
        for (int ai = 0; ai < 2; ++ai)
#pragma unroll
            for (int m = 0; m < 4; ++m) { float* rowp = C + (size_t)(row0 + ai * HALF + m * 16) * ldc + col0;
#pragma unroll
                for (int bj = 0; bj < 2; ++bj)
#pragma unroll
                    for (int n = 0; n < 2; ++n) if (col0 + bj * HALF + n * 16 < ncols) *(f32x4*)(rowp + bj * HALF + n * 16) = acc[ai][bj][m][n]; }
    }
};
template <class Epi, class Sched, bool ALIGN_EPI = false, bool SP2 = false>
__device__ __forceinline__ void gemm_phase(PG8_LAS unsigned char* lds, const Gemm g, const Sched& S, const Epi& E) {
    int tid_o = threadIdx.x; asm volatile("" : "+v"(tid_o));
    const int tid = tid_o, wid = __builtin_amdgcn_readfirstlane(tid >> 6), lane = tid & 63, wr = wid >> 2, wc = wid & 3, fr = lane & 15, fq = lane >> 4;
    const int K = g.K, nt = K / BK;
    unsigned voffA[2], voffB[2];
#pragma unroll
    for (int i = 0; i < 2; ++i) { int R, C; stage_rc(tid * 16 + i * 8192, R, C); const int Rb = Epi::PERM ? ((R & ~31) + perm32(R & 31)) : R;
        voffA[i] = (unsigned)(R * K + C) * 2u; voffB[i] = (unsigned)(Rb * K + C) * 2u; }
    const size_t kstep = (size_t)(BK * 2);
    const size_t hstep = (size_t)HALF * K * 2;
    const size_t tstep = 2 * hstep;
    const unsigned ldsw = (unsigned)wid * 1024u;
    const int aoff = lds_byte(wr * 64 + fr, fq * 8), boff = lds_byte(wc * 32 + fr, fq * 8);
#define PG8_SA(b, h) (((b) * 2 + (h)) * HTB)
#define PG8_SB(b, h) ((4 + (b) * 2 + (h)) * HTB)
#define PG8_STAGE(bufoff, gbase, voff) do { _Pragma("unroll") for (int _i = 0; _i < 2; ++_i) \
        __builtin_amdgcn_global_load_lds((const unsigned*)((const char*)(gbase) + (voff)[_i]), (PG8_LAS unsigned*)(lds + (bufoff) + ldsw + _i * 8192), 16, 0, 0); } while (0)
#define PG8_LDA(dst, b, h) do { _Pragma("unroll") for (int m = 0; m < 4; ++m) _Pragma("unroll") for (int k = 0; k < 2; ++k) dst[m][k] = *(const PG8_LAS bf16x8*)(lds + PG8_SA(b, h) + aoff + m * 2048 + k * 1024); } while (0)
#define PG8_LDB(dst, b, h) do { _Pragma("unroll") for (int n = 0; n < 2; ++n) _Pragma("unroll") for (int k = 0; k < 2; ++k) dst[n][k] = *(const PG8_LAS bf16x8*)(lds + PG8_SB(b, h) + boff + n * 2048 + k * 1024); } while (0)
#define PG8_MMA(ai, bj, At, Bt) do { __builtin_amdgcn_s_setprio(1); _Pragma("unroll") for (int m = 0; m < 4; ++m) _Pragma("unroll") for (int n = 0; n < 2; ++n) _Pragma("unroll") for (int k = 0; k < 2; ++k) \
        acc[ai][bj][m][n] = __builtin_amdgcn_mfma_f32_16x16x32_bf16(Bt[n][k], At[m][k], acc[ai][bj][m][n], 0, 0, 0); __builtin_amdgcn_s_setprio(0); } while (0)
#define PG8_WAIT_V(n) asm volatile("s_waitcnt vmcnt(" #n ")" ::: "memory")
#define PG8_WAIT_L(n) asm volatile("s_waitcnt lgkmcnt(" #n ")" ::: "memory")
#define PG8_BAR __builtin_amdgcn_s_barrier()
#define PG8_SCHED __builtin_amdgcn_sched_barrier(0)
    Unit cur, nxt; int ui = 0;
    if (!S.next(0, cur)) return;
    f32x4 acc[2][2][4][2];
#pragma unroll
    for (int a = 0; a < 2; ++a)
#pragma unroll
        for (int b = 0; b < 2; ++b)
#pragma unroll
            for (int m = 0; m < 4; ++m)
#pragma unroll
                for (int n = 0; n < 2; ++n) acc[a][b][m][n] = (f32x4){0.f, 0.f, 0.f, 0.f};
    bf16x8 At[4][2], B0[2][2], B1[2][2];
    const char* cA = (const char*)g.A + (size_t)cur.pm * tstep; const char* cB = (const char*)g.Bt + (size_t)cur.pn * tstep;
    S.a_ready(cur);
    if constexpr (SP2) {
        PG8_STAGE(PG8_SB(0, 0), cB, voffB); PG8_STAGE(PG8_SB(0, 1), cB + hstep, voffB); PG8_STAGE(PG8_SA(0, 0), cA, voffA); PG8_STAGE(PG8_SA(0, 1), cA + hstep, voffA);
        if (wr == 1) PG8_BAR;
        PG8_WAIT_V(2); PG8_BAR;
        PG8_STAGE(PG8_SB(1, 0), cB + kstep, voffB); PG8_STAGE(PG8_SA(1, 0), cA + kstep, voffA); PG8_STAGE(PG8_SB(1, 1), cB + hstep + kstep, voffB);
        PG8_WAIT_V(6); PG8_BAR;
    } else {
        PG8_STAGE(PG8_SB(0, 0), cB, voffB); PG8_STAGE(PG8_SA(0, 0), cA, voffA); PG8_STAGE(PG8_SB(0, 1), cB + hstep, voffB); PG8_STAGE(PG8_SA(0, 1), cA + hstep, voffA);
        if (wr == 1) PG8_BAR;
        PG8_WAIT_V(4); PG8_BAR;
        PG8_STAGE(PG8_SB(1, 0), cB + kstep, voffB); PG8_STAGE(PG8_SA(1, 0), cA + kstep, voffA); PG8_STAGE(PG8_SB(1, 1), cB + hstep + kstep, voffB);
        PG8_WAIT_V(6); PG8_BAR;
    }
    for (;;) {
        const bool has_next = S.next(ui + 1, nxt);
        const char* nA = has_next ? (const char*)g.A + (size_t)nxt.pm * tstep : cA; const char* nB = has_next ? (const char*)g.Bt + (size_t)nxt.pn * tstep : cB;
        for (int t = 0; t < nt; t += 2) {
            const bool last = (t == nt - 2);
            const char* a1 = cA + (size_t)(t + 1) * kstep;
            const char* a2 = last ? nA : cA + (size_t)(t + 2) * kstep; const char* b2 = last ? nB : cB + (size_t)(t + 2) * kstep;
            const char* a3 = a2 + kstep; const char* b3 = b2 + kstep;
            if (last && has_next) S.a_ready(nxt);
            if constexpr (SP2) {
            PG8_LDB(B0, 0, 0); PG8_LDB(B1, 0, 1); PG8_SCHED; PG8_LDA(At, 0, 0); PG8_STAGE(PG8_SA(1, 1), a1 + hstep, voffA);
            PG8_WAIT_V(8); PG8_WAIT_L(0); PG8_BAR; PG8_MMA(0, 0, At, B0); PG8_MMA(0, 1, At, B1); PG8_BAR; PG8_SCHED;
            PG8_LDA(At, 0, 1); PG8_STAGE(PG8_SB(0, 0), b2, voffB); PG8_STAGE(PG8_SB(0, 1), b2 + hstep, voffB); PG8_STAGE(PG8_SA(0, 0), a2, voffA);
            PG8_WAIT_V(8); PG8_WAIT_L(0); PG8_BAR; PG8_MMA(1, 0, At, B0); PG8_MMA(1, 1, At, B1); PG8_BAR; PG8_SCHED;
            PG8_LDB(B0, 1, 0); PG8_LDB(B1, 1, 1); PG8_SCHED; PG8_LDA(At, 1, 0); PG8_STAGE(PG8_SA(0, 1), a2 + hstep, voffA);
            PG8_WAIT_V(8); PG8_WAIT_L(0); PG8_BAR; PG8_MMA(0, 0, At, B0); PG8_MMA(0, 1, At, B1); PG8_BAR; PG8_SCHED;
            PG8_LDA(At, 1, 1); PG8_STAGE(PG8_SB(1, 0), b3, voffB); PG8_STAGE(PG8_SB(1, 1), b3 + hstep, voffB); PG8_STAGE(PG8_SA(1, 0), a3, voffA);
            PG8_WAIT_V(8); PG8_WAIT_L(0); PG8_BAR; PG8_MMA(1, 0, At, B0); PG8_MMA(1, 1, At, B1); PG8_BAR; PG8_SCHED;
            } else {
            PG8_LDB(B0, 0, 0); PG8_SCHED; PG8_LDA(At, 0, 0); PG8_STAGE(PG8_SA(1, 1), a1 + hstep, voffA);
            PG8_WAIT_L(8); PG8_BAR; PG8_WAIT_L(0); PG8_MMA(0, 0, At, B0); PG8_BAR; PG8_SCHED;
            PG8_LDB(B1, 0, 1); PG8_STAGE(PG8_SB(0, 0), b2, voffB);
            PG8_BAR; PG8_WAIT_L(0); PG8_MMA(0, 1, At, B1); PG8_BAR;
            PG8_LDA(At, 0, 1); PG8_STAGE(PG8_SA(0, 0), a2, voffA);
            PG8_BAR; PG8_WAIT_L(0); PG8_MMA(1, 0, At, B0); PG8_BAR; PG8_SCHED;
            PG8_STAGE(PG8_SB(0, 1), b2 + hstep, voffB);
            PG8_WAIT_V(6); PG8_BAR; PG8_MMA(1, 1, At, B1); PG8_BAR;
            PG8_LDB(B0, 1, 0); PG8_SCHED; PG8_LDA(At, 1, 0); PG8_STAGE(PG8_SA(0, 1), a2 + hstep, voffA);
            PG8_WAIT_L(8); PG8_BAR; PG8_WAIT_L(0); PG8_MMA(0, 0, At, B0); PG8_BAR; PG8_SCHED;
            PG8_LDB(B1, 1, 1); PG8_STAGE(PG8_SB(1, 0), b3, voffB);
            PG8_BAR; PG8_WAIT_L(0); PG8_MMA(0, 1, At, B1); PG8_BAR;
            PG8_LDA(At, 1, 1); PG8_STAGE(PG8_SA(1, 0), a3, voffA);
            PG8_BAR; PG8_WAIT_L(0); PG8_MMA(1, 0, At, B0); PG8_BAR; PG8_SCHED;
            PG8_STAGE(PG8_SB(1, 1), b3 + hstep, voffB);
            PG8_WAIT_V(6); PG8_BAR; PG8_MMA(1, 1, At, B1); PG8_BAR;
            }
        }
        if constexpr (ALIGN_EPI) { if (wr == 0) PG8_BAR; }
        if constexpr (!Epi::AFTER_DRAIN) { E(acc, cur, wr, wc, fr, fq); S.done(cur); }
        if (!has_next) break;
#pragma unroll
        for (int a = 0; a < 2; ++a)
#pragma unroll
            for (int b = 0; b < 2; ++b)
#pragma unroll
                for (int m = 0; m < 4; ++m)
#pragma unroll
                    for (int n = 0; n < 2; ++n) acc[a][b][m][n] = (f32x4){0.f, 0.f, 0.f, 0.f};
        cur = nxt; cA = nA; cB = nB; ++ui;
        if constexpr (ALIGN_EPI) { if (wr == 1) PG8_BAR; }
    }
    PG8_WAIT_V(0);
    if constexpr (!ALIGN_EPI) { if (wr == 0) PG8_BAR; }
    PG8_BAR;
    if constexpr (Epi::AFTER_DRAIN) { E.fused(acc, cur, wr, wc, fr, fq, lds, wid, lane); S.done(cur); }
#undef PG8_SA
#undef PG8_SB
#undef PG8_STAGE
#undef PG8_LDA
#undef PG8_LDB
#undef PG8_MMA
#undef PG8_WAIT_V
#undef PG8_WAIT_L
#undef PG8_BAR
#undef PG8_SCHED
}
}
#define GAS __attribute__((address_space(1)))
#define LAS __attribute__((address_space(3)))
typedef unsigned short bf16;
typedef unsigned v4u __attribute__((ext_vector_type(4)));
typedef float f32x4 __attribute__((ext_vector_type(4)));
typedef short bf16x8 __attribute__((ext_vector_type(8)));
typedef GAS unsigned gu32;
typedef GAS unsigned long long gu64;
#define RLX_AGENT __ATOMIC_RELAXED, __HIP_MEMORY_SCOPE_AGENT
#define LDS_WAIT() asm volatile("s_waitcnt lgkmcnt(0)" ::: "memory")
#define VM_WAIT() asm volatile("s_waitcnt vmcnt(0)" ::: "memory")
__device__ __forceinline__ unsigned long long rt() { return __builtin_amdgcn_s_memrealtime(); }
__device__ __forceinline__ unsigned f2bf(float f) { unsigned u = __builtin_bit_cast(unsigned, f); return (u + 0x7fffu + ((u >> 16) & 1u)) >> 16; }
__device__ __forceinline__ unsigned pk2(float lo, float hi) { return f2bf(lo) | (f2bf(hi) << 16); }
#define XB_TMO      128
#define XB_XCNT(j)  (256  + 64 * (j))
#define XB_XSUB(j)  (1280 + 64 * (j))
#define XB_XGEN(j)  (2304 + 64 * (j))
#define XB_TOP      3328
#define XB_TOPGEN   3392
#define XCD_BAR_WORDS 3456
#define XB_SPIN_CAP (1u << 27)

__device__ __forceinline__ unsigned xb_ld(unsigned* p)              { return __hip_atomic_load(p, __ATOMIC_RELAXED, __HIP_MEMORY_SCOPE_AGENT); }
__device__ __forceinline__ unsigned xb_add(unsigned* p, unsigned v) { return __hip_atomic_fetch_add(p, v, __ATOMIC_RELAXED, __HIP_MEMORY_SCOPE_AGENT); }
__device__ __forceinline__ unsigned xb_xcc_id() { return (unsigned)__builtin_amdgcn_s_getreg((3 << 11) | 20) & 0xFu; }
#define XB_SPIN(cond, bar) do { unsigned _sp = 0; while (cond) { __builtin_amdgcn_s_sleep(1); \
    if ((++_sp & 255u) == 0u) { if (xb_ld(&(bar)[XB_TMO])) break; if (_sp > XB_SPIN_CAP) { atomicAdd(&(bar)[XB_TMO], 1u); break; } } } } while (0)

struct XcdBarrier {
    unsigned* bar; unsigned x;
    volatile LAS unsigned* st;
};

__device__ __forceinline__ XcdBarrier xcd_barrier_post(unsigned* bar, volatile LAS unsigned* st) {
    XcdBarrier b; b.bar = bar; b.x = xb_xcc_id(); b.st = st;
    if (threadIdx.x == 0) (void)xb_add(&bar[XB_XCNT(b.x)], 1u);
    return b;
}
__device__ __forceinline__ void xcd_barrier_complete(unsigned* bar, unsigned x, unsigned& nloc, unsigned& nx) {
    const unsigned G = gridDim.x * gridDim.y * gridDim.z;
    unsigned sum, cnt, mine, sp = 0u;
    for (;;) {
        sum = 0u; cnt = 0u; mine = 0u;
#pragma unroll
        for (unsigned j = 0; j < 16; ++j) { const unsigned c = xb_ld(&bar[XB_XCNT(j)]); sum += c; cnt += (c > 0u) ? 1u : 0u; mine = (j == x) ? c : mine; }
        if (sum == G) break;
        __builtin_amdgcn_s_sleep(1);
        if ((++sp & 255u) == 0u) { if (xb_ld(&bar[XB_TMO])) break; if (sp > XB_SPIN_CAP) { atomicAdd(&bar[XB_TMO], 1u); break; } }
    }
    nloc = mine > 0u ? mine : 1u; nx = cnt > 0u ? cnt : 1u;
}

__device__ __forceinline__ void xcd_barrier(const XcdBarrier& b) {
    asm volatile("s_waitcnt vmcnt(0)" ::: "memory");
    __syncthreads();
    if (threadIdx.x == 0) {
        unsigned* bar = b.bar;
        __builtin_amdgcn_s_waitcnt(0);
        unsigned nloc = b.st[0], nx = b.st[1];
        if (nloc == 0u) { xcd_barrier_complete(bar, b.x, nloc, nx); b.st[0] = nloc; b.st[1] = nx; }
        const unsigned old = xb_add(&bar[XB_XSUB(b.x)], 1u);
        const unsigned gen = old / nloc;
        if (old + 1u == (gen + 1u) * nloc) {
            __builtin_amdgcn_fence(__ATOMIC_RELEASE, "agent");
            asm volatile("s_waitcnt vmcnt(0)" ::: "memory");
            const unsigned og = xb_add(&bar[XB_TOP], 1u);
            const unsigned tg = og / nx;
            if (og + 1u == (tg + 1u) * nx) xb_add(&bar[XB_TOPGEN], 1u);
            else XB_SPIN(xb_ld(&bar[XB_TOPGEN]) == tg, bar);
            __builtin_amdgcn_fence(__ATOMIC_ACQUIRE, "agent");
            xb_add(&bar[XB_XGEN(b.x)], 1u);
            asm volatile("s_waitcnt vmcnt(0)" ::: "memory");
        } else {
            XB_SPIN(xb_ld(&bar[XB_XGEN(b.x)]) == gen, bar);
            __builtin_amdgcn_fence(__ATOMIC_ACQUIRE, "agent");
            asm volatile("s_waitcnt vmcnt(0)" ::: "memory");
        }
    }
    __syncthreads();
}
typedef float f32x16 __attribute__((ext_vector_type(16)));
typedef short s16x4 __attribute__((ext_vector_type(4)));
typedef short v4i16_t __attribute__((ext_vector_type(4)));
typedef __bf16 bf2_t __attribute__((ext_vector_type(2)));
typedef float f32x2_t __attribute__((ext_vector_type(2)));
typedef unsigned u32x2 __attribute__((ext_vector_type(2)));
typedef unsigned u32x4 __attribute__((ext_vector_type(4)));
#define DI __device__ __forceinline__
constexpr int NWAVES = 8, NTHR = 512;
DI unsigned cvt2(float a, float b) { f32x2_t v = {a, b}; return __builtin_bit_cast(unsigned, __builtin_convertvector(v, bf2_t)); }
DI float bf_lo(unsigned u) { return __uint_as_float(u << 16); }
DI float bf_hi(unsigned u) { return __uint_as_float(u & 0xffff0000u); }
DI s16x4 tr_read(const LAS unsigned char* p) { return __builtin_bit_cast(s16x4, __builtin_amdgcn_ds_read_tr16_b64_v4i16((LAS v4i16_t*)p)); }
DI bf16x8 cat8(s16x4 a, s16x4 b) { bf16x8 r; r[0] = a[0]; r[1] = a[1]; r[2] = a[2]; r[3] = a[3]; r[4] = b[0]; r[5] = b[1]; r[6] = b[2]; r[7] = b[3]; return r; }
DI float wave_sum(float v) {
#pragma unroll
    for (int o = 1; o < 64; o <<= 1) v += __shfl_xor(v, o);
    return v;
}
#define MFMA32(a, b, c) __builtin_amdgcn_mfma_f32_32x32x16_bf16((a), (b), (c), 0, 0, 0)
#define WG_SYNC() __syncthreads()

namespace pg8 {
struct EpiGen {
    static constexpr bool PERM = true, AFTER_DRAIN = false;
    int mode; bf16_t* out; int ldc; const void* res; float* side0; float* side1;
    __device__ __forceinline__ void operator()(const f32x4 (&acc)[2][2][4][2], const Unit& u, int wr, int wc, int fr, int fq) const {
        const int row0 = u.pm * BM + wr * 64 + fr, col0 = u.pn * BM + wc * 32 + 8 * fq; const float alpha = cfg::ALPHA;
#pragma unroll
        for (int ai = 0; ai < 2; ++ai)
#pragma unroll
            for (int m = 0; m < 4; ++m) { const size_t row = (size_t)(row0 + ai * HALF + m * 16);
#pragma unroll
                for (int bj = 0; bj < 2; ++bj) { const int col = col0 + bj * HALF; f32x4 v0 = acc[ai][bj][m][0], v1 = acc[ai][bj][m][1];
                    if (mode == 1) { const float* r = (const float*)res + row * 1024 + col; const f32x4 r0 = *(const f32x4*)r, r1 = *(const f32x4*)(r + 4); v0 += alpha * r0; v1 += alpha * r1; }
                    else if (mode == 2) { const u32x4 r = *(const u32x4*)((const bf16_t*)res + row * 1024 + col);
                        v0[0] += alpha * bf_lo(r.x); v0[1] += alpha * bf_hi(r.x); v0[2] += alpha * bf_lo(r.y); v0[3] += alpha * bf_hi(r.y);
                        v1[0] += alpha * bf_lo(r.z); v1[1] += alpha * bf_hi(r.z); v1[2] += alpha * bf_lo(r.w); v1[3] += alpha * bf_hi(r.w); }
                    u32x4 w; w.x = cvt2(v0[0], v0[1]); w.y = cvt2(v0[2], v0[3]); w.z = cvt2(v1[0], v1[1]); w.w = cvt2(v1[2], v1[3]);
                    *(u32x4*)(out + row * ldc + col) = w;
                    if (side0 && bj == 0) { if (col == 3072 || col == 3080) { float* p = side0 + row * 16 + (col - 3072); *(f32x4*)p = v0; *(f32x4*)(p + 4) = v1; }
                                            if (col == 5392 || col == 5400) { float* p = side1 + row * 16 + (col - 5392); *(f32x4*)p = v0; *(f32x4*)(p + 4) = v1; } } }
                asm volatile("" ::: "memory"); }
    }
};
}

DI void ln_rows_bf16(bf16* buf, const float* g, const float* bt, int rows, int gw, int NGW, int lane) {
    for (int r = gw; r < rows; r += NGW) {
        bf16* p = buf + (size_t)r * 1024 + lane * 8;
        const u32x4 a = *(const u32x4*)p, b = *(const u32x4*)(p + 512);
        float v[16] = {bf_lo(a.x), bf_hi(a.x), bf_lo(a.y), bf_hi(a.y), bf_lo(a.z), bf_hi(a.z), bf_lo(a.w), bf_hi(a.w), bf_lo(b.x), bf_hi(b.x), bf_lo(b.y), bf_hi(b.y), bf_lo(b.z), bf_hi(b.z), bf_lo(b.w), bf_hi(b.w)};
        float s = 0.f;
#pragma unroll
        for (int i = 0; i < 16; ++i) s += v[i];
        const float mean = wave_sum(s) * (1.f / 1024.f); float q = 0.f;
#pragma unroll
        for (int i = 0; i < 16; ++i) { v[i] -= mean; q += v[i] * v[i]; }
        const float rstd = 1.0f / sqrtf(wave_sum(q) * (1.f / 1024.f) + cfg::LN_EPS);
        const f32x4 g0 = *(const f32x4*)(g + lane * 8), g1 = *(const f32x4*)(g + lane * 8 + 4), g2 = *(const f32x4*)(g + 512 + lane * 8), g3 = *(const f32x4*)(g + 512 + lane * 8 + 4);
        const f32x4 b0 = *(const f32x4*)(bt + lane * 8), b1 = *(const f32x4*)(bt + lane * 8 + 4), b2 = *(const f32x4*)(bt + 512 + lane * 8), b3 = *(const f32x4*)(bt + 512 + lane * 8 + 4);
        u32x4 oa, ob;
        oa.x = cvt2(v[0] * rstd * g0[0] + b0[0], v[1] * rstd * g0[1] + b0[1]); oa.y = cvt2(v[2] * rstd * g0[2] + b0[2], v[3] * rstd * g0[3] + b0[3]);
        oa.z = cvt2(v[4] * rstd * g1[0] + b1[0], v[5] * rstd * g1[1] + b1[1]); oa.w = cvt2(v[6] * rstd * g1[2] + b1[2], v[7] * rstd * g1[3] + b1[3]);
        ob.x = cvt2(v[8] * rstd * g2[0] + b2[0], v[9] * rstd * g2[1] + b2[1]); ob.y = cvt2(v[10] * rstd * g2[2] + b2[2], v[11] * rstd * g2[3] + b2[3]);
        ob.z = cvt2(v[12] * rstd * g3[0] + b3[0], v[13] * rstd * g3[1] + b3[1]); ob.w = cvt2(v[14] * rstd * g3[2] + b3[2], v[15] * rstd * g3[3] + b3[3]);
        *(u32x4*)p = oa; *(u32x4*)(p + 512) = ob;
    }
}

constexpr int ATT_KP = 528, ATT_VP = 576;
DI void attn_phase(LAS unsigned char* lds, bf16* QO, const bf16* Kc, const bf16* Vc, int G, int bx, int tid) {
    using namespace cfg;
    const int lane = tid & 63, wave = tid >> 6, q = lane & 31, h = lane >> 5;
    constexpr int NU = (NTOK / 256) * MEM_HEADS;
    for (int u = bx; u < NU; u += G) {
        const int bh = u / (SEQ / 256), qb = u % (SEQ / 256), b = bh / MEM_HEADS, hd = bh % MEM_HEADS;
        const bf16* Kg = Kc + (size_t)(b * MEM_LEN) * D_MODEL + hd * MEM_HEAD_DIM;
        const bf16* Vg = Vc + (size_t)(b * MEM_LEN) * D_MODEL + hd * MEM_HEAD_DIM;
        bf16* Qg = QO + ((size_t)b * SEQ + (size_t)qb * 256 + wave * 32 + q) * D_MODEL + hd * MEM_HEAD_DIM;
        WG_SYNC();
#pragma unroll 4
        for (int p = 0; p < 16; ++p) { const int key = p * 16 + (tid >> 5), ch = tid & 31;
            const u32x4 v = *(const u32x4*)(Kg + (size_t)key * D_MODEL + ch * 8); *(LAS u32x4*)(lds + key * ATT_KP + ch * 16) = v; }
        bf16x8 qf[16];
#pragma unroll
        for (int s = 0; s < 16; ++s) qf[s] = *(const bf16x8*)(Qg + 16 * s + 8 * h);
        WG_SYNC();
        f32x16 sc[8];
#pragma unroll
        for (int kt = 0; kt < 8; ++kt) {
#pragma unroll
            for (int i = 0; i < 16; ++i) sc[kt][i] = 0.f;
#pragma unroll
            for (int s = 0; s < 16; ++s) { const bf16x8 kf = *(const LAS bf16x8*)(lds + (kt * 32 + q) * ATT_KP + (16 * s + 8 * h) * 2); sc[kt] = MFMA32(kf, qf[s], sc[kt]); }
        }
        float m = sc[0][0];
#pragma unroll
        for (int kt = 0; kt < 8; ++kt)
#pragma unroll
            for (int i = 0; i < 16; ++i) m = fmaxf(m, sc[kt][i]);
        m = fmaxf(m, __shfl_xor(m, 32));
        const float c = 0.0625f * 1.44269504088896f; float l = 0.f; const float mc = m * c;
        bf16x8 pf[8][2];
#pragma unroll
        for (int kt = 0; kt < 8; ++kt) {
            float e[16];
#pragma unroll
            for (int i = 0; i < 16; ++i) { e[i] = __builtin_amdgcn_exp2f(sc[kt][i] * c - mc); l += e[i]; }
#pragma unroll
            for (int s = 0; s < 2; ++s) { u32x4 w; w.x = cvt2(e[8 * s], e[8 * s + 1]); w.y = cvt2(e[8 * s + 2], e[8 * s + 3]); w.z = cvt2(e[8 * s + 4], e[8 * s + 5]); w.w = cvt2(e[8 * s + 6], e[8 * s + 7]); pf[kt][s] = __builtin_bit_cast(bf16x8, w); }
        }
        l += __shfl_xor(l, 32);
        const float inv = 1.0f / l;
        WG_SYNC();
#pragma unroll 4
        for (int p = 0; p < 16; ++p) { const int key = p * 16 + (tid >> 5), ch = tid & 31;
            const u32x4 v = *(const u32x4*)(Vg + (size_t)key * D_MODEL + ch * 8); *(LAS u32x4*)(lds + key * ATT_VP + ch * 16) = v; }
        WG_SYNC();
        const int gi = (lane >> 4) & 1, i16 = lane & 15;
        const LAS unsigned char* vb = lds + (4 * h + (i16 >> 2)) * ATT_VP + (16 * gi + 4 * (i16 & 3)) * 2;
#pragma unroll
        for (int et = 0; et < 8; ++et) {
            f32x16 o;
#pragma unroll
            for (int i = 0; i < 16; ++i) o[i] = 0.f;
#pragma unroll
            for (int kt = 0; kt < 8; ++kt)
#pragma unroll
                for (int s = 0; s < 2; ++s) { const LAS unsigned char* a = vb + (kt * 32 + 16 * s) * ATT_VP + et * 64;
                    const bf16x8 vf = cat8(tr_read(a), tr_read(a + 8 * ATT_VP)); o = MFMA32(vf, pf[kt][s], o); }
#pragma unroll
            for (int r4 = 0; r4 < 4; ++r4) { u32x2 w; w.x = cvt2(o[4 * r4] * inv, o[4 * r4 + 1] * inv); w.y = cvt2(o[4 * r4 + 2] * inv, o[4 * r4 + 3] * inv);
                *(u32x2*)(Qg + et * 32 + 8 * r4 + 4 * h) = w; }
        }
    }
    WG_SYNC();
}

DI int f2key(float s) { int k = __float_as_int(s); return k ^ ((k >> 31) & 0x7fffffff); }
DI float key2f(int k) { return __int_as_float(k ^ ((k >> 31) & 0x7fffffff)); }
#define CE_DESC(a, b) do { const int _hi = max((a), (b)), _lo = min((a), (b)); (a) = _hi; (b) = _lo; } while (0)
DI void sort16_desc(int (&t)[16]) {
#pragma unroll
    for (int k = 2; k <= 16; k <<= 1)
#pragma unroll
        for (int j = k >> 1; j > 0; j >>= 1)
#pragma unroll
            for (int i = 0; i < 16; ++i) { const int l = i ^ j; if (l > i) { if ((i & k) == 0) CE_DESC(t[i], t[l]); else CE_DESC(t[l], t[i]); } }
}
DI void merge16_desc(int (&a)[16], const int (&b)[16]) {
#pragma unroll
    for (int i = 0; i < 16; ++i) a[i] = max(a[i], b[15 - i]);
#pragma unroll
    for (int j = 8; j > 0; j >>= 1)
#pragma unroll
        for (int i = 0; i < 16; ++i) { const int l = i ^ j; if (l > i) CE_DESC(a[i], a[l]); }
}
constexpr int TK_KP = 144;
DI void topk_phase(LAS unsigned char* lds, const bf16* PQ, const float* keys, unsigned* picks, int G, int bx, int tid) {
    using namespace cfg;
    const int lane = tid & 63, wave = tid >> 6, q = lane & 31, h = lane >> 5;
    for (int i = tid; i < 2 * PEER_N_KEYS * PEER_HALF / 2; i += NTHR) { const int row = i / (PEER_HALF / 2), c2 = i % (PEER_HALF / 2);
        const float a = keys[row * PEER_HALF + 2 * c2], b = keys[row * PEER_HALF + 2 * c2 + 1]; *(LAS unsigned*)(lds + row * TK_KP + c2 * 4) = cvt2(a, b); }
    LAS unsigned* lut = (LAS unsigned*)(lds + 40960) + (wave * 64 + lane) * 33;
    WG_SYNC();
    constexpr int NTASK = (NTOK / 32) * PEER_HEADS;
    for (int task = bx * NWAVES + wave; task < NTASK; task += G * NWAVES) {
        const int tb = task / PEER_HEADS, hd = task % PEER_HEADS;
        const bf16* qg = PQ + (size_t)(tb * 32 + q) * D_MODEL + hd * PEER_KEY_DIM;
        int top[2][16];
#pragma unroll
        for (int p = 0; p < 2; ++p) {
            bf16x8 qf[4];
#pragma unroll
            for (int s = 0; s < 4; ++s) qf[s] = *(const bf16x8*)(qg + p * PEER_HALF + 16 * s + 8 * h);
            int grp[4][16];
#pragma unroll
            for (int kt = 0; kt < 4; ++kt) {
                f32x16 sc;
#pragma unroll
                for (int i = 0; i < 16; ++i) sc[i] = 0.f;
#pragma unroll
                for (int s = 0; s < 4; ++s) { const bf16x8 kf = *(const LAS bf16x8*)(lds + (p * PEER_N_KEYS + kt * 32 + q) * TK_KP + (16 * s + 8 * h) * 2); sc = MFMA32(kf, qf[s], sc); }
#pragma unroll
                for (int i = 0; i < 16; ++i) { const int idx = kt * 32 + (i & 3) + 8 * (i >> 2) + 4 * h; grp[kt][i] = (f2key(sc[i]) & ~127) | (127 - idx); }
                sort16_desc(grp[kt]);
            }
            merge16_desc(grp[0], grp[1]); merge16_desc(grp[2], grp[3]); merge16_desc(grp[0], grp[2]);
            int other[16];
#pragma unroll
            for (int i = 0; i < 16; ++i) other[i] = __shfl_xor(grp[0][i], 32);
            merge16_desc(grp[0], other);
#pragma unroll
            for (int i = 0; i < 16; ++i) top[p][i] = grp[0][i];
        }
        float s1[16], s2[16];
#pragma unroll
        for (int i = 0; i < 16; ++i) { s1[i] = key2f(top[0][i] & ~127); s2[i] = key2f(top[1][i] & ~127); lut[i] = 127 - (top[0][i] & 127); lut[16 + i] = 127 - (top[1][i] & 127); }
        int L[16];
#pragma unroll
        for (int j = 0; j < 16; ++j) L[j] = (f2key(s1[0] + s2[j]) & ~255) | (255 - j);
#pragma unroll
        for (int i = 1; i < 16; ++i)
#pragma unroll
            for (int j = 0; j < 16; ++j) if ((i + 1) * (j + 1) <= 16) {
                int x = (f2key(s1[i] + s2[j]) & ~255) | (255 - (16 * i + j));
#pragma unroll
                for (int pz = (i + 1) * (j + 1) - 1; pz < 16; ++pz) CE_DESC(L[pz], x);
            }
        const float best0 = key2f(L[0] & ~255); float ge[16], gs = 0.f;
#pragma unroll
        for (int n = 0; n < 16; ++n) { ge[n] = __expf(key2f(L[n] & ~255) - best0); gs += ge[n]; }
        const float ginv = 1.0f / gs;
        asm volatile("s_waitcnt lgkmcnt(0)" ::: "memory");
        unsigned* pk = picks + ((size_t)(tb * 32 + q) * PEER_HEADS + hd) * 16 + 8 * h;
        unsigned wv[16];
#pragma unroll
        for (int n = 0; n < 16; ++n) { const int c = 255 - (L[n] & 255); const unsigned e = lut[c >> 4] * PEER_N_KEYS + lut[16 + (c & 15)];
            wv[n] = (e << 16) | (cvt2(ge[n] * ginv, 0.f) & 0xffffu); }
        u32x4 o0, o1;
        o0.x = h ? wv[8] : wv[0]; o0.y = h ? wv[9] : wv[1]; o0.z = h ? wv[10] : wv[2]; o0.w = h ? wv[11] : wv[3];
        o1.x = h ? wv[12] : wv[4]; o1.y = h ? wv[13] : wv[5]; o1.z = h ? wv[14] : wv[6]; o1.w = h ? wv[15] : wv[7];
        *(u32x4*)pk = o0; *(u32x4*)(pk + 4) = o1;
    }
    WG_SYNC();
}

DI float gelu_erf(float v) {
    const float av = fabsf(v), t = __builtin_amdgcn_rcpf(av * 0.2316418882f + 1.0f);
    float qv = t * 0.5307027145f - 0.7265760135f; qv = qv * t + 0.7107068705f; qv = qv * t - 0.142248368f; qv = qv * t + 0.127414796f; qv = qv * t;
    const float e = __builtin_amdgcn_exp2f(v * v * -0.72134752044f), mm = v * (qv * e);
    return v < 0.f ? mm : v - mm;
}
typedef __bf16 bf8_t __attribute__((ext_vector_type(8)));
DI float dot8(const u32x4 a, const u32x4 b, float acc) {
    const bf8_t a8 = __builtin_bit_cast(bf8_t, a), b8 = __builtin_bit_cast(bf8_t, b);
    acc = __builtin_amdgcn_fdot2_f32_bf16(a8.s01, b8.s01, acc, false);
    acc = __builtin_amdgcn_fdot2_f32_bf16(a8.s23, b8.s23, acc, false);
    acc = __builtin_amdgcn_fdot2_f32_bf16(a8.s45, b8.s45, acc, false);
    acc = __builtin_amdgcn_fdot2_f32_bf16(a8.s67, b8.s67, acc, false);
    return acc;
}
DI void axpy8(float (&o)[8], float w, const u32x4 v) {
    o[0] += w * bf_lo(v.x); o[1] += w * bf_hi(v.x); o[2] += w * bf_lo(v.y); o[3] += w * bf_hi(v.y); o[4] += w * bf_lo(v.z); o[5] += w * bf_hi(v.z); o[6] += w * bf_lo(v.w); o[7] += w * bf_hi(v.w);
}
template <int XM> DI float swz_xor(float v) { return __int_as_float(__builtin_amdgcn_ds_swizzle(__float_as_int(v), (XM << 10) | 0x1f)); }
template <int D> DI void treduce_stage(float (&p)[16], int lane) {
    const bool up = (lane & D) != 0;
#pragma unroll
    for (int k = 0; k < D; ++k) { const float keep = up ? p[k + D] : p[k], send = up ? p[k] : p[k + D]; p[k] = keep + swz_xor<D>(send); }
}
DI float treduce16(float (&p)[16], int lane) {
    treduce_stage<8>(p, lane); treduce_stage<4>(p, lane); treduce_stage<2>(p, lane); treduce_stage<1>(p, lane);
    float r = p[0]; r += swz_xor<16>(r); r += __shfl_xor(r, 32); return r;
}
DI u32x4 bload(__amdgpu_buffer_rsrc_t r, int voff, int soff) { return __builtin_bit_cast(u32x4, __builtin_amdgcn_raw_buffer_load_b128(r, voff, soff, 0)); }
DI void peer_phase(const bf16* H2, const unsigned* picks, const bf16* U, const bf16* V, const float* g, const float* bt, float* out, int gw, int NGW, int lane) {
    using namespace cfg;
    const __amdgpu_buffer_rsrc_t ru = __builtin_amdgcn_make_buffer_rsrc((void*)U, 0, PEER_EXPERTS * D_MODEL * 2, 0x00020000);
    const __amdgpu_buffer_rsrc_t rv = __builtin_amdgcn_make_buffer_rsrc((void*)V, 0, PEER_EXPERTS * D_MODEL * 2, 0x00020000);
    const int voff = lane * 16;
    for (int t = gw; t < NTOK; t += NGW) {
        const bf16* xr = H2 + (size_t)t * D_MODEL + lane * 8;
        const u32x4 xa = *(const u32x4*)xr, xb = *(const u32x4*)(xr + 512);
        float acc0[8], acc1[8];
#pragma unroll
        for (int i = 0; i < 8; ++i) { acc0[i] = 0.f; acc1[i] = 0.f; }
#pragma unroll 1
        for (int grp = 0; grp < 2; ++grp) {
            const unsigned pk = picks[(size_t)t * 128 + grp * 64 + lane];
            const int eoff = (int)(pk >> 16) * (D_MODEL * 2); const float gate = __uint_as_float(pk << 16);
            float act = 0.f;
#pragma unroll
            for (int sg = 0; sg < 4; ++sg) {
                float part[16];
#pragma unroll
                for (int k = 0; k < 16; ++k) { const int so = __builtin_amdgcn_readlane(eoff, sg * 16 + k);
                    const u32x4 ua = bload(ru, voff, so), ub = bload(ru, voff + 1024, so); part[k] = dot8(ub, xb, dot8(ua, xa, 0.f));
                    if (k == 7) __builtin_amdgcn_sched_barrier(0); }
                __builtin_amdgcn_sched_barrier(0);
                const float r = treduce16(part, lane);
                act = ((lane >> 4) == sg) ? r : act;
            }
            const float w = gate * gelu_erf(act);
#pragma unroll 8
            for (int k = 0; k < 64; ++k) { if ((k & 7) == 0) __builtin_amdgcn_sched_barrier(0); const int so = __builtin_amdgcn_readlane(eoff, k); const float wk = __int_as_float(__builtin_amdgcn_readlane(__float_as_int(w), k));
                const u32x4 va = bload(rv, voff, so), vb = bload(rv, voff + 1024, so); axpy8(acc0, wk, va); axpy8(acc1, wk, vb); }
        }
        const float xs[16] = {bf_lo(xa.x), bf_hi(xa.x), bf_lo(xa.y), bf_hi(xa.y), bf_lo(xa.z), bf_hi(xa.z), bf_lo(xa.w), bf_hi(xa.w), bf_lo(xb.x), bf_hi(xb.x), bf_lo(xb.y), bf_hi(xb.y), bf_lo(xb.z), bf_hi(xb.z), bf_lo(xb.w), bf_hi(xb.w)};
        float z[16]; float s = 0.f;
#pragma unroll
        for (int i = 0; i < 8; ++i) { z[i] = ALPHA * xs[i] + acc0[i]; z[8 + i] = ALPHA * xs[8 + i] + acc1[i]; s += z[i] + z[8 + i]; }
        const float mean = wave_sum(s) * (1.f / 1024.f); float qv = 0.f;
#pragma unroll
        for (int i = 0; i < 16; ++i) { z[i] -= mean; qv += z[i] * z[i]; }
        const float rstd = 1.0f / sqrtf(wave_sum(qv) * (1.f / 1024.f) + LN_EPS);
        float* op = out + (size_t)t * D_MODEL + lane * 8;
#pragma unroll
        for (int hlf = 0; hlf < 2; ++hlf) {
            const f32x4 g0 = *(const f32x4*)(g + hlf * 512 + lane * 8), g1 = *(const f32x4*)(g + hlf * 512 + lane * 8 + 4), b0 = *(const f32x4*)(bt + hlf * 512 + lane * 8), b1 = *(const f32x4*)(bt + hlf * 512 + lane * 8 + 4);
            f32x4 o0, o1;
#pragma unroll
            for (int i = 0; i < 4; ++i) { o0[i] = z[hlf * 8 + i] * rstd * g0[i] + b0[i]; o1[i] = z[hlf * 8 + 4 + i] * rstd * g1[i] + b1[i]; }
            *(f32x4*)(op + hlf * 512) = o0; *(f32x4*)(op + hlf * 512 + 4) = o1;
        }
    }
}
constexpr int PROJ_LD = 5632;
constexpr int PC_Q = 0, PC_K = 512, PC_V = 1024, PC_R = 2048, PC_G = 3072, PC_Z = 3088, PC_XBC = 4112, PC_DT = 5392;
struct MixBufs { const bf16* proj; const float* glow; const float* dtraw; bf16* gS; float* gdec; bf16* sS; float* sdec; bf16* oy; int nbatch; };

DI float log_sigmoid_f(float z) { return fminf(z, 0.f) - __logf(1.0f + __expf(-fabsf(z))); }
DI float silu_f(float x) { return x / (1.0f + __expf(-x)); }
DI float bf2f(bf16 v) { return __uint_as_float((unsigned)v << 16); }
DI bf16 f2bf16(float f) { return (bf16)(cvt2(f, 0.f) & 0xffffu); }

DI void gla_gate(LAS unsigned char* lds, const float* glow_rows, const float* wg2, const float* bg, int h, int tid, float (&b)[16], float& blast) {
    LAS float* gl = (LAS float*)lds; LAS float* tot = (LAS float*)(lds + 4096);
    gl[tid] = glow_rows[tid]; gl[tid + 512] = glow_rows[tid + 512];
    const int d = tid & 127, tb = tid >> 7;
    float wc[16];
#pragma unroll
    for (int r = 0; r < 16; ++r) wc[r] = wg2[r * 512 + h * 128 + d];
    const float bgv = bg[h * 128 + d];
    WG_SYNC();
    float run = 0.f;
#pragma unroll
    for (int i = 0; i < 16; ++i) { const LAS float* g = gl + (tb * 16 + i) * 16; float z = bgv;
#pragma unroll
        for (int r = 0; r < 16; ++r) z += g[r] * wc[r];
        run += log_sigmoid_f(z) * 0.0625f; b[i] = run; }
    tot[tb * 128 + d] = run;
    WG_SYNC();
    const float t0 = tot[d], t1 = tot[128 + d], t2 = tot[256 + d], t3 = tot[384 + d];
    const float off = tb == 0 ? 0.f : tb == 1 ? t0 : tb == 2 ? t0 + t1 : t0 + t1 + t2;
    blast = (t0 + t1) + (t2 + t3);
#pragma unroll
    for (int i = 0; i < 16; ++i) b[i] += off;
}

constexpr int GA_KH = 8192, GA_KHP = 320, GA_V = GA_KH + 64 * GA_KHP, GA_VP = 576, GA_ST = GA_V + 64 * GA_VP, GA_STP = 272;
static_assert(GA_ST + 256 * GA_STP <= 152 * 1024, "GLA-A LDS");
DI void gla_a_phase(LAS unsigned char* lds, const MixBufs& mb, const float* wg2, const float* bg, int G, int bx, int tid) {
    using namespace cfg;
    const int lane = tid & 63, wave = tid >> 6, i16 = lane & 15, gi = (lane >> 4) & 1, hh = lane >> 5;
    const int nitem = mb.nbatch * GLA_HEADS * (SEQ / 64);
    for (int it = bx; it < nitem; it += G) {
        const int bh = it / (SEQ / 64), c = it % (SEQ / 64), bl = bh / GLA_HEADS, h = bh % GLA_HEADS;
        const size_t row0 = (size_t)bl * SEQ + (size_t)c * 64;
        const bf16* prow = mb.proj + row0 * PROJ_LD;
        float b[16], blast;
        gla_gate(lds, mb.glow + row0 * 16, wg2, bg, h, tid, b, blast);
        const int d = tid & 127, tb = tid >> 7;
#pragma unroll
        for (int i = 0; i < 16; ++i) { const int t = tb * 16 + i; const float kv = bf2f(prow[(size_t)t * PROJ_LD + PC_K + h * 128 + d]);
            *(LAS bf16*)(lds + GA_KH + t * GA_KHP + d * 2) = f2bf16(kv * __expf(blast - b[i])); }
        if (tb == 0) mb.gdec[((size_t)bh * (SEQ / 64) + c) * 128 + d] = __expf(blast);
#pragma unroll
        for (int j = 0; j < 4; ++j) { const int id = tid + 512 * j, t = id >> 5, ch = id & 31;
            *(LAS u32x4*)(lds + GA_V + t * GA_VP + ch * 16) = *(const u32x4*)(prow + (size_t)t * PROJ_LD + PC_V + h * 256 + ch * 8); }
        WG_SYNC();
        const int dtile = wave & 3, eq = wave >> 2;
        f32x16 acc[4];
#pragma unroll
        for (int j = 0; j < 4; ++j)
#pragma unroll
            for (int i = 0; i < 16; ++i) acc[j][i] = 0.f;
        const LAS unsigned char* ka = lds + GA_KH + (8 * hh + (i16 >> 2)) * GA_KHP + (dtile * 32 + 16 * gi + 4 * (i16 & 3)) * 2;
        const LAS unsigned char* va = lds + GA_V + (8 * hh + (i16 >> 2)) * GA_VP + (eq * 128 + 16 * gi + 4 * (i16 & 3)) * 2;
#pragma unroll
        for (int s = 0; s < 4; ++s) {
            const bf16x8 af = cat8(tr_read(ka + 16 * s * GA_KHP), tr_read(ka + (16 * s + 4) * GA_KHP));
#pragma unroll
            for (int j = 0; j < 4; ++j) { const bf16x8 bfr = cat8(tr_read(va + 16 * s * GA_VP + j * 64), tr_read(va + (16 * s + 4) * GA_VP + j * 64)); acc[j] = MFMA32(af, bfr, acc[j]); }
        }
#pragma unroll
        for (int j = 0; j < 4; ++j)
#pragma unroll
            for (int r4 = 0; r4 < 4; ++r4) { u32x2 w; w.x = cvt2(acc[j][4 * r4], acc[j][4 * r4 + 1]); w.y = cvt2(acc[j][4 * r4 + 2], acc[j][4 * r4 + 3]);
                *(LAS u32x2*)(lds + GA_ST + ((eq * 4 + j) * 32 + (lane & 31)) * GA_STP + (dtile * 32 + 8 * r4 + 4 * hh) * 2) = w; }
        WG_SYNC();
        bf16* so = mb.gS + ((size_t)bh * (SEQ / 64) + c) * (256 * 128);
#pragma unroll
        for (int j = 0; j < 8; ++j) { const int id = tid + 512 * j, e = id >> 4, ch = id & 15;
            *(u32x4*)(so + e * 128 + ch * 8) = *(const LAS u32x4*)(lds + GA_ST + e * GA_STP + ch * 16); }
        WG_SYNC();
    }
}

DI void gla_b_phase(const MixBufs& mb, long gtid, long nthr) {
    using namespace cfg;
    const long total = (long)mb.nbatch * GLA_HEADS * 256 * 16;
    for (long i = gtid; i < total; i += nthr) {
        const int dg = (int)(i & 15), e = (int)((i >> 4) & 255), bh = (int)(i >> 12);
        bf16* sp = mb.gS + (size_t)bh * (SEQ / 64) * (256 * 128) + e * 128 + dg * 8;
        const float* dp = mb.gdec + (size_t)bh * (SEQ / 64) * 128 + dg * 8;
        float st[8];
#pragma unroll
        for (int k = 0; k < 8; ++k) st[k] = 0.f;
        for (int c0 = 0; c0 < SEQ / 64; c0 += 4) {
            u32x4 kv[4]; f32x4 d0[4], d1[4];
#pragma unroll
            for (int u = 0; u < 4; ++u) { kv[u] = *(const u32x4*)(sp + (size_t)(c0 + u) * (256 * 128)); d0[u] = *(const f32x4*)(dp + (c0 + u) * 128); d1[u] = *(const f32x4*)(dp + (c0 + u) * 128 + 4); }
#pragma unroll
            for (int u = 0; u < 4; ++u) {
                u32x4 o; o.x = cvt2(st[0], st[1]); o.y = cvt2(st[2], st[3]); o.z = cvt2(st[4], st[5]); o.w = cvt2(st[6], st[7]);
                *(u32x4*)(sp + (size_t)(c0 + u) * (256 * 128)) = o;
                st[0] = d0[u][0] * st[0] + bf_lo(kv[u].x); st[1] = d0[u][1] * st[1] + bf_hi(kv[u].x); st[2] = d0[u][2] * st[2] + bf_lo(kv[u].y); st[3] = d0[u][3] * st[3] + bf_hi(kv[u].y);
                st[4] = d1[u][0] * st[4] + bf_lo(kv[u].z); st[5] = d1[u][1] * st[5] + bf_hi(kv[u].z); st[6] = d1[u][2] * st[6] + bf_lo(kv[u].w); st[7] = d1[u][3] * st[7] + bf_hi(kv[u].w);
            }
        }
    }
}

constexpr int GC_SSQ = 6144, GC_QT = 8192, GC_QKP = 272, GC_KT = GC_QT + 64 * GC_QKP, GC_V = GC_KT + 64 * GC_QKP, GC_VP = 576, GC_P = GC_V + 64 * GC_VP, GC_PP = 144, GC_O = GC_P + 64 * GC_PP, GC_OP = 528;
static_assert(GC_O + 64 * GC_OP <= 152 * 1024, "GLA-C LDS");
DI void gla_c_phase(LAS unsigned char* lds, const MixBufs& mb, const float* wg2, const float* bg, const float* norm_g, int G, int bx, int tid) {
    using namespace cfg;
    const int lane = tid & 63, wave = tid >> 6, i16 = lane & 15, gi = (lane >> 4) & 1, hh = lane >> 5, l31 = lane & 31;
    const int nitem = mb.nbatch * GLA_HEADS * (SEQ / 64);
    for (int it = bx; it < nitem; it += G) {
        const int bh = it / (SEQ / 64), c = it % (SEQ / 64), bl = bh / GLA_HEADS, h = bh % GLA_HEADS;
        const size_t row0 = (size_t)bl * SEQ + (size_t)c * 64;
        const bf16* prow = mb.proj + row0 * PROJ_LD;
        float b[16], blast;
        gla_gate(lds, mb.glow + row0 * 16, wg2, bg, h, tid, b, blast);
        const int d = tid & 127, tb = tid >> 7;
#pragma unroll
        for (int i = 0; i < 16; ++i) { const int t = tb * 16 + i; const bf16* pr = prow + (size_t)t * PROJ_LD + h * 128 + d;
            *(LAS bf16*)(lds + GC_QT + t * GC_QKP + d * 2) = f2bf16(bf2f(pr[PC_Q]) * 0.08838834764831845f * __expf(b[i]));
            *(LAS bf16*)(lds + GC_KT + t * GC_QKP + d * 2) = f2bf16(bf2f(pr[PC_K]) * __expf(-b[i])); }
#pragma unroll
        for (int j = 0; j < 4; ++j) { const int id = tid + 512 * j, t = id >> 5, ch = id & 31;
            *(LAS u32x4*)(lds + GC_V + t * GC_VP + ch * 16) = *(const u32x4*)(prow + (size_t)t * PROJ_LD + PC_V + h * 256 + ch * 8); }
        WG_SYNC();
        if (wave < 3) {
            const int st = wave == 2 ? 1 : 0, tt = wave == 0 ? 0 : 1;
            f32x16 p;
#pragma unroll
            for (int i = 0; i < 16; ++i) p[i] = 0.f;
#pragma unroll
            for (int ks = 0; ks < 8; ++ks) { const bf16x8 af = *(const LAS bf16x8*)(lds + GC_KT + (st * 32 + l31) * GC_QKP + (16 * ks + 8 * hh) * 2);
                const bf16x8 bfr = *(const LAS bf16x8*)(lds + GC_QT + (tt * 32 + l31) * GC_QKP + (16 * ks + 8 * hh) * 2); p = MFMA32(af, bfr, p); }
            const int t = tt * 32 + l31;
#pragma unroll
            for (int r4 = 0; r4 < 4; ++r4) { const int s0 = st * 32 + 8 * r4 + 4 * hh; u32x2 w;
                w.x = cvt2(s0 <= t ? p[4 * r4] : 0.f, s0 + 1 <= t ? p[4 * r4 + 1] : 0.f); w.y = cvt2(s0 + 2 <= t ? p[4 * r4 + 2] : 0.f, s0 + 3 <= t ? p[4 * r4 + 3] : 0.f);
                *(LAS u32x2*)(lds + GC_P + t * GC_PP + s0 * 2) = w; }
        }
        WG_SYNC();
        f32x16 o[2];
#pragma unroll
        for (int tt = 0; tt < 2; ++tt)
#pragma unroll
            for (int i = 0; i < 16; ++i) o[tt][i] = 0.f;
        const LAS unsigned char* va = lds + GC_V + (8 * hh + (i16 >> 2)) * GC_VP + (wave * 32 + 16 * gi + 4 * (i16 & 3)) * 2;
#pragma unroll
        for (int ks = 0; ks < 4; ++ks) {
            const bf16x8 af = cat8(tr_read(va + 16 * ks * GC_VP), tr_read(va + (16 * ks + 4) * GC_VP));
            if (ks < 2) { const bf16x8 b0 = *(const LAS bf16x8*)(lds + GC_P + l31 * GC_PP + (16 * ks + 8 * hh) * 2); o[0] = MFMA32(af, b0, o[0]); }
            const bf16x8 b1 = *(const LAS bf16x8*)(lds + GC_P + (32 + l31) * GC_PP + (16 * ks + 8 * hh) * 2); o[1] = MFMA32(af, b1, o[1]);
        }
        const bf16* sin = mb.gS + (((size_t)bh * (SEQ / 64) + c) * 256 + wave * 32 + l31) * 128 + 8 * hh;
#pragma unroll
        for (int ks = 0; ks < 8; ++ks) { const bf16x8 af = *(const bf16x8*)(sin + 16 * ks);
#pragma unroll
            for (int tt = 0; tt < 2; ++tt) { const bf16x8 bfr = *(const LAS bf16x8*)(lds + GC_QT + (tt * 32 + l31) * GC_QKP + (16 * ks + 8 * hh) * 2); o[tt] = MFMA32(af, bfr, o[tt]); } }
#pragma unroll
        for (int tt = 0; tt < 2; ++tt) { float q = 0.f;
#pragma unroll
            for (int i = 0; i < 16; ++i) q += o[tt][i] * o[tt][i];
            q += __shfl_xor(q, 32);
            if (hh == 0) ((LAS float*)(lds + GC_SSQ))[wave * 64 + tt * 32 + l31] = q;
#pragma unroll
            for (int r4 = 0; r4 < 4; ++r4) { u32x2 w; w.x = cvt2(o[tt][4 * r4], o[tt][4 * r4 + 1]); w.y = cvt2(o[tt][4 * r4 + 2], o[tt][4 * r4 + 3]);
                *(LAS u32x2*)(lds + GC_O + (tt * 32 + l31) * GC_OP + (wave * 32 + 8 * r4 + 4 * hh) * 2) = w; } }
        WG_SYNC();
#pragma unroll
        for (int j = 0; j < 4; ++j) { const int id = tid + 512 * j, t = id >> 5, ch = id & 31;
            const LAS float* sq = (const LAS float*)(lds + GC_SSQ) + t; float ss = 0.f;
#pragma unroll
            for (int w = 0; w < 8; ++w) ss += sq[w * 64];
            const float rs = 1.0f / sqrtf(ss * (1.0f / 256.0f) + RMS_EPS);
            const u32x4 ov = *(const LAS u32x4*)(lds + GC_O + t * GC_OP + ch * 16);
            const u32x4 rv = *(const u32x4*)(prow + (size_t)t * PROJ_LD + PC_R + h * 256 + ch * 8);
            const f32x4 g0 = *(const f32x4*)(norm_g + ch * 8), g1 = *(const f32x4*)(norm_g + ch * 8 + 4);
            u32x4 w;
            w.x = cvt2(bf_lo(ov.x) * rs * g0[0] * silu_f(bf_lo(rv.x)), bf_hi(ov.x) * rs * g0[1] * silu_f(bf_hi(rv.x)));
            w.y = cvt2(bf_lo(ov.y) * rs * g0[2] * silu_f(bf_lo(rv.y)), bf_hi(ov.y) * rs * g0[3] * silu_f(bf_hi(rv.y)));
            w.z = cvt2(bf_lo(ov.z) * rs * g1[0] * silu_f(bf_lo(rv.z)), bf_hi(ov.z) * rs * g1[1] * silu_f(bf_hi(rv.z)));
            w.w = cvt2(bf_lo(ov.w) * rs * g1[2] * silu_f(bf_lo(rv.w)), bf_hi(ov.w) * rs * g1[3] * silu_f(bf_hi(rv.w)));
            *(u32x4*)(mb.oy + (row0 + t) * D_MIX + h * 256 + ch * 8) = w; }
        WG_SYNC();
    }
}

constexpr int SD_DT = 0, SD_AC = 2048, SD_XS = 4096, SD_XP = 1088, SD_BM = SD_XS + 64 * SD_XP, SD_BP_TR = 192, SD_BP = 144, SD_CM = SD_BM + 64 * SD_BP_TR, SD_Y = SD_CM + 64 * SD_BP, SD_YP = 1040, SD_STP = 144;
static_assert(SD_Y + 64 * SD_YP <= 159 * 1024, "SSD LDS");
DI float ssd_dt_scan(LAS unsigned char* lds, const float* dtraw_rows, const float* dt_bias, const float* a_log, int g, int wave, int lane) {
    const int hd = g * 8 + wave;
    const float x = dtraw_rows[lane * 16 + hd] + dt_bias[hd];
    const float dtv = x > 0.f ? x + __logf(1.0f + __expf(-x)) : __logf(1.0f + __expf(x));
    float a = dtv * -__expf(a_log[hd]);
#pragma unroll
    for (int o = 1; o < 64; o <<= 1) { const float v = __shfl_up(a, o); if (lane >= o) a += v; }
    ((LAS float*)(lds + SD_DT))[lane * 8 + wave] = dtv; ((LAS float*)(lds + SD_AC))[lane * 8 + wave] = a;
    return __shfl(a, 63);
}
template <int MODE> DI void ssd_conv_wu(LAS unsigned char* lds, const bf16* prow, const float* cw, const float* cb, int g, int c, int oc, int t0) {
    using namespace cfg;
    const int xch = oc < 64 ? g * 512 + oc * 8 : oc < 72 ? 1024 + g * 64 + (oc - 64) * 8 : 1152 + g * 64 + (oc - 72) * 8;
    float w[4][8], bias[8];
#pragma unroll
    for (int k = 0; k < 4; ++k) { const f32x4 a = *(const f32x4*)(cw + k * SSD_CONV_DIM + xch), b = *(const f32x4*)(cw + k * SSD_CONV_DIM + xch + 4);
        w[k][0] = a[0]; w[k][1] = a[1]; w[k][2] = a[2]; w[k][3] = a[3]; w[k][4] = b[0]; w[k][5] = b[1]; w[k][6] = b[2]; w[k][7] = b[3]; }
    { const f32x4 a = *(const f32x4*)(cb + xch), b = *(const f32x4*)(cb + xch + 4); bias[0] = a[0]; bias[1] = a[1]; bias[2] = a[2]; bias[3] = a[3]; bias[4] = b[0]; bias[5] = b[1]; bias[6] = b[2]; bias[7] = b[3]; }
    u32x4 xin[11];
#pragma unroll
    for (int i = 0; i < 11; ++i) { const int t = t0 - 3 + i; xin[i] = (c == 0 && t < 0) ? (u32x4){0u, 0u, 0u, 0u} : *(const u32x4*)(prow + (long)t * PROJ_LD + PC_XBC + xch); }
#pragma unroll
    for (int i = 0; i < 8; ++i) {
        float y[8];
#pragma unroll
        for (int j = 0; j < 8; ++j) y[j] = bias[j];
#pragma unroll
        for (int k = 0; k < 4; ++k) { const u32x4 v = xin[i + k];
            y[0] += w[k][0] * bf_lo(v.x); y[1] += w[k][1] * bf_hi(v.x); y[2] += w[k][2] * bf_lo(v.y); y[3] += w[k][3] * bf_hi(v.y);
            y[4] += w[k][4] * bf_lo(v.z); y[5] += w[k][5] * bf_hi(v.z); y[6] += w[k][6] * bf_lo(v.w); y[7] += w[k][7] * bf_hi(v.w); }
        const int t = t0 + i; float sc = 1.f;
        if (MODE == 0 && oc < 64) sc = ((const LAS float*)(lds + SD_DT))[t * 8 + (oc >> 3)];
#pragma unroll
        for (int j = 0; j < 8; ++j) y[j] = silu_f(y[j]) * sc;
        u32x4 o; o.x = cvt2(y[0], y[1]); o.y = cvt2(y[2], y[3]); o.z = cvt2(y[4], y[5]); o.w = cvt2(y[6], y[7]);
        if (oc < 64) *(LAS u32x4*)(lds + SD_XS + t * SD_XP + oc * 16) = o;
        else if (oc < 72) *(LAS u32x4*)(lds + SD_BM + t * (MODE == 0 ? SD_BP_TR : SD_BP) + (oc - 64) * 16) = o;
        else *(LAS u32x4*)(lds + SD_CM + t * SD_BP + (oc - 72) * 16) = o;
    }
}
DI void ssd_a_phase(LAS unsigned char* lds, const MixBufs& mb, const float* cw, const float* cb, const float* dt_bias, const float* a_log, int G, int bx, int tid) {
    using namespace cfg;
    const int lane = tid & 63, wave = tid >> 6, i16 = lane & 15, gi = (lane >> 4) & 1, hh = lane >> 5, l31 = lane & 31;
    const int nitem = mb.nbatch * SSD_GROUPS * (SEQ / 64);
    for (int it = bx; it < nitem; it += G) {
        const int bg = it / (SEQ / 64), c = it % (SEQ / 64), bl = bg / SSD_GROUPS, g = bg % SSD_GROUPS;
        const size_t row0 = (size_t)bl * SEQ + (size_t)c * 64;
        const bf16* prow = mb.proj + row0 * PROJ_LD;
        const float alast = ssd_dt_scan(lds, mb.dtraw + row0 * 16, dt_bias, a_log, g, wave, lane);
        { LAS float* dtp = (LAS float*)(lds + SD_DT) + lane * 8 + wave; const float ac = ((LAS float*)(lds + SD_AC))[lane * 8 + wave]; *dtp = *dtp * __expf(alast - ac); }
        if (lane == 0) mb.sdec[((size_t)bl * SSD_HEADS + g * 8 + wave) * (SEQ / 64) + c] = __expf(alast);
        WG_SYNC();
        for (int wu = tid; wu < 72 * 8; wu += NTHR) ssd_conv_wu<0>(lds, prow, cw, cb, g, c, wu % 72, (wu / 72) * 8);
        WG_SYNC();
        f32x16 acc[2][2];
#pragma unroll
        for (int a = 0; a < 2; ++a)
#pragma unroll
            for (int b = 0; b < 2; ++b)
#pragma unroll
                for (int i = 0; i < 16; ++i) acc[a][b][i] = 0.f;
        const LAS unsigned char* ba = lds + SD_BM + (8 * hh + (i16 >> 2)) * SD_BP_TR + (16 * gi + 4 * (i16 & 3)) * 2;
        const LAS unsigned char* xa = lds + SD_XS + (8 * hh + (i16 >> 2)) * SD_XP + (wave * 64 + 16 * gi + 4 * (i16 & 3)) * 2;
#pragma unroll
        for (int s = 0; s < 4; ++s) {
            bf16x8 af[2], bfr[2];
#pragma unroll
            for (int nt = 0; nt < 2; ++nt) af[nt] = cat8(tr_read(ba + 16 * s * SD_BP_TR + nt * 64), tr_read(ba + (16 * s + 4) * SD_BP_TR + nt * 64));
#pragma unroll
            for (int pt = 0; pt < 2; ++pt) bfr[pt] = cat8(tr_read(xa + 16 * s * SD_XP + pt * 64), tr_read(xa + (16 * s + 4) * SD_XP + pt * 64));
#pragma unroll
            for (int nt = 0; nt < 2; ++nt)
#pragma unroll
                for (int pt = 0; pt < 2; ++pt) acc[nt][pt] = MFMA32(af[nt], bfr[pt], acc[nt][pt]);
        }
        WG_SYNC();
#pragma unroll
        for (int nt = 0; nt < 2; ++nt)
#pragma unroll
            for (int pt = 0; pt < 2; ++pt)
#pragma unroll
                for (int r4 = 0; r4 < 4; ++r4) { u32x2 w; w.x = cvt2(acc[nt][pt][4 * r4], acc[nt][pt][4 * r4 + 1]); w.y = cvt2(acc[nt][pt][4 * r4 + 2], acc[nt][pt][4 * r4 + 3]);
                    *(LAS u32x2*)(lds + SD_XS + (wave * 64 + pt * 32 + l31) * SD_STP + (nt * 32 + 8 * r4 + 4 * hh) * 2) = w; }
        WG_SYNC();
#pragma unroll
        for (int j = 0; j < 8; ++j) { const int id = tid + 512 * j, hd = id >> 9, p = (id >> 3) & 63, ch = id & 7;
            *(u32x4*)(mb.sS + ((((size_t)bl * SSD_HEADS + g * 8 + hd) * (SEQ / 64) + c) * 64 + p) * 64 + ch * 8) = *(const LAS u32x4*)(lds + SD_XS + (hd * 64 + p) * SD_STP + ch * 16); }
        WG_SYNC();
    }
}
DI void ssd_b_phase(const MixBufs& mb, long gtid, long nthr) {
    using namespace cfg;
    const long total = (long)mb.nbatch * SSD_HEADS * 64 * 8;
    for (long i = gtid; i < total; i += nthr) {
        const int ng = (int)(i & 7), p = (int)((i >> 3) & 63), bh = (int)(i >> 9);
        bf16* sp = mb.sS + (size_t)bh * (SEQ / 64) * 4096 + p * 64 + ng * 8;
        const float* dp = mb.sdec + (size_t)bh * (SEQ / 64);
        float st[8];
#pragma unroll
        for (int k = 0; k < 8; ++k) st[k] = 0.f;
        for (int c0 = 0; c0 < SEQ / 64; c0 += 4) {
            u32x4 kv[4]; float dc[4];
#pragma unroll
            for (int u = 0; u < 4; ++u) { kv[u] = *(const u32x4*)(sp + (size_t)(c0 + u) * 4096); dc[u] = dp[c0 + u]; }
#pragma unroll
            for (int u = 0; u < 4; ++u) {
                u32x4 o; o.x = cvt2(st[0], st[1]); o.y = cvt2(st[2], st[3]); o.z = cvt2(st[4], st[5]); o.w = cvt2(st[6], st[7]);
                *(u32x4*)(sp + (size_t)(c0 + u) * 4096) = o;
                st[0] = dc[u] * st[0] + bf_lo(kv[u].x); st[1] = dc[u] * st[1] + bf_hi(kv[u].x); st[2] = dc[u] * st[2] + bf_lo(kv[u].y); st[3] = dc[u] * st[3] + bf_hi(kv[u].y);
                st[4] = dc[u] * st[4] + bf_lo(kv[u].z); st[5] = dc[u] * st[5] + bf_hi(kv[u].z); st[6] = dc[u] * st[6] + bf_lo(kv[u].w); st[7] = dc[u] * st[7] + bf_hi(kv[u].w);
            }
        }
    }
}
DI void ssd_c_phase(LAS unsigned char* lds, const MixBufs& mb, const float* cw, const float* cb, const float* dt_bias, const float* a_log, const float* dskip, const float* norm_g, int G, int bx, int tid) {
    using namespace cfg;
    const int lane = tid & 63, wave = tid >> 6, i16 = lane & 15, gi = (lane >> 4) & 1, hh = lane >> 5, l31 = lane & 31;
    const int nitem = mb.nbatch * SSD_GROUPS * (SEQ / 64);
    for (int it = bx; it < nitem; it += G) {
        const int bg = it / (SEQ / 64), c = it % (SEQ / 64), bl = bg / SSD_GROUPS, g = bg % SSD_GROUPS, hd = g * 8 + wave;
        const size_t row0 = (size_t)bl * SEQ + (size_t)c * 64;
        const bf16* prow = mb.proj + row0 * PROJ_LD;
        (void)ssd_dt_scan(lds, mb.dtraw + row0 * 16, dt_bias, a_log, g, wave, lane);
        for (int wu = tid; wu < 80 * 8; wu += NTHR) ssd_conv_wu<1>(lds, prow, cw, cb, g, c, wu % 80, (wu / 80) * 8);
        WG_SYNC();
        const LAS float* dtl = (const LAS float*)(lds + SD_DT); const LAS float* acl = (const LAS float*)(lds + SD_AC);
        f32x16 gt[3];
#pragma unroll
        for (int q = 0; q < 3; ++q) { const int st = q == 2 ? 1 : 0, tt = q == 0 ? 0 : 1;
#pragma unroll
            for (int i = 0; i < 16; ++i) gt[q][i] = 0.f;
#pragma unroll
            for (int ks = 0; ks < 4; ++ks) { const bf16x8 af = *(const LAS bf16x8*)(lds + SD_BM + (st * 32 + l31) * SD_BP + (16 * ks + 8 * hh) * 2);
                const bf16x8 bfr = *(const LAS bf16x8*)(lds + SD_CM + (tt * 32 + l31) * SD_BP + (16 * ks + 8 * hh) * 2); gt[q] = MFMA32(af, bfr, gt[q]); } }
        bf16x8 mf[3][2];
#pragma unroll
        for (int q = 0; q < 3; ++q) { const int st = q == 2 ? 1 : 0, tt = q == 0 ? 0 : 1; const int t = tt * 32 + l31; const float at = acl[t * 8 + wave];
            float e[16];
#pragma unroll
            for (int i = 0; i < 16; ++i) { const int s = st * 32 + (i & 3) + 8 * (i >> 2) + 4 * hh; e[i] = s <= t ? gt[q][i] * __expf(at - acl[s * 8 + wave]) * dtl[s * 8 + wave] : 0.f; }
#pragma unroll
            for (int s2 = 0; s2 < 2; ++s2) { u32x4 w; w.x = cvt2(e[8 * s2], e[8 * s2 + 1]); w.y = cvt2(e[8 * s2 + 2], e[8 * s2 + 3]); w.z = cvt2(e[8 * s2 + 4], e[8 * s2 + 5]); w.w = cvt2(e[8 * s2 + 6], e[8 * s2 + 7]); mf[q][s2] = __builtin_bit_cast(bf16x8, w); } }
        f32x16 yd[2][2], yo[2][2];
#pragma unroll
        for (int a = 0; a < 2; ++a)
#pragma unroll
            for (int b = 0; b < 2; ++b)
#pragma unroll
                for (int i = 0; i < 16; ++i) { yd[a][b][i] = 0.f; yo[a][b][i] = 0.f; }
        const LAS unsigned char* xa = lds + SD_XS + (4 * hh + (i16 >> 2)) * SD_XP + (wave * 64 + 16 * gi + 4 * (i16 & 3)) * 2;
#pragma unroll
        for (int pt = 0; pt < 2; ++pt)
#pragma unroll
            for (int st = 0; st < 2; ++st)
#pragma unroll
                for (int s2 = 0; s2 < 2; ++s2) { const LAS unsigned char* a = xa + (st * 32 + 16 * s2) * SD_XP + pt * 64; const bf16x8 xf = cat8(tr_read(a), tr_read(a + 8 * SD_XP));
                    if (st == 0) { yd[pt][0] = MFMA32(xf, mf[0][s2], yd[pt][0]); yd[pt][1] = MFMA32(xf, mf[1][s2], yd[pt][1]); }
                    else yd[pt][1] = MFMA32(xf, mf[2][s2], yd[pt][1]); }
        const bf16* hin = mb.sS + ((((size_t)bl * SSD_HEADS + hd) * (SEQ / 64) + c) * 64 + l31) * 64 + 8 * hh;
#pragma unroll
        for (int ks = 0; ks < 4; ++ks) { bf16x8 cf[2];
#pragma unroll
            for (int tt = 0; tt < 2; ++tt) cf[tt] = *(const LAS bf16x8*)(lds + SD_CM + (tt * 32 + l31) * SD_BP + (16 * ks + 8 * hh) * 2);
#pragma unroll
            for (int pt = 0; pt < 2; ++pt) { const bf16x8 hf = *(const bf16x8*)(hin + pt * 32 * 64 + 16 * ks);
#pragma unroll
                for (int tt = 0; tt < 2; ++tt) yo[pt][tt] = MFMA32(hf, cf[tt], yo[pt][tt]); } }
        const float dsk = dskip[hd];
#pragma unroll
        for (int tt = 0; tt < 2; ++tt) { const int t = tt * 32 + l31; const float ea = __expf(acl[t * 8 + wave]);
#pragma unroll
            for (int pt = 0; pt < 2; ++pt)
#pragma unroll
                for (int r4 = 0; r4 < 4; ++r4) { const int p = pt * 32 + 8 * r4 + 4 * hh; const u32x2 xv = *(const LAS u32x2*)(lds + SD_XS + t * SD_XP + (wave * 64 + p) * 2);
                    const float y0 = yd[pt][tt][4 * r4] + ea * yo[pt][tt][4 * r4] + dsk * bf_lo(xv.x), y1 = yd[pt][tt][4 * r4 + 1] + ea * yo[pt][tt][4 * r4 + 1] + dsk * bf_hi(xv.x);
                    const float y2 = yd[pt][tt][4 * r4 + 2] + ea * yo[pt][tt][4 * r4 + 2] + dsk * bf_lo(xv.y), y3 = yd[pt][tt][4 * r4 + 3] + ea * yo[pt][tt][4 * r4 + 3] + dsk * bf_hi(xv.y);
                    u32x2 w; w.x = cvt2(y0, y1); w.y = cvt2(y2, y3); *(LAS u32x2*)(lds + SD_Y + t * SD_YP + (wave * 64 + p) * 2) = w; } }
        WG_SYNC();
        { const int t = tid >> 3, sub = tid & 7; float u[8][8]; float ss = 0.f;
#pragma unroll
            for (int j = 0; j < 8; ++j) { const int ch = 8 * j + sub; const u32x4 yv = *(const LAS u32x4*)(lds + SD_Y + t * SD_YP + ch * 16);
                const u32x4 zv = *(const u32x4*)(prow + (size_t)t * PROJ_LD + PC_Z + g * 512 + ch * 8);
                u[j][0] = bf_lo(yv.x) * silu_f(bf_lo(zv.x)); u[j][1] = bf_hi(yv.x) * silu_f(bf_hi(zv.x)); u[j][2] = bf_lo(yv.y) * silu_f(bf_lo(zv.y)); u[j][3] = bf_hi(yv.y) * silu_f(bf_hi(zv.y));
                u[j][4] = bf_lo(yv.z) * silu_f(bf_lo(zv.z)); u[j][5] = bf_hi(yv.z) * silu_f(bf_hi(zv.z)); u[j][6] = bf_lo(yv.w) * silu_f(bf_lo(zv.w)); u[j][7] = bf_hi(yv.w) * silu_f(bf_hi(zv.w));
#pragma unroll
                for (int k = 0; k < 8; ++k) ss += u[j][k] * u[j][k]; }
            ss += __shfl_xor(ss, 1); ss += __shfl_xor(ss, 2); ss += __shfl_xor(ss, 4);
            const float rs = 1.0f / sqrtf(ss * (1.0f / 512.0f) + RMS_EPS);
#pragma unroll
            for (int j = 0; j < 8; ++j) { const int ch = 8 * j + sub; const float* ng = norm_g + g * 512 + ch * 8; const f32x4 g0 = *(const f32x4*)ng, g1 = *(const f32x4*)(ng + 4);
                u32x4 w; w.x = cvt2(u[j][0] * rs * g0[0], u[j][1] * rs * g0[1]); w.y = cvt2(u[j][2] * rs * g0[2], u[j][3] * rs * g0[3]);
                w.z = cvt2(u[j][4] * rs * g1[0], u[j][5] * rs * g1[1]); w.w = cvt2(u[j][6] * rs * g1[2], u[j][7] * rs * g1[3]);
                *(u32x4*)(mb.oy + (row0 + t) * D_MIX + GLA_DV + g * 512 + ch * 8) = w; } }
        WG_SYNC();
    }
}

using namespace cfg;
constexpr int RING_OFF = 0, LDSCTL_OFF = 159 * 1024, MISC_OFF = LDSCTL_OFF + 320, LDS_BYTES = 160 * 1024;
constexpr size_t MiB = 1u << 20;
constexpr size_t WS_CTL = 0, CTL_ZERO_BYTES = 1 * MiB;
constexpr int CW_BAR = 4096;
constexpr int HB = 2, MH = HB * SEQ;
constexpr size_t WS_PROJ = 1 * MiB;
constexpr size_t WS_GS = 177 * MiB, WS_GDEC = 241 * MiB, WS_SS = 242 * MiB, WS_SDEC = 274 * MiB, WS_GLOW = 275 * MiB, WS_DTRAW = 276 * MiB;
constexpr size_t WS_H1 = 1 * MiB, WS_QA = 65 * MiB, WS_H2 = 129 * MiB, WS_PICKS = 193 * MiB;
constexpr size_t WS_XB = 309 * MiB;
constexpr size_t WS_W = 376 * MiB;
constexpr int N1P = 5632;
constexpr size_t OW_IN = 0, OW_OUT = OW_IN + (size_t)N1P * 1024 * 2, OW_Q = OW_OUT + (size_t)1024 * 2048 * 2, OW_K = OW_Q + 2 * MiB, OW_V = OW_K + 2 * MiB, OW_O = OW_V + 2 * MiB, OW_PQ = OW_O + 2 * MiB, OW_END = OW_PQ + 2 * MiB;
static_assert(OW_END <= 28 * MiB, "weights region");
constexpr size_t WS_U = 404 * MiB, WS_V = 436 * MiB, WS_MEMB = 468 * MiB, WS_KC = 470 * MiB, WS_VC = 472 * MiB, WS_END = 474 * MiB;

__device__ __forceinline__ void p0_transpose_item(const float* W, int K, int N, bf16* WT, LAS float* scr, int item, int lane) {
    const int nblk = N / 32, kb = item / nblk, nb = item % nblk, k0 = 64 * kb, n0 = 32 * nb;
#pragma unroll 8
    for (int i = 0; i < 32; ++i) { const int kk = 2 * i + (lane >> 5); scr[kk * 33 + (lane & 31)] = W[(size_t)(k0 + kk) * N + n0 + (lane & 31)]; }
    LDS_WAIT(); asm volatile("" ::: "memory");
    const int c = lane & 7;
#pragma unroll
    for (int j = 0; j < 4; ++j) { const int n = (lane >> 3) + 8 * j; const LAS float* s = scr + (8 * c) * 33 + n;
        v4u o; o.x = pk2(s[0 * 33], s[1 * 33]); o.y = pk2(s[2 * 33], s[3 * 33]); o.z = pk2(s[4 * 33], s[5 * 33]); o.w = pk2(s[6 * 33], s[7 * 33]);
        *(GAS v4u*)(WT + (size_t)(n0 + n) * K + k0 + 8 * c) = o; }
    LDS_WAIT(); asm volatile("" ::: "memory");
}
__device__ __forceinline__ void cvt_rows(const float* src, bf16* dst, long n, long gtid, long nthr) {
    for (long i = gtid * 8; i < n; i += nthr * 8) { const f32x4 a = *(const f32x4*)(src + i), b = *(const f32x4*)(src + i + 4);
        v4u o; o.x = cvt2(a.x, a.y); o.y = cvt2(a.z, a.w); o.z = cvt2(b.x, b.y); o.w = cvt2(b.z, b.w); *(v4u*)(dst + i) = o; }
}
__device__ __forceinline__ void cvt_rows_ld(const float* src, bf16* dst, long n, long gtid, long nthr) { cvt_rows(src, dst, n, gtid, nthr); }

struct In27 { const float* p[27]; };
struct Args { In27 in; float* out; unsigned char* ws; };

__global__ void __launch_bounds__(NTHR, 2) mega(Args args) {
    extern __shared__ __attribute__((aligned(16))) unsigned char lds_raw[];
    LAS unsigned char* lds = (LAS unsigned char*)lds_raw;
    volatile LAS unsigned* MISC = (volatile LAS unsigned*)(lds + MISC_OFF);
    const int tid = threadIdx.x, lane = tid & 63, wave = __builtin_amdgcn_readfirstlane(tid >> 6);
    const int G = gridDim.x; const int bx = blockIdx.x; const int vcu = (G % 8 == 0) ? (bx % 8) * (G / 8) + bx / 8 : bx;
    unsigned char* ws = args.ws;
    gu32* ctl = (gu32*)(ws + WS_CTL);
    for (int u = tid; u < (LDS_BYTES - LDSCTL_OFF) / 4; u += NTHR) ((LAS unsigned*)(lds + LDSCTL_OFF))[u] = 0u;
    __syncthreads();
    XcdBarrier bar = xcd_barrier_post((unsigned*)(ctl + CW_BAR), MISC + 8);
    const long nthr = (long)G * NTHR;
    const int gw = vcu * NWAVES + wave, NGW = G * NWAVES;
    unsigned char* wbase = ws + WS_W;
    bf16* w_in_t = (bf16*)(wbase + OW_IN); bf16* w_out_t = (bf16*)(wbase + OW_OUT); bf16* wq_t = (bf16*)(wbase + OW_Q); bf16* wk_t = (bf16*)(wbase + OW_K);
    bf16* wv_t = (bf16*)(wbase + OW_V); bf16* wo_t = (bf16*)(wbase + OW_O); bf16* pwq_t = (bf16*)(wbase + OW_PQ);
    bf16* x_bf = (bf16*)(ws + WS_XB); bf16* u_bf = (bf16*)(ws + WS_U); bf16* v_bf = (bf16*)(ws + WS_V); bf16* mem_bf = (bf16*)(ws + WS_MEMB);
    bf16* kc = (bf16*)(ws + WS_KC); bf16* vc = (bf16*)(ws + WS_VC);
    bf16* h1 = (bf16*)(ws + WS_H1); bf16* qa = (bf16*)(ws + WS_QA); bf16* h2 = (bf16*)(ws + WS_H2); unsigned* picks = (unsigned*)(ws + WS_PICKS);
    bf16* oy_all = (bf16*)args.out;
    bf16* projb = (bf16*)(ws + WS_PROJ);

#define GRID_BAR() xcd_barrier(bar)
    {
        const long gtid = (long)bx * NTHR + tid;
        LAS float* scr = (LAS float*)(lds + RING_OFF + wave * 16384);
        constexpr int I_IN = (D_MODEL / 64) * (D_IN_PROJ / 32), I_OUT = (D_MIX / 64) * (D_MODEL / 32), I_SQ = (D_MODEL / 64) * (D_MODEL / 32);
        constexpr int NITEMS = I_IN + I_OUT + 5 * I_SQ;
        for (int it = gw; it < NITEMS; it += NGW) {
            int r = it; const float* W; int K = D_MODEL, N = D_MODEL; bf16* WT;
            if (r < I_IN) { W = args.in.p[2]; N = D_IN_PROJ; WT = w_in_t; }
            else if ((r -= I_IN) < I_OUT) { W = args.in.p[12]; K = D_MIX; WT = w_out_t; }
            else { r -= I_OUT; const int which = r / I_SQ; r -= which * I_SQ; const int idx = which == 0 ? 15 : which == 1 ? 16 : which == 2 ? 17 : which == 3 ? 18 : 21; W = args.in.p[idx]; WT = wq_t + (size_t)which * D_MODEL * D_MODEL; }
            p0_transpose_item(W, K, N, WT, scr, r, lane);
        }
        for (long i = gtid * 8; i < (long)(N1P - D_IN_PROJ) * D_MODEL; i += nthr * 8) *(v4u*)(w_in_t + (size_t)D_IN_PROJ * D_MODEL + i) = (v4u){0u, 0u, 0u, 0u};
        cvt_rows(args.in.p[23], u_bf, (long)PEER_EXPERTS * D_MODEL, gtid, nthr);
        cvt_rows(args.in.p[24], v_bf, (long)PEER_EXPERTS * D_MODEL, gtid, nthr);
        cvt_rows(args.in.p[1], mem_bf, (long)BATCH * MEM_LEN * D_MODEL, gtid, nthr);
        cvt_rows(args.in.p[0], x_bf, (long)NTOK * D_MODEL, gtid, nthr);
        GRID_BAR();
    }
    for (int st = 0; st < 19; ++st) {
        int tid_ = threadIdx.x; asm volatile("" : "+v"(tid_));
        const long gtid = (long)bx * NTHR + tid_;
        int gk = -1; const int hf = st >> 2;
        if (st < 8) {
            MixBufs mb{projb, (const float*)(ws + WS_GLOW), (const float*)(ws + WS_DTRAW), (bf16*)(ws + WS_GS), (float*)(ws + WS_GDEC), (bf16*)(ws + WS_SS), (float*)(ws + WS_SDEC), oy_all + (size_t)hf * MH * D_MIX, HB};
            switch (st & 3) {
            case 0: gk = 0; break;
            case 1: ssd_a_phase(lds, mb, args.in.p[6], args.in.p[7], args.in.p[8], args.in.p[9], G, bx, tid_); gla_a_phase(lds, mb, args.in.p[3], args.in.p[4], G, bx, tid_); break;
            case 2: ssd_b_phase(mb, gtid, nthr); gla_b_phase(mb, gtid, nthr); break;
            default: ssd_c_phase(lds, mb, args.in.p[6], args.in.p[7], args.in.p[8], args.in.p[9], args.in.p[10], args.in.p[11], G, bx, tid_);
                     gla_c_phase(lds, mb, args.in.p[3], args.in.p[4], args.in.p[5], G, bx, tid_); break;
            }
        } else {
            switch (st) {
            case 8: gk = 1; break;
            case 9: ln_rows_bf16(h1, args.in.p[13], args.in.p[14], NTOK, gw, NGW, tid_ & 63); break;
            case 10: gk = 2; break;
            case 11: gk = 3; break;
            case 12: gk = 4; break;
            case 13: attn_phase(lds, qa, kc, vc, G, bx, tid_); break;
            case 14: gk = 5; break;
            case 15: ln_rows_bf16(h2, args.in.p[19], args.in.p[20], NTOK, gw, NGW, tid_ & 63); break;
            case 16: gk = 6; break;
            case 17: topk_phase(lds, qa, args.in.p[22], picks, G, bx, tid_); break;
            default: peer_phase(h2, picks, u_bf, v_bf, args.in.p[25], args.in.p[26], args.out, gw, NGW, tid_ & 63); break;
            }
        }
        if (gk >= 0) {
            const bf16* A; const bf16* Bt; int M = NTOK, N = D_MODEL, K = D_MODEL; pg8::EpiGen E{0, nullptr, D_MODEL, nullptr, nullptr, nullptr};
            switch (gk) {
            case 0: A = x_bf + (size_t)hf * MH * D_MODEL; Bt = w_in_t; M = MH; N = N1P; E.out = projb; E.ldc = N1P; E.side0 = (float*)(ws + WS_GLOW); E.side1 = (float*)(ws + WS_DTRAW); break;
            case 1: A = oy_all; Bt = w_out_t; K = D_MIX; E.mode = 1; E.out = h1; E.res = args.in.p[0]; break;
            case 2: A = h1; Bt = wq_t; E.out = qa; break;
            case 3: A = mem_bf; Bt = wk_t; M = BATCH * MEM_LEN; E.out = kc; break;
            case 4: A = mem_bf; Bt = wv_t; M = BATCH * MEM_LEN; E.out = vc; break;
            case 5: A = qa; Bt = wo_t; E.mode = 2; E.out = h2; E.res = h1; break;
            default: A = h2; Bt = pwq_t; E.out = qa; break;
            }
            pg8::Gemm g{(const pg8::bf16_t*)A, (const pg8::bf16_t*)Bt, M, N, K}; pg8::StaticOrder S; S.init(M, N, G, bx);
            pg8::gemm_phase<pg8::EpiGen, pg8::StaticOrder, true, true>(lds + RING_OFF, g, S, E);
        }
        GRID_BAR();
    }
}

extern "C" void kernel_launch(void* const* d_in, const int* in_sizes, int n_in, void* d_out, int out_size, void* d_ws, size_t ws_size, hipStream_t stream) {
    static int grid = 0;
    if (grid == 0) {
        int dev = 0, cus = 0, per_cu = 0;
        if (hipGetDevice(&dev) != hipSuccess || hipDeviceGetAttribute(&cus, hipDeviceAttributeMultiprocessorCount, dev) != hipSuccess) { fprintf(stderr, "kernel_launch: device query failed\n"); grid = -1; return; }
        if (hipFuncSetAttribute((const void*)mega, hipFuncAttributeMaxDynamicSharedMemorySize, LDS_BYTES) != hipSuccess) { fprintf(stderr, "kernel_launch: hipFuncSetAttribute failed\n"); grid = -1; return; }
        if (hipOccupancyMaxActiveBlocksPerMultiprocessor(&per_cu, (const void*)mega, NTHR, LDS_BYTES) != hipSuccess || per_cu < 1) fprintf(stderr, "kernel_launch: occupancy query says %d\n", per_cu);
        (void)hipGetLastError();
        if (ws_size < WS_END) { fprintf(stderr, "kernel_launch: workspace too small: ws %zu need %zu\n", ws_size, (size_t)WS_END); grid = -1; return; }
        grid = cus;
    }
    if (grid < 0) return;
    if (hipMemsetAsync((char*)d_ws + WS_CTL, 0, CTL_ZERO_BYTES, stream) != hipSuccess) { fprintf(stderr, "kernel_launch: memset failed\n"); return; }
    Args a{};
    for (int i = 0; i < 27; ++i) a.in.p[i] = (const float*)d_in[i];
    a.out = (float*)d_out; a.ws = (unsigned char*)d_ws;
    hipLaunchKernelGGL(mega, dim3(grid), dim3(NTHR), LDS_BYTES, stream, a);
}
```

```cpp
#include <hip/hip_runtime.h>
#include <cmath>
#include <cstdio>
#include <cstdint>
#define HD __device__ __forceinline__
namespace cfg {
#ifdef SMALL
constexpr int D_MODEL = 128, BATCH = 2, SEQ = 64, GLA_HEADS = 4, GLA_GATE_RANK = 4, SSD_HEADDIM = 16, SSD_GROUPS = 2, SSD_STATE = 16, SSD_CONV = 4,
              MEM_LEN = 16, MEM_HEADS = 2, PEER_HEADS = 2, PEER_N_KEYS = 16, PEER_KEY_DIM = 16, PEER_TOPK = 4;
#else
constexpr int D_MODEL = 1024, BATCH = 4, SEQ = 8192, GLA_HEADS = 4, GLA_GATE_RANK = 16, SSD_HEADDIM = 64, SSD_GROUPS = 2, SSD_STATE = 64, SSD_CONV = 4,
              MEM_LEN = 256, MEM_HEADS = 4, PEER_HEADS = 8, PEER_N_KEYS = 128, PEER_KEY_DIM = 128, PEER_TOPK = 16;
#endif
constexpr int D_MIX = 2 * D_MODEL, GLA_DV = D_MIX / 2, GLA_DK = GLA_DV / 2, GLA_HEAD_K = GLA_DK / GLA_HEADS, GLA_HEAD_V = GLA_DV / GLA_HEADS;
constexpr float GLA_GATE_TAU = 16.0f;
constexpr int SSD_DINNER = D_MIX - GLA_DV, SSD_HEADS = SSD_DINNER / SSD_HEADDIM, SSD_HPG = SSD_HEADS / SSD_GROUPS, SSD_CONV_DIM = SSD_DINNER + 2 * SSD_GROUPS * SSD_STATE;
constexpr int D_IN_PROJ = GLA_DK * 2 + GLA_DV * 2 + GLA_GATE_RANK + SSD_DINNER + SSD_CONV_DIM + SSD_HEADS;
constexpr int MEM_HEAD_DIM = D_MODEL / MEM_HEADS, PEER_EXPERTS = PEER_N_KEYS * PEER_N_KEYS, PEER_HALF = PEER_KEY_DIM / 2;
constexpr float ALPHA = 1.189207115002721f;
constexpr float LN_EPS = 1e-5f, RMS_EPS = 1e-6f;
constexpr int NTOK = BATCH * SEQ;
}
namespace pg8 {
#define PG8_LAS __attribute__((address_space(3)))
typedef unsigned short bf16_t;
typedef short bf16x8 __attribute__((ext_vector_type(8)));
typedef float f32x4 __attribute__((ext_vector_type(4)));
typedef unsigned u32x4 __attribute__((ext_vector_type(4)));
constexpr int BM = 256, BK = 64, HALF = 128, HTB = HALF * BK * 2  , STAGE_BYTES = 8 * HTB, NXCD = 8, WGM = 8;

__host__ __device__ __forceinline__ int lds_byte(int r, int c) { const int st = (r >> 4) * 2 + (c >> 5), rr = r & 15, cc = c & 31, ob = rr * 64 + cc * 2; return st * 1024 + (ob ^ (((ob >> 9) & 1) << 5)); }
__host__ __device__ __forceinline__ void stage_rc(int b, int& R, int& C) { const int st = b / 1024, sb = b % 1024, swz = sb ^ (((sb >> 9) & 1) << 5); R = (st >> 1) * 16 + swz / 64; C = (st & 1) * 32 + (swz % 64) / 2; }
__host__ __device__ __forceinline__ int perm32(int rho) { const int n = rho >> 4, i = rho & 15; return 8 * (i >> 2) + 4 * n + (i & 3); }

struct Unit { int pm, pn; };
struct Gemm { const bf16_t* A; const bf16_t* Bt; int M, N, K; };

struct StaticOrder {
    int nM, nN, nwg, G, c;
    __host__ __device__ void init(int M, int N, int G_, int c_) { nM = M / BM; nN = N / BM; nwg = nM * nN; G = G_; c = c_; }
    __host__ __device__ bool next(int i, Unit& u) const {
        const long L = (long)i * G + c; if (L >= nwg) return false;
        int wgid = (int)L; { const int q = nwg / NXCD, r = nwg % NXCD, xcd = wgid % NXCD, off = wgid / NXCD; wgid = (xcd < r ? xcd * (q + 1) : r * (q + 1) + (xcd - r) * q) + off; }
        const int nig = WGM * nN, gid = wgid / nig, fm = gid * WGM, gsz = (nM - fm) < WGM ? (nM - fm) : WGM;
        u.pm = fm + ((wgid % nig) % gsz); u.pn = (wgid % nig) / gsz; return true;
    }
    __device__ __forceinline__ void a_ready(const Unit&) const {}
    __device__ __forceinline__ void done(const Unit&) const {}
};

__device__ __forceinline__ unsigned cvt_pk_bf16(float lo, float hi) { unsigned r; asm volatile("v_cvt_pk_bf16_f32 %0, %1, %2" : "=v"(r) : "v"(lo), "v"(hi)); return r; }
typedef float f32x2 __attribute__((ext_vector_type(2)));
struct EpiF32 {
    static constexpr bool PERM = false, AFTER_DRAIN = false;
    float* C; int ldc; int ncols;
    __device__ __forceinline__ void operator()(const f32x4 (&acc)[2][2][4][2], const Unit& u, int wr, int wc, int fr, int fq) const {
        const int row0 = u.pm * BM + wr * 64 + fr, col0 = u.pn * BM + wc * 32 + 4 * fq;
#pragma unroll
        for (int ai = 0; ai < 2; ++ai)
#pragma unroll
            for (int m = 0; m < 4; ++m) { float* rowp = C + (size_t)(row0 + ai * HALF + m * 16) * ldc + col0;
#pragma unroll
                for (int bj = 0; bj < 2; ++bj)
#pragma unroll
                    for (int n = 0; n < 2; ++n) if (col0 + bj * HALF + n * 16 < ncols) *(f32x4*)(rowp + bj * HALF + n * 16) = acc[ai][bj][m][n]; }
    }
};
template <class Epi, class Sched, bool ALIGN_EPI = false, bool SP2 = false>
__device__ __forceinline__ void gemm_phase(PG8_LAS unsigned char* lds, const Gemm g, const Sched& S, const Epi& E) {
    int tid_o = threadIdx.x; asm volatile("" : "+v"(tid_o));
    const int tid = tid_o, wid = __builtin_amdgcn_readfirstlane(tid >> 6), lane = tid & 63, wr = wid >> 2, wc = wid & 3, fr = lane & 15, fq = lane >> 4;
    const int K = g.K, nt = K / BK;
    unsigned voffA[2], voffB[2];
#pragma unroll
    for (int i = 0; i < 2; ++i) { int R, C; stage_rc(tid * 16 + i * 8192, R, C); const int Rb = Epi::PERM ? ((R & ~31) + perm32(R & 31)) : R;
        voffA[i] = (unsigned)(R * K + C) * 2u; voffB[i] = (unsigned)(Rb * K + C) * 2u; }
    const size_t kstep = (size_t)(BK * 2);
    const size_t hstep = (size_t)HALF * K * 2;
    const size_t tstep = 2 * hstep;
    const unsigned ldsw = (unsigned)wid * 1024u;
    const int aoff = lds_byte(wr * 64 + fr, fq * 8), boff = lds_byte(wc * 32 + fr, fq * 8);
#define PG8_SA(b, h) (((b) * 2 + (h)) * HTB)
#define PG8_SB(b, h) ((4 + (b) * 2 + (h)) * HTB)
#define PG8_STAGE(bufoff, gbase, voff) do { _Pragma("unroll") for (int _i = 0; _i < 2; ++_i) \
        __builtin_amdgcn_global_load_lds((const unsigned*)((const char*)(gbase) + (voff)[_i]), (PG8_LAS unsigned*)(lds + (bufoff) + ldsw + _i * 8192), 16, 0, 0); } while (0)
#define PG8_LDA(dst, b, h) do { _Pragma("unroll") for (int m = 0; m < 4; ++m) _Pragma("unroll") for (int k = 0; k < 2; ++k) dst[m][k] = *(const PG8_LAS bf16x8*)(lds + PG8_SA(b, h) + aoff + m * 2048 + k * 1024); } while (0)
#define PG8_LDB(dst, b, h) do { _Pragma("unroll") for (int n = 0; n < 2; ++n) _Pragma("unroll") for (int k = 0; k < 2; ++k) dst[n][k] = *(const PG8_LAS bf16x8*)(lds + PG8_SB(b, h) + boff + n * 2048 + k * 1024); } while (0)
#define PG8_MMA(ai, bj, At, Bt) do { __builtin_amdgcn_s_setprio(1); _Pragma("unroll") for (int m = 0; m < 4; ++m) _Pragma("unroll") for (int n = 0; n < 2; ++n) _Pragma("unroll") for (int k = 0; k < 2; ++k) \
        acc[ai][bj][m][n] = __builtin_amdgcn_mfma_f32_16x16x32_bf16(Bt[n][k], At[m][k], acc[ai][bj][m][n], 0, 0, 0); __builtin_amdgcn_s_setprio(0); } while (0)
#define PG8_WAIT_V(n) asm volatile("s_waitcnt vmcnt(" #n ")" ::: "memory")
#define PG8_WAIT_L(n) asm volatile("s_waitcnt lgkmcnt(" #n ")" ::: "memory")
#define PG8_BAR __builtin_amdgcn_s_barrier()
#define PG8_SCHED __builtin_amdgcn_sched_barrier(0)
    Unit cur, nxt; int ui = 0;
    if (!S.next(0, cur)) return;
    f32x4 acc[2][2][4][2];
#pragma unroll
    for (int a = 0; a < 2; ++a)
#pragma unroll
        for (int b = 0; b < 2; ++b)
#pragma unroll
            for (int m = 0; m < 4; ++m)
#pragma unroll
                for (int n = 0; n < 2; ++n) acc[a][b][m][n] = (f32x4){0.f, 0.f, 0.f, 0.f};
    bf16x8 At[4][2], B0[2][2], B1[2][2];
    const char* cA = (const char*)g.A + (size_t)cur.pm * tstep; const char* cB = (const char*)g.Bt + (size_t)cur.pn * tstep;
    S.a_ready(cur);
    if constexpr (SP2) {
        PG8_STAGE(PG8_SB(0, 0), cB, voffB); PG8_STAGE(PG8_SB(0, 1), cB + hstep, voffB); PG8_STAGE(PG8_SA(0, 0), cA, voffA); PG8_STAGE(PG8_SA(0, 1), cA + hstep, voffA);
        if (wr == 1) PG8_BAR;
        PG8_WAIT_V(2); PG8_BAR;
        PG8_STAGE(PG8_SB(1, 0), cB + kstep, voffB); PG8_STAGE(PG8_SA(1, 0), cA + kstep, voffA); PG8_STAGE(PG8_SB(1, 1), cB + hstep + kstep, voffB);
        PG8_WAIT_V(6); PG8_BAR;
    } else {
        PG8_STAGE(PG8_SB(0, 0), cB, voffB); PG8_STAGE(PG8_SA(0, 0), cA, voffA); PG8_STAGE(PG8_SB(0, 1), cB + hstep, voffB); PG8_STAGE(PG8_SA(0, 1), cA + hstep, voffA);
        if (wr == 1) PG8_BAR;
        PG8_WAIT_V(4); PG8_BAR;
        PG8_STAGE(PG8_SB(1, 0), cB + kstep, voffB); PG8_STAGE(PG8_SA(1, 0), cA + kstep, voffA); PG8_STAGE(PG8_SB(1, 1), cB + hstep + kstep, voffB);
        PG8_WAIT_V(6); PG8_BAR;
    }
    for (;;) {
        const bool has_next = S.next(ui + 1, nxt);
        const char* nA = has_next ? (const char*)g.A + (size_t)nxt.pm * tstep : cA; const char* nB = has_next ? (const char*)g.Bt + (size_t)nxt.pn * tstep : cB;
        for (int t = 0; t < nt; t += 2) {
            const bool last = (t == nt - 2);
            const char* a1 = cA + (size_t)(t + 1) * kstep;
            const char* a2 = last ? nA : cA + (size_t)(t + 2) * kstep; const char* b2 = last ? nB : cB + (size_t)(t + 2) * kstep;
            const char* a3 = a2 + kstep; const char* b3 = b2 + kstep;
            if (last && has_next) S.a_ready(nxt);
            if constexpr (SP2) {
            PG8_LDB(B0, 0, 0); PG8_LDB(B1, 0, 1); PG8_SCHED; PG8_LDA(At, 0, 0); PG8_STAGE(PG8_SA(1, 1), a1 + hstep, voffA);
            PG8_WAIT_V(8); PG8_WAIT_L(0); PG8_BAR; PG8_MMA(0, 0, At, B0); PG8_MMA(0, 1, At, B1); PG8_BAR; PG8_SCHED;
            PG8_LDA(At, 0, 1); PG8_STAGE(PG8_SB(0, 0), b2, voffB); PG8_STAGE(PG8_SB(0, 1), b2 + hstep, voffB); PG8_STAGE(PG8_SA(0, 0), a2, voffA);
            PG8_WAIT_V(8); PG8_WAIT_L(0); PG8_BAR; PG8_MMA(1, 0, At, B0); PG8_MMA(1, 1, At, B1); PG8_BAR; PG8_SCHED;
            PG8_LDB(B0, 1, 0); PG8_LDB(B1, 1, 1); PG8_SCHED; PG8_LDA(At, 1, 0); PG8_STAGE(PG8_SA(0, 1), a2 + hstep, voffA);
            PG8_WAIT_V(8); PG8_WAIT_L(0); PG8_BAR; PG8_MMA(0, 0, At, B0); PG8_MMA(0, 1, At, B1); PG8_BAR; PG8_SCHED;
            PG8_LDA(At, 1, 1); PG8_STAGE(PG8_SB(1, 0), b3, voffB); PG8_STAGE(PG8_SB(1, 1), b3 + hstep, voffB); PG8_STAGE(PG8_SA(1, 0), a3, voffA);
            PG8_WAIT_V(8); PG8_WAIT_L(0); PG8_BAR; PG8_MMA(1, 0, At, B0); PG8_MMA(1, 1, At, B1); PG8_BAR; PG8_SCHED;
            } else {
            PG8_LDB(B0, 0, 0); PG8_SCHED; PG8_LDA(At, 0, 0); PG8_STAGE(PG8_SA(1, 1), a1 + hstep, voffA);
            PG8_WAIT_L(8); PG8_BAR; PG8_WAIT_L(0); PG8_MMA(0, 0, At, B0); PG8_BAR; PG8_SCHED;
            PG8_LDB(B1, 0, 1); PG8_STAGE(PG8_SB(0, 0), b2, voffB);
            PG8_BAR; PG8_WAIT_L(0); PG8_MMA(0, 1, At, B1); PG8_BAR;
            PG8_LDA(At, 0, 1); PG8_STAGE(PG8_SA(0, 0), a2, voffA);
            PG8_BAR; PG8_WAIT_L(0); PG8_MMA(1, 0, At, B0); PG8_BAR; PG8_SCHED;
            PG8_STAGE(PG8_SB(0, 1), b2 + hstep, voffB);
            PG8_WAIT_V(6); PG8_BAR; PG8_MMA(1, 1, At, B1); PG8_BAR;
            PG8_LDB(B0, 1, 0); PG8_SCHED; PG8_LDA(At, 1, 0); PG8_STAGE(PG8_SA(0, 1), a2 + hstep, voffA);
            PG8_WAIT_L(8); PG8_BAR; PG8_WAIT_L(0); PG8_MMA(0, 0, At, B0); PG8_BAR; PG8_SCHED;
            PG8_LDB(B1, 1, 1); PG8_STAGE(PG8_SB(1, 0), b3, voffB);
            PG8_BAR; PG8_WAIT_L(0); PG8_MMA(0, 1, At, B1); PG8_BAR;
            PG8_LDA(At, 1, 1); PG8_STAGE(PG8_SA(1, 0), a3, voffA);
            PG8_BAR; PG8_WAIT_L(0); PG8_MMA(1, 0, At, B0); PG8_BAR; PG8_SCHED;
            PG8_STAGE(PG8_SB(1, 1), b3 + hstep, voffB);
            PG8_WAIT_V(6); PG8_BAR; PG8_MMA(1, 1, At, B1); PG8_BAR;
            }
        }
        if constexpr (ALIGN_EPI) { if (wr == 0) PG8_BAR; }
        if constexpr (!Epi::AFTER_DRAIN) { E(acc, cur, wr, wc, fr, fq); S.done(cur); }
        if (!has_next) break;
#pragma unroll
        for (int a = 0; a < 2; ++a)
#pragma unroll
            for (int b = 0; b < 2; ++b)
#pragma unroll
                for (int m = 0; m < 4; ++m)
#pragma unroll
                    for (int n = 0; n < 2; ++n) acc[a][b][m][n] = (f32x4){0.f, 0.f, 0.f, 0.f};
        cur = nxt; cA = nA; cB = nB; ++ui;
        if constexpr (ALIGN_EPI) { if (wr == 1) PG8_BAR; }
    }
    PG8_WAIT_V(0);
    if constexpr (!ALIGN_EPI) { if (wr == 0) PG8_BAR; }
    PG8_BAR;
    if constexpr (Epi::AFTER_DRAIN) { E.fused(acc, cur, wr, wc, fr, fq, lds, wid, lane); S.done(cur); }
#undef PG8_SA
#undef PG8_SB
#undef PG8_STAGE
#undef PG8_LDA
#undef PG8_LDB
#undef PG8_MMA
#undef PG8_WAIT_V
#undef PG8_WAIT_L
#undef PG8_BAR
#undef PG8_SCHED
}
}
#define GAS __attribute__((address_space(1)))
#define LAS __attribute__((address_space(3)))
typedef unsigned short bf16;
typedef unsigned v4u __attribute__((ext_vector_type(4)));
typedef float f32x4 __attribute__((ext_vector_type(4)));
typedef short bf16x8 __attribute__((ext_vector_type(8)));
typedef GAS unsigned gu32;
typedef GAS unsigned long long gu64;
#define RLX_AGENT __ATOMIC_RELAXED, __HIP_MEMORY_SCOPE_AGENT
#define LDS_WAIT() asm volatile("s_waitcnt lgkmcnt(0)" ::: "memory")
#define VM_WAIT() asm volatile("s_waitcnt vmcnt(0)" ::: "memory")
__device__ __forceinline__ unsigned long long rt() { return __builtin_amdgcn_s_memrealtime(); }
__device__ __forceinline__ unsigned f2bf(float f) { unsigned u = __builtin_bit_cast(unsigned, f); return (u + 0x7fffu + ((u >> 16) & 1u)) >> 16; }
__device__ __forceinline__ unsigned pk2(float lo, float hi) { return f2bf(lo) | (f2bf(hi) << 16); }
#define XB_TMO      128
#define XB_XCNT(j)  (256  + 64 * (j))
#define XB_XSUB(j)  (1280 + 64 * (j))
#define XB_XGEN(j)  (2304 + 64 * (j))
#define XB_TOP      3328
#define XB_TOPGEN   3392
#define XCD_BAR_WORDS 3456
#define XB_SPIN_CAP (1u << 27)

__device__ __forceinline__ unsigned xb_ld(unsigned* p)              { return __hip_atomic_load(p, __ATOMIC_RELAXED, __HIP_MEMORY_SCOPE_AGENT); }
__device__ __forceinline__ unsigned xb_add(unsigned* p, unsigned v) { return __hip_atomic_fetch_add(p, v, __ATOMIC_RELAXED, __HIP_MEMORY_SCOPE_AGENT); }
__device__ __forceinline__ unsigned xb_xcc_id() { return (unsigned)__builtin_amdgcn_s_getreg((3 << 11) | 20) & 0xFu; }
#define XB_SPIN(cond, bar) do { unsigned _sp = 0; while (cond) { __builtin_amdgcn_s_sleep(1); \
    if ((++_sp & 255u) == 0u) { if (xb_ld(&(bar)[XB_TMO])) break; if (_sp > XB_SPIN_CAP) { atomicAdd(&(bar)[XB_TMO], 1u); break; } } } } while (0)

struct XcdBarrier {
    unsigned* bar; unsigned x;
    volatile LAS unsigned* st;
};

__device__ __forceinline__ XcdBarrier xcd_barrier_post(unsigned* bar, volatile LAS unsigned* st) {
    XcdBarrier b; b.bar = bar; b.x = xb_xcc_id(); b.st = st;
    if (threadIdx.x == 0) (void)xb_add(&bar[XB_XCNT(b.x)], 1u);
    return b;
}
__device__ __forceinline__ void xcd_barrier_complete(unsigned* bar, unsigned x, unsigned& nloc, unsigned& nx) {
    const unsigned G = gridDim.x * gridDim.y * gridDim.z;
    unsigned sum, cnt, mine, sp = 0u;
    for (;;) {
        sum = 0u; cnt = 0u; mine = 0u;
#pragma unroll
        for (unsigned j = 0; j < 16; ++j) { const unsigned c = xb_ld(&bar[XB_XCNT(j)]); sum += c; cnt += (c > 0u) ? 1u : 0u; mine = (j == x) ? c : mine; }
        if (sum == G) break;
        __builtin_amdgcn_s_sleep(1);
        if ((++sp & 255u) == 0u) { if (xb_ld(&bar[XB_TMO])) break; if (sp > XB_SPIN_CAP) { atomicAdd(&bar[XB_TMO], 1u); break; } }
    }
    nloc = mine > 0u ? mine : 1u; nx = cnt > 0u ? cnt : 1u;
}

__device__ __forceinline__ void xcd_barrier(const XcdBarrier& b) {
    asm volatile("s_waitcnt vmcnt(0)" ::: "memory");
    __syncthreads();
    if (threadIdx.x == 0) {
        unsigned* bar = b.bar;
        __builtin_amdgcn_s_waitcnt(0);
        unsigned nloc = b.st[0], nx = b.st[1];
        if (nloc == 0u) { xcd_barrier_complete(bar, b.x, nloc, nx); b.st[0] = nloc; b.st[1] = nx; }
        const unsigned old = xb_add(&bar[XB_XSUB(b.x)], 1u);
        const unsigned gen = old / nloc;
        if (old + 1u == (gen + 1u) * nloc) {
            __builtin_amdgcn_fence(__ATOMIC_RELEASE, "agent");
            asm volatile("s_waitcnt vmcnt(0)" ::: "memory");
            const unsigned og = xb_add(&bar[XB_TOP], 1u);
            const unsigned tg = og / nx;
            if (og + 1u == (tg + 1u) * nx) xb_add(&bar[XB_TOPGEN], 1u);
            else XB_SPIN(xb_ld(&bar[XB_TOPGEN]) == tg, bar);
            __builtin_amdgcn_fence(__ATOMIC_ACQUIRE, "agent");
            xb_add(&bar[XB_XGEN(b.x)], 1u);
            asm volatile("s_waitcnt vmcnt(0)" ::: "memory");
        } else {
            XB_SPIN(xb_ld(&bar[XB_XGEN(b.x)]) == gen, bar);
            __builtin_amdgcn_fence(__ATOMIC_ACQUIRE, "agent");
            asm volatile("s_waitcnt vmcnt(0)" ::: "memory");
        }
    }
    __syncthreads();
}
typedef float f32x16 __attribute__((ext_vector_type(16)));
typedef short s16x4 __attribute__((ext_vector_type(4)));
typedef short v4i16_t __attribute__((ext_vector_type(4)));
typedef __bf16 bf2_t __attribute__((ext_vector_type(2)));
typedef float f32x2_t __attribute__((ext_vector_type(2)));
typedef unsigned u32x2 __attribute__((ext_vector_type(2)));
typedef unsigned u32x4 __attribute__((ext_vector_type(4)));
#define DI __device__ __forceinline__
constexpr int NWAVES = 8, NTHR = 512;
DI unsigned cvt2(float a, float b) { f32x2_t v = {a, b}; return __builtin_bit_cast(unsigned, __builtin_convertvector(v, bf2_t)); }
DI float bf_lo(unsigned u) { return __uint_as_float(u << 16); }
DI float bf_hi(unsigned u) { return __uint_as_float(u & 0xffff0000u); }
DI s16x4 tr_read(const LAS unsigned char* p) { return __builtin_bit_cast(s16x4, __builtin_amdgcn_ds_read_tr16_b64_v4i16((LAS v4i16_t*)p)); }
DI bf16x8 cat8(s16x4 a, s16x4 b) { bf16x8 r; r[0] = a[0]; r[1] = a[1]; r[2] = a[2]; r[3] = a[3]; r[4] = b[0]; r[5] = b[1]; r[6] = b[2]; r[7] = b[3]; return r; }
DI float wave_sum(float v) {
#pragma unroll
    for (int o = 1; o < 64; o <<= 1) v += __shfl_xor(v, o);
    return v;
}
#define MFMA32(a, b, c) __builtin_amdgcn_mfma_f32_32x32x16_bf16((a), (b), (c), 0, 0, 0)
#define WG_SYNC() __syncthreads()

namespace pg8 {
struct EpiGen {
    static constexpr bool PERM = true, AFTER_DRAIN = false;
    int mode; bf16_t* out; int ldc; const void* res; float* side0; float* side1;
    __device__ __forceinline__ void operator()(const f32x4 (&acc)[2][2][4][2], const Unit& u, int wr, int wc, int fr, int fq) const {
        const int row0 = u.pm * BM + wr * 64 + fr, col0 = u.pn * BM + wc * 32 + 8 * fq; const float alpha = cfg::ALPHA;
#pragma unroll
        for (int ai = 0; ai < 2; ++ai)
#pragma unroll
            for (int m = 0; m < 4; ++m) { const size_t row = (size_t)(row0 + ai * HALF + m * 16);
#pragma unroll
                for (int bj = 0; bj < 2; ++bj) { const int col = col0 + bj * HALF; f32x4 v0 = acc[ai][bj][m][0], v1 = acc[ai][bj][m][1];
                    if (mode == 1) { const float* r = (const float*)res + row * 1024 + col; const f32x4 r0 = *(const f32x4*)r, r1 = *(const f32x4*)(r + 4); v0 += alpha * r0; v1 += alpha * r1; }
                    else if (mode == 2) { const u32x4 r = *(const u32x4*)((const bf16_t*)res + row * 1024 + col);
                        v0[0] += alpha * bf_lo(r.x); v0[1] += alpha * bf_hi(r.x); v0[2] += alpha * bf_lo(r.y); v0[3] += alpha * bf_hi(r.y);
                        v1[0] += alpha * bf_lo(r.z); v1[1] += alpha * bf_hi(r.z); v1[2] += alpha * bf_lo(r.w); v1[3] += alpha * bf_hi(r.w); }
                    u32x4 w; w.x = cvt2(v0[0], v0[1]); w.y = cvt2(v0[2], v0[3]); w.z = cvt2(v1[0], v1[1]); w.w = cvt2(v1[2], v1[3]);
                    *(u32x4*)(out + row * ldc + col) = w;
                    if (side0 && bj == 0) { if (col == 3072 || col == 3080) { float* p = side0 + row * 16 + (col - 3072); *(f32x4*)p = v0; *(f32x4*)(p + 4) = v1; }
                                            if (col == 5392 || col == 5400) { float* p = side1 + row * 16 + (col - 5392); *(f32x4*)p = v0; *(f32x4*)(p + 4) = v1; } } }
                asm volatile("" ::: "memory"); }
    }
};
}

DI void ln_rows_bf16(bf16* buf, const float* g, const float* bt, int rows, int gw, int NGW, int lane) {
    for (int r = gw; r < rows; r += NGW) {
        bf16* p = buf + (size_t)r * 1024 + lane * 8;
        const u32x4 a = *(const u32x4*)p, b = *(const u32x4*)(p + 512);
        float v[16] = {bf_lo(a.x), bf_hi(a.x), bf_lo(a.y), bf_hi(a.y), bf_lo(a.z), bf_hi(a.z), bf_lo(a.w), bf_hi(a.w), bf_lo(b.x), bf_hi(b.x), bf_lo(b.y), bf_hi(b.y), bf_lo(b.z), bf_hi(b.z), bf_lo(b.w), bf_hi(b.w)};
        float s = 0.f;
#pragma unroll
        for (int i = 0; i < 16; ++i) s += v[i];
        const float mean = wave_sum(s) * (1.f / 1024.f); float q = 0.f;
#pragma unroll
        for (int i = 0; i < 16; ++i) { v[i] -= mean; q += v[i] * v[i]; }
        const float rstd = 1.0f / sqrtf(wave_sum(q) * (1.f / 1024.f) + cfg::LN_EPS);
        const f32x4 g0 = *(const f32x4*)(g + lane * 8), g1 = *(const f32x4*)(g + lane * 8 + 4), g2 = *(const f32x4*)(g + 512 + lane * 8), g3 = *(const f32x4*)(g + 512 + lane * 8 + 4);
        const f32x4 b0 = *(const f32x4*)(bt + lane * 8), b1 = *(const f32x4*)(bt + lane * 8 + 4), b2 = *(const f32x4*)(bt + 512 + lane * 8), b3 = *(const f32x4*)(bt + 512 + lane * 8 + 4);
        u32x4 oa, ob;
        oa.x = cvt2(v[0] * rstd * g0[0] + b0[0], v[1] * rstd * g0[1] + b0[1]); oa.y = cvt2(v[2] * rstd * g0[2] + b0[2], v[3] * rstd * g0[3] + b0[3]);
        oa.z = cvt2(v[4] * rstd * g1[0] + b1[0], v[5] * rstd * g1[1] + b1[1]); oa.w = cvt2(v[6] * rstd * g1[2] + b1[2], v[7] * rstd * g1[3] + b1[3]);
        ob.x = cvt2(v[8] * rstd * g2[0] + b2[0], v[9] * rstd * g2[1] + b2[1]); ob.y = cvt2(v[10] * rstd * g2[2] + b2[2], v[11] * rstd * g2[3] + b2[3]);
        ob.z = cvt2(v[12] * rstd * g3[0] + b3[0], v[13] * rstd * g3[1] + b3[1]); ob.w = cvt2(v[14] * rstd * g3[2] + b3[2], v[15] * rstd * g3[3] + b3[3]);
        *(u32x4*)p = oa; *(u32x4*)(p + 512) = ob;
    }
}

constexpr int ATT_KP = 528, ATT_VP = 576;
DI void attn_phase(LAS unsigned char* lds, bf16* QO, const bf16* Kc, const bf16* Vc, int G, int bx, int tid) {
    using namespace cfg;
    const int wave = tid >> 6;
    constexpr int NU = (NTOK / 256) * MEM_HEADS;
    for (int u = bx; u < NU; u += G) {
        int lane = tid & 63; asm volatile("" : "+v"(lane));
        const int q = lane & 31, h = lane >> 5;
        const int bh = u / (SEQ / 256), qb = u % (SEQ / 256), b = bh / MEM_HEADS, hd = bh % MEM_HEADS;
        const bf16* Kg = Kc + (size_t)(b * MEM_LEN) * D_MODEL + hd * MEM_HEAD_DIM;
        const bf16* Vg = Vc + (size_t)(b * MEM_LEN) * D_MODEL + hd * MEM_HEAD_DIM;
        bf16* Qg = QO + ((size_t)b * SEQ + (size_t)qb * 256 + wave * 32 + q) * D_MODEL + hd * MEM_HEAD_DIM;
        WG_SYNC();
#pragma unroll 4
        for (int p = 0; p < 16; ++p) { const int key = p * 16 + (tid >> 5), ch = tid & 31;
            const u32x4 v = *(const u32x4*)(Kg + (size_t)key * D_MODEL + ch * 8); *(LAS u32x4*)(lds + key * ATT_KP + ch * 16) = v; }
        bf16x8 qf[16];
#pragma unroll
        for (int s = 0; s < 16; ++s) qf[s] = *(const bf16x8*)(Qg + 16 * s + 8 * h);
        WG_SYNC();
        f32x16 sc[8];
#pragma unroll
        for (int kt = 0; kt < 8; ++kt) {
#pragma unroll
            for (int i = 0; i < 16; ++i) sc[kt][i] = 0.f;
#pragma unroll
            for (int s = 0; s < 16; ++s) { const bf16x8 kf = *(const LAS bf16x8*)(lds + (kt * 32 + q) * ATT_KP + (16 * s + 8 * h) * 2); sc[kt] = MFMA32(kf, qf[s], sc[kt]); }
        }
        float m = sc[0][0];
#pragma unroll
        for (int kt = 0; kt < 8; ++kt)
#pragma unroll
            for (int i = 0; i < 16; ++i) m = fmaxf(m, sc[kt][i]);
        m = fmaxf(m, __shfl_xor(m, 32));
        const float c = 0.0625f * 1.44269504088896f; float l = 0.f; const float mc = m * c;
        bf16x8 pf[8][2];
#pragma unroll
        for (int kt = 0; kt < 8; ++kt) {
            float e[16];
#pragma unroll
            for (int i = 0; i < 16; ++i) { e[i] = __builtin_amdgcn_exp2f(sc[kt][i] * c - mc); l += e[i]; }
#pragma unroll
            for (int s = 0; s < 2; ++s) { u32x4 w; w.x = cvt2(e[8 * s], e[8 * s + 1]); w.y = cvt2(e[8 * s + 2], e[8 * s + 3]); w.z = cvt2(e[8 * s + 4], e[8 * s + 5]); w.w = cvt2(e[8 * s + 6], e[8 * s + 7]); pf[kt][s] = __builtin_bit_cast(bf16x8, w); }
        }
        l += __shfl_xor(l, 32);
        const float inv = 1.0f / l;
        WG_SYNC();
#pragma unroll 4
        for (int p = 0; p < 16; ++p) { const int key = p * 16 + (tid >> 5), ch = tid & 31;
            const u32x4 v = *(const u32x4*)(Vg + (size_t)key * D_MODEL + ch * 8); *(LAS u32x4*)(lds + key * ATT_VP + ch * 16) = v; }
        WG_SYNC();
        const int gi = (lane >> 4) & 1, i16 = lane & 15;
        const LAS unsigned char* vb = lds + (4 * h + (i16 >> 2)) * ATT_VP + (16 * gi + 4 * (i16 & 3)) * 2;
#pragma unroll
        for (int et = 0; et < 8; ++et) {
            f32x16 o;
#pragma unroll
            for (int i = 0; i < 16; ++i) o[i] = 0.f;
#pragma unroll
            for (int kt = 0; kt < 8; ++kt)
#pragma unroll
                for (int s = 0; s < 2; ++s) { const LAS unsigned char* a = vb + (kt * 32 + 16 * s) * ATT_VP + et * 64;
                    const bf16x8 vf = cat8(tr_read(a), tr_read(a + 8 * ATT_VP)); o = MFMA32(vf, pf[kt][s], o); }
#pragma unroll
            for (int r4 = 0; r4 < 4; ++r4) { u32x2 w; w.x = cvt2(o[4 * r4] * inv, o[4 * r4 + 1] * inv); w.y = cvt2(o[4 * r4 + 2] * inv, o[4 * r4 + 3] * inv);
                *(u32x2*)(Qg + et * 32 + 8 * r4 + 4 * h) = w; }
        }
    }
    WG_SYNC();
}

DI int f2key(float s) { int k = __float_as_int(s); return k ^ ((k >> 31) & 0x7fffffff); }
DI float key2f(int k) { return __int_as_float(k ^ ((k >> 31) & 0x7fffffff)); }
#define CE_DESC(a, b) do { const int _hi = max((a), (b)), _lo = min((a), (b)); (a) = _hi; (b) = _lo; } while (0)
DI void sort16_desc(int (&t)[16]) {
#pragma unroll
    for (int k = 2; k <= 16; k <<= 1)
#pragma unroll
        for (int j = k >> 1; j > 0; j >>= 1)
#pragma unroll
            for (int i = 0; i < 16; ++i) { const int l = i ^ j; if (l > i) { if ((i & k) == 0) CE_DESC(t[i], t[l]); else CE_DESC(t[l], t[i]); } }
}
DI void merge16_desc(int (&a)[16], const int (&b)[16]) {
#pragma unroll
    for (int i = 0; i < 16; ++i) a[i] = max(a[i], b[15 - i]);
#pragma unroll
    for (int j = 8; j > 0; j >>= 1)
#pragma unroll
        for (int i = 0; i < 16; ++i) { const int l = i ^ j; if (l > i) CE_DESC(a[i], a[l]); }
}
constexpr int TK_KP = 144;
DI void topk_phase(LAS unsigned char* lds, const bf16* PQ, const float* keys, unsigned* picks, bf16* eid16, int G, int bx, int tid) {
    using namespace cfg;
    const int lane = tid & 63, wave = tid >> 6, q = lane & 31, h = lane >> 5;
    for (int i = tid; i < 2 * PEER_N_KEYS * PEER_HALF / 2; i += NTHR) { const int row = i / (PEER_HALF / 2), c2 = i % (PEER_HALF / 2);
        const float a = keys[row * PEER_HALF + 2 * c2], b = keys[row * PEER_HALF + 2 * c2 + 1]; *(LAS unsigned*)(lds + row * TK_KP + c2 * 4) = cvt2(a, b); }
    LAS unsigned* lut = (LAS unsigned*)(lds + 40960) + (wave * 64 + lane) * 33;
    WG_SYNC();
    constexpr int NTASK = (NTOK / 32) * PEER_HEADS;
    for (int task = bx * NWAVES + wave; task < NTASK; task += G * NWAVES) {
        const int tb = task / PEER_HEADS, hd = task % PEER_HEADS;
        const bf16* qg = PQ + (size_t)(tb * 32 + q) * D_MODEL + hd * PEER_KEY_DIM;
        int top[2][16];
#pragma unroll
        for (int p = 0; p < 2; ++p) {
            bf16x8 qf[4];
#pragma unroll
            for (int s = 0; s < 4; ++s) qf[s] = *(const bf16x8*)(qg + p * PEER_HALF + 16 * s + 8 * h);
            int grp[4][16];
#pragma unroll
            for (int kt = 0; kt < 4; ++kt) {
                f32x16 sc;
#pragma unroll
                for (int i = 0; i < 16; ++i) sc[i] = 0.f;
#pragma unroll
                for (int s = 0; s < 4; ++s) { const bf16x8 kf = *(const LAS bf16x8*)(lds + (p * PEER_N_KEYS + kt * 32 + q) * TK_KP + (16 * s + 8 * h) * 2); sc = MFMA32(kf, qf[s], sc); }
#pragma unroll
                for (int i = 0; i < 16; ++i) { const int idx = kt * 32 + (i & 3) + 8 * (i >> 2) + 4 * h; grp[kt][i] = (f2key(sc[i]) & ~127) | (127 - idx); }
                sort16_desc(grp[kt]);
            }
            merge16_desc(grp[0], grp[1]); merge16_desc(grp[2], grp[3]); merge16_desc(grp[0], grp[2]);
            int other[16];
#pragma unroll
            for (int i = 0; i < 16; ++i) other[i] = __shfl_xor(grp[0][i], 32);
            merge16_desc(grp[0], other);
#pragma unroll
            for (int i = 0; i < 16; ++i) top[p][i] = grp[0][i];
        }
        float s1[16], s2[16];
#pragma unroll
        for (int i = 0; i < 16; ++i) { s1[i] = key2f(top[0][i] & ~127); s2[i] = key2f(top[1][i] & ~127); lut[i] = 127 - (top[0][i] & 127); lut[16 + i] = 127 - (top[1][i] & 127); }
        int L[16];
#pragma unroll
        for (int j = 0; j < 16; ++j) L[j] = (f2key(s1[0] + s2[j]) & ~255) | (255 - j);
#pragma unroll
        for (int i = 1; i < 16; ++i)
#pragma unroll
            for (int j = 0; j < 16; ++j) if ((i + 1) * (j + 1) <= 16) {
                int x = (f2key(s1[i] + s2[j]) & ~255) | (255 - (16 * i + j));
#pragma unroll
                for (int pz = (i + 1) * (j + 1) - 1; pz < 16; ++pz) CE_DESC(L[pz], x);
            }
        const float best0 = key2f(L[0] & ~255); float ge[16], gs = 0.f;
#pragma unroll
        for (int n = 0; n < 16; ++n) { ge[n] = __expf(key2f(L[n] & ~255) - best0); gs += ge[n]; }
        const float ginv = 1.0f / gs;
        asm volatile("s_waitcnt lgkmcnt(0)" ::: "memory");
        unsigned* pk = picks + ((size_t)(tb * 32 + q) * PEER_HEADS + hd) * 16 + 8 * h;
        unsigned wv[16];
#pragma unroll
        for (int n = 0; n < 16; ++n) { const int c = 255 - (L[n] & 255); const unsigned e = lut[c >> 4] * PEER_N_KEYS + lut[16 + (c & 15)];
            wv[n] = (e << 16) | (cvt2(ge[n] * ginv, 0.f) & 0xffffu); }
        u32x4 o0, o1;
        o0.x = h ? wv[8] : wv[0]; o0.y = h ? wv[9] : wv[1]; o0.z = h ? wv[10] : wv[2]; o0.w = h ? wv[11] : wv[3];
        o1.x = h ? wv[12] : wv[4]; o1.y = h ? wv[13] : wv[5]; o1.z = h ? wv[14] : wv[6]; o1.w = h ? wv[15] : wv[7];
        *(u32x4*)pk = o0; *(u32x4*)(pk + 4) = o1;
        u32x4 e16; e16.x = (o0.x >> 16) | (o0.y & 0xffff0000u); e16.y = (o0.z >> 16) | (o0.w & 0xffff0000u); e16.z = (o1.x >> 16) | (o1.y & 0xffff0000u); e16.w = (o1.z >> 16) | (o1.w & 0xffff0000u);
        *(u32x4*)(eid16 + ((size_t)(tb * 32 + q) * PEER_HEADS + hd) * 16 + 8 * h) = e16;
    }
    WG_SYNC();
}

DI float gelu_erf(float v) {
    const float av = fabsf(v), t = __builtin_amdgcn_rcpf(av * 0.2316418882f + 1.0f);
    float qv = t * 0.5307027145f - 0.7265760135f; qv = qv * t + 0.7107068705f; qv = qv * t - 0.142248368f; qv = qv * t + 0.127414796f; qv = qv * t;
    const float e = __builtin_amdgcn_exp2f(v * v * -0.72134752044f), mm = v * (qv * e);
    return v < 0.f ? mm : v - mm;
}
typedef __bf16 bf8_t __attribute__((ext_vector_type(8)));
DI float dot8(const u32x4 a, const u32x4 b, float acc) {
    const bf8_t a8 = __builtin_bit_cast(bf8_t, a), b8 = __builtin_bit_cast(bf8_t, b);
    acc = __builtin_amdgcn_fdot2_f32_bf16(a8.s01, b8.s01, acc, false);
    acc = __builtin_amdgcn_fdot2_f32_bf16(a8.s23, b8.s23, acc, false);
    acc = __builtin_amdgcn_fdot2_f32_bf16(a8.s45, b8.s45, acc, false);
    acc = __builtin_amdgcn_fdot2_f32_bf16(a8.s67, b8.s67, acc, false);
    return acc;
}
DI void axpy8(float (&o)[8], float w, const u32x4 v) {
    o[0] += w * bf_lo(v.x); o[1] += w * bf_hi(v.x); o[2] += w * bf_lo(v.y); o[3] += w * bf_hi(v.y); o[4] += w * bf_lo(v.z); o[5] += w * bf_hi(v.z); o[6] += w * bf_lo(v.w); o[7] += w * bf_hi(v.w);
}
template <int XM> DI float swz_xor(float v) { return __int_as_float(__builtin_amdgcn_ds_swizzle(__float_as_int(v), (XM << 10) | 0x1f)); }
template <int D> DI void treduce_stage(float (&p)[16], int lane) {
    const bool up = (lane & D) != 0;
#pragma unroll
    for (int k = 0; k < D; ++k) { const float keep = up ? p[k + D] : p[k], send = up ? p[k] : p[k + D]; p[k] = keep + swz_xor<D>(send); }
}
DI float treduce16(float (&p)[16], int lane) {
    treduce_stage<8>(p, lane); treduce_stage<4>(p, lane); treduce_stage<2>(p, lane); treduce_stage<1>(p, lane);
    float r = p[0]; r += swz_xor<16>(r); r += __shfl_xor(r, 32); return r;
}
DI u32x4 bload(__amdgpu_buffer_rsrc_t r, int voff, int soff) { return __builtin_bit_cast(u32x4, __builtin_amdgcn_raw_buffer_load_b128(r, voff, soff, 0)); }
DI void cvt_fp8_rows(const float* src, unsigned char* dst, float* scales, int rows, int gw, int NGW, int lane) {
    for (int r = gw; r < rows; r += NGW) {
        const float* p = src + (size_t)r * 1024 + lane * 16;
        const f32x4 a = *(const f32x4*)p, b = *(const f32x4*)(p + 4), c = *(const f32x4*)(p + 8), d = *(const f32x4*)(p + 12);
        float m = fmaxf(fmaxf(fmaxf(fabsf(a[0]), fabsf(a[1])), fmaxf(fabsf(a[2]), fabsf(a[3]))), fmaxf(fmaxf(fabsf(b[0]), fabsf(b[1])), fmaxf(fabsf(b[2]), fabsf(b[3]))));
        m = fmaxf(m, fmaxf(fmaxf(fmaxf(fabsf(c[0]), fabsf(c[1])), fmaxf(fabsf(c[2]), fabsf(c[3]))), fmaxf(fmaxf(fabsf(d[0]), fabsf(d[1])), fmaxf(fabsf(d[2]), fabsf(d[3])))));
#pragma unroll
        for (int o = 1; o < 64; o <<= 1) m = fmaxf(m, __shfl_xor(m, o));
        const float sc = m > 0.f ? m * (1.0f / 448.0f) : 1.0f, inv = 1.0f / sc;
        u32x4 o;
        o.x = (unsigned)__builtin_amdgcn_cvt_pk_fp8_f32(a[2] * inv, a[3] * inv, __builtin_amdgcn_cvt_pk_fp8_f32(a[0] * inv, a[1] * inv, 0, false), true);
        o.y = (unsigned)__builtin_amdgcn_cvt_pk_fp8_f32(b[2] * inv, b[3] * inv, __builtin_amdgcn_cvt_pk_fp8_f32(b[0] * inv, b[1] * inv, 0, false), true);
        o.z = (unsigned)__builtin_amdgcn_cvt_pk_fp8_f32(c[2] * inv, c[3] * inv, __builtin_amdgcn_cvt_pk_fp8_f32(c[0] * inv, c[1] * inv, 0, false), true);
        o.w = (unsigned)__builtin_amdgcn_cvt_pk_fp8_f32(d[2] * inv, d[3] * inv, __builtin_amdgcn_cvt_pk_fp8_f32(d[0] * inv, d[1] * inv, 0, false), true);
        *(u32x4*)(dst + (size_t)(lane >> 3) * (2u << 20) + (size_t)r * 128 + (lane & 7) * 16) = o;
        if (lane == 0) scales[r] = sc;
    }
}
DI void unpack_fp8x16(const u32x4 v, float (&f)[16]) {
    const f32x2_t a0 = __builtin_amdgcn_cvt_pk_f32_fp8((int)v.x, false), a1 = __builtin_amdgcn_cvt_pk_f32_fp8((int)v.x, true), b0 = __builtin_amdgcn_cvt_pk_f32_fp8((int)v.y, false), b1 = __builtin_amdgcn_cvt_pk_f32_fp8((int)v.y, true);
    const f32x2_t c0 = __builtin_amdgcn_cvt_pk_f32_fp8((int)v.z, false), c1 = __builtin_amdgcn_cvt_pk_f32_fp8((int)v.z, true), d0 = __builtin_amdgcn_cvt_pk_f32_fp8((int)v.w, false), d1 = __builtin_amdgcn_cvt_pk_f32_fp8((int)v.w, true);
    f[0] = a0.x; f[1] = a0.y; f[2] = a1.x; f[3] = a1.y; f[4] = b0.x; f[5] = b0.y; f[6] = b1.x; f[7] = b1.y; f[8] = c0.x; f[9] = c0.y; f[10] = c1.x; f[11] = c1.y; f[12] = d0.x; f[13] = d0.y; f[14] = d1.x; f[15] = d1.y;
}

constexpr int PEER_BLK = 128, PEER_NBLK = cfg::NTOK / PEER_BLK;
DI bool peer_next_item(volatile LAS unsigned* slot, gu32* cnt, int tid, int& s, int& blk) {
    if (tid == 0) { const int myx = (int)(xb_xcc_id() & 7u); int found = -1; unsigned tk = 0u;
        for (int a = 0; a < 8 && found < 0; ++a) { const int ss = (myx + a) & 7; const unsigned t = __hip_atomic_fetch_add(cnt + ss * 64, 1u, __ATOMIC_RELAXED, __HIP_MEMORY_SCOPE_AGENT); if (t < (unsigned)PEER_NBLK) { found = ss; tk = t; } }
        slot[0] = (unsigned)found; slot[1] = tk; }
    __syncthreads();
    s = __builtin_amdgcn_readfirstlane((int)slot[0]); blk = __builtin_amdgcn_readfirstlane((int)slot[1]);
    __syncthreads();
    return s >= 0;
}
template <int LB> DI float xor_lane(float v) { if constexpr (LB < 32) return __int_as_float(__builtin_amdgcn_ds_swizzle(__float_as_int(v), (LB << 10) | 0x1f)); else return __shfl_xor(v, 32); }
template <int AH, int LB> DI void halve_stage(float (&p)[16], int lane) {
    const bool up = (lane & LB) != 0;
#pragma unroll
    for (int k = 0; k < AH; ++k) { const float keep = up ? p[k + AH] : p[k], send = up ? p[k] : p[k + AH]; p[k] = keep + xor_lane<LB>(send); }
}
DI int peer_voff(const u32x4 (&pk)[2], int i, int sub) { const unsigned p = pk[i >> 3][(i >> 1) & 3]; const unsigned e = (i & 1) ? (p >> 16) : (p & 0xffffu); return (int)(e * 128u) + sub * 16; }
DI void peer_load_pk(u32x4 (&pk)[2], const bf16* arr16, int t, int grp) {
    pk[0] = *(const u32x4*)(arr16 + (size_t)t * 128 + grp * 16); pk[1] = *(const u32x4*)(arr16 + (size_t)t * 128 + grp * 16 + 8);
}
typedef int i32x4_t __attribute__((ext_vector_type(4)));
DI i32x4_t peer_rsrc(const void* base, unsigned bytes) {
    const unsigned long long a = (unsigned long long)base; i32x4_t r;
    r.x = __builtin_amdgcn_readfirstlane((int)(unsigned)a); r.y = __builtin_amdgcn_readfirstlane((int)((unsigned)(a >> 32) & 0xffffu)); r.z = __builtin_amdgcn_readfirstlane((int)bytes); r.w = __builtin_amdgcn_readfirstlane(0x00020000);
    return r;
}
#define PEER_ROW_ISSUE(dst, voff, rs) dst = bload(__builtin_amdgcn_make_buffer_rsrc((void*)(((unsigned long long)(unsigned)rs.x) | ((unsigned long long)(unsigned)rs.y << 32)), 0, 2 << 20, 0x00020000), voff, 0)
#define PEER_ROW_ISSUE_FIRST(dst, voff, rs) PEER_ROW_ISSUE(dst, voff, rs)
#define PEER_G_ISSUE(dst, ptr) dst = *(const u32x4*)(ptr)
template <int N> DI void peer_wait(u32x4& r) { }
template <int N> DI void peer_wait2(u32x4& a, u32x4& b, u32x4& c, u32x4& d) { }
template <int IT> DI void peer_u_token(u32x4 (&r)[16], u32x4 (&eNext)[2], u32x4 (&eLoad)[2], u32x4 (&xCur)[2], u32x4 (&xLoad)[2], const i32x4_t rs, const bf16* eid16, const bf16* xbase, float* abase, int t0, int grp, int sub, int lane) {
    constexpr int NTOP = IT <= 13 ? 4 : IT == 14 ? 2 : 0;
    constexpr int NW = IT <= 14 ? 15 + NTOP : 0;
    if constexpr (IT <= 13) { const bf16* ep = eid16 + (size_t)(t0 + IT + 2) * 128 + grp * 16; PEER_G_ISSUE(eLoad[0], ep); PEER_G_ISSUE(eLoad[1], ep + 8); }
    if constexpr (IT <= 14) { const bf16* xp = xbase + (size_t)(t0 + IT + 1) * cfg::D_MODEL; PEER_G_ISSUE(xLoad[0], xp); PEER_G_ISSUE(xLoad[1], xp + 8); }
    float xs[16]; float part[16];
#pragma unroll
    for (int i = 0; i < 16; ++i) {
        if (i == 0) { if constexpr (IT <= 14) peer_wait2<NW>(r[0], eNext[0], eNext[1], xCur[0]); else peer_wait2<15>(r[0], eNext[0], eNext[1], xCur[0]);
            asm volatile("" : "+v"(xCur[1]));
            const u32x4 xa = xCur[0], xb = xCur[1];
            xs[0] = bf_lo(xa.x); xs[1] = bf_hi(xa.x); xs[2] = bf_lo(xa.y); xs[3] = bf_hi(xa.y); xs[4] = bf_lo(xa.z); xs[5] = bf_hi(xa.z); xs[6] = bf_lo(xa.w); xs[7] = bf_hi(xa.w);
            xs[8] = bf_lo(xb.x); xs[9] = bf_hi(xb.x); xs[10] = bf_lo(xb.y); xs[11] = bf_hi(xb.y); xs[12] = bf_lo(xb.z); xs[13] = bf_hi(xb.z); xs[14] = bf_lo(xb.w); xs[15] = bf_hi(xb.w); }
        else { if constexpr (IT <= 14) peer_wait<NW>(r[i]); else { if (i == 1) peer_wait<14>(r[i]); else if (i == 2) peer_wait<13>(r[i]); else if (i == 3) peer_wait<12>(r[i]); else if (i == 4) peer_wait<11>(r[i]); else if (i == 5) peer_wait<10>(r[i]);
                else if (i == 6) peer_wait<9>(r[i]); else if (i == 7) peer_wait<8>(r[i]); else if (i == 8) peer_wait<7>(r[i]); else if (i == 9) peer_wait<6>(r[i]); else if (i == 10) peer_wait<5>(r[i]); else if (i == 11) peer_wait<4>(r[i]);
                else if (i == 12) peer_wait<3>(r[i]); else if (i == 13) peer_wait<2>(r[i]); else if (i == 14) peer_wait<1>(r[i]); else peer_wait<0>(r[i]); } }
        float f[16]; unpack_fp8x16(r[i], f);
        if constexpr (IT <= 14) { const int vo = peer_voff(eNext, i, sub); PEER_ROW_ISSUE(r[i], vo, rs); }
        float a[8];
#pragma unroll
        for (int k = 0; k < 8; ++k) a[k] = f[k] * xs[k];
#pragma unroll
        for (int k = 0; k < 8; ++k) a[k] += f[k + 8] * xs[k + 8];
        part[i] = ((a[0] + a[1]) + (a[2] + a[3])) + ((a[4] + a[5]) + (a[6] + a[7]));
        asm volatile("" : "+v"(part[i]));
    }
    halve_stage<8, 4>(part, lane); halve_stage<4, 2>(part, lane); halve_stage<2, 1>(part, lane);
    *(f32x2_t*)(abase + (size_t)(t0 + IT) * 128) = (f32x2_t){part[0], part[1]};
}
DI void peer_u_phase(volatile LAS unsigned* slot, const bf16* H2, const bf16* eid16, const unsigned char* U8S, float* actp, gu32* cnt, int tid) {
    using namespace cfg;
    const int wave = tid >> 6;
    int s, blk;
    while (peer_next_item(slot, cnt, tid, s, blk)) {
        int lane = tid & 63; asm volatile("" : "+v"(lane));
        const int grp = lane >> 3, sub = lane & 7;
        const i32x4_t rs = peer_rsrc(U8S + (size_t)s * (2u << 20), 2u << 20);
        const int t0 = blk * PEER_BLK + wave * 16;
        const bf16* xbase = H2 + (size_t)s * 128 + sub * 16;
        float* abase = actp + ((size_t)s * NTOK) * 128 + grp * 16 + 2 * sub;
        u32x4 eA[2], eB[2], xA[2], xB[2], r[16];
        { const bf16* ep = eid16 + (size_t)t0 * 128 + grp * 16; PEER_G_ISSUE(eA[0], ep); PEER_G_ISSUE(eA[1], ep + 8); PEER_G_ISSUE(eB[0], ep + 128); PEER_G_ISSUE(eB[1], ep + 136);
          const bf16* xp = xbase + (size_t)t0 * D_MODEL; PEER_G_ISSUE(xA[0], xp); PEER_G_ISSUE(xA[1], xp + 8); }
        peer_wait2<4>(eA[0], eA[1], eA[0], eA[1]);
#pragma unroll
        for (int i = 0; i < 16; ++i) { const int vo = peer_voff(eA, i, sub); if (i == 0) PEER_ROW_ISSUE_FIRST(r[i], vo, rs); else PEER_ROW_ISSUE(r[i], vo, rs); }
        peer_u_token<0>(r, eB, eA, xA, xB, rs, eid16, xbase, abase, t0, grp, sub, lane);   peer_u_token<1>(r, eA, eB, xB, xA, rs, eid16, xbase, abase, t0, grp, sub, lane);
        peer_u_token<2>(r, eB, eA, xA, xB, rs, eid16, xbase, abase, t0, grp, sub, lane);   peer_u_token<3>(r, eA, eB, xB, xA, rs, eid16, xbase, abase, t0, grp, sub, lane);
        peer_u_token<4>(r, eB, eA, xA, xB, rs, eid16, xbase, abase, t0, grp, sub, lane);   peer_u_token<5>(r, eA, eB, xB, xA, rs, eid16, xbase, abase, t0, grp, sub, lane);
        peer_u_token<6>(r, eB, eA, xA, xB, rs, eid16, xbase, abase, t0, grp, sub, lane);   peer_u_token<7>(r, eA, eB, xB, xA, rs, eid16, xbase, abase, t0, grp, sub, lane);
        peer_u_token<8>(r, eB, eA, xA, xB, rs, eid16, xbase, abase, t0, grp, sub, lane);   peer_u_token<9>(r, eA, eB, xB, xA, rs, eid16, xbase, abase, t0, grp, sub, lane);
        peer_u_token<10>(r, eB, eA, xA, xB, rs, eid16, xbase, abase, t0, grp, sub, lane);  peer_u_token<11>(r, eA, eB, xB, xA, rs, eid16, xbase, abase, t0, grp, sub, lane);
        peer_u_token<12>(r, eB, eA, xA, xB, rs, eid16, xbase, abase, t0, grp, sub, lane);  peer_u_token<13>(r, eA, eB, xB, xA, rs, eid16, xbase, abase, t0, grp, sub, lane);
        peer_u_token<14>(r, eB, eA, xA, xB, rs, eid16, xbase, abase, t0, grp, sub, lane);  peer_u_token<15>(r, eA, eB, xB, xA, rs, eid16, xbase, abase, t0, grp, sub, lane);
    }
}
DI bf16 f2bf16w(float f) { return (bf16)(cvt2(f, 0.f) & 0xffffu); }
DI void peer_w_pass(const unsigned* picks, const float* actp, const float* su, const float* sv, bf16* wbuf, int gw, int NGW, int lane) {
    using namespace cfg;
    for (int t = gw; t < NTOK; t += NGW) {
#pragma unroll
        for (int hf = 0; hf < 2; ++hf) { const int pos = hf * 64 + lane; const unsigned pk = picks[(size_t)t * 128 + pos]; const int e = (int)(pk >> 16); float a = 0.f;
#pragma unroll
            for (int s = 0; s < 8; ++s) a += actp[((size_t)s * NTOK + t) * 128 + pos];
            wbuf[(size_t)t * 128 + pos] = f2bf16w(__uint_as_float(pk << 16) * gelu_erf(a * su[e]) * sv[e]); }
    }
}
template <int IT> DI void peer_v_token(u32x4 (&r)[16], u32x4 (&eNext)[2], u32x4 (&eLoad)[2], u32x4 (&wCur)[2], u32x4 (&wLoad)[2], const i32x4_t rs, const bf16* eid16, const bf16* wbuf, bf16* fbase, int t0, int grp, int sub, int lane) {
    constexpr int NTOP = IT <= 13 ? 4 : IT == 14 ? 2 : 0;
    constexpr int NW = IT <= 14 ? 15 + NTOP : 0;
    if constexpr (IT <= 13) { const bf16* ep = eid16 + (size_t)(t0 + IT + 2) * 128 + grp * 16; PEER_G_ISSUE(eLoad[0], ep); PEER_G_ISSUE(eLoad[1], ep + 8); }
    if constexpr (IT <= 14) { const bf16* wp = wbuf + (size_t)(t0 + IT + 1) * 128 + grp * 16; PEER_G_ISSUE(wLoad[0], wp); PEER_G_ISSUE(wLoad[1], wp + 8); }
    float acc[16];
#pragma unroll
    for (int k = 0; k < 16; ++k) acc[k] = 0.f;
#pragma unroll
    for (int i = 0; i < 16; ++i) {
        if (i == 0) { if constexpr (IT <= 14) peer_wait2<NW>(r[0], eNext[0], eNext[1], wCur[0]); else peer_wait2<15>(r[0], eNext[0], eNext[1], wCur[0]); asm volatile("" : "+v"(wCur[1])); }
        else { if constexpr (IT <= 14) peer_wait<NW>(r[i]); else { if (i == 1) peer_wait<14>(r[i]); else if (i == 2) peer_wait<13>(r[i]); else if (i == 3) peer_wait<12>(r[i]); else if (i == 4) peer_wait<11>(r[i]); else if (i == 5) peer_wait<10>(r[i]);
                else if (i == 6) peer_wait<9>(r[i]); else if (i == 7) peer_wait<8>(r[i]); else if (i == 8) peer_wait<7>(r[i]); else if (i == 9) peer_wait<6>(r[i]); else if (i == 10) peer_wait<5>(r[i]); else if (i == 11) peer_wait<4>(r[i]);
                else if (i == 12) peer_wait<3>(r[i]); else if (i == 13) peer_wait<2>(r[i]); else if (i == 14) peer_wait<1>(r[i]); else peer_wait<0>(r[i]); } }
        float f[16]; unpack_fp8x16(r[i], f);
        if constexpr (IT <= 14) { const int vo = peer_voff(eNext, i, sub); PEER_ROW_ISSUE(r[i], vo, rs); }
        const unsigned wp = wCur[i >> 3][(i >> 1) & 3]; const float w = (i & 1) ? bf_hi(wp) : bf_lo(wp);
#pragma unroll
        for (int k = 0; k < 16; ++k) acc[k] += w * f[k];
    }
    halve_stage<8, 8>(acc, lane); halve_stage<4, 16>(acc, lane); halve_stage<2, 32>(acc, lane);
    *(unsigned*)(fbase + (size_t)(t0 + IT) * cfg::D_MODEL) = cvt2(acc[0], acc[1]);
}
DI void peer_v_phase(volatile LAS unsigned* slot, const bf16* eid16, const bf16* wbuf, const unsigned char* V8S, bf16* ff, gu32* cnt, int tid) {
    using namespace cfg;
    const int wave = tid >> 6;
    int s, blk;
    while (peer_next_item(slot, cnt, tid, s, blk)) {
        int lane = tid & 63; asm volatile("" : "+v"(lane));
        const int grp = lane >> 3, sub = lane & 7;
        const i32x4_t rs = peer_rsrc(V8S + (size_t)s * (2u << 20), 2u << 20);
        const int t0 = blk * PEER_BLK + wave * 16;
        bf16* fbase = ff + (size_t)s * 128 + sub * 16 + 8 * (grp & 1) + 4 * ((grp >> 1) & 1) + 2 * (grp >> 2);
        u32x4 eA[2], eB[2], wA[2], wB[2], r[16];
        { const bf16* ep = eid16 + (size_t)t0 * 128 + grp * 16; PEER_G_ISSUE(eA[0], ep); PEER_G_ISSUE(eA[1], ep + 8); PEER_G_ISSUE(eB[0], ep + 128); PEER_G_ISSUE(eB[1], ep + 136);
          const bf16* wp = wbuf + (size_t)t0 * 128 + grp * 16; PEER_G_ISSUE(wA[0], wp); PEER_G_ISSUE(wA[1], wp + 8); }
        peer_wait2<4>(eA[0], eA[1], eA[0], eA[1]);
#pragma unroll
        for (int i = 0; i < 16; ++i) { const int vo = peer_voff(eA, i, sub); if (i == 0) PEER_ROW_ISSUE_FIRST(r[i], vo, rs); else PEER_ROW_ISSUE(r[i], vo, rs); }
        peer_v_token<0>(r, eB, eA, wA, wB, rs, eid16, wbuf, fbase, t0, grp, sub, lane);   peer_v_token<1>(r, eA, eB, wB, wA, rs, eid16, wbuf, fbase, t0, grp, sub, lane);
        peer_v_token<2>(r, eB, eA, wA, wB, rs, eid16, wbuf, fbase, t0, grp, sub, lane);   peer_v_token<3>(r, eA, eB, wB, wA, rs, eid16, wbuf, fbase, t0, grp, sub, lane);
        peer_v_token<4>(r, eB, eA, wA, wB, rs, eid16, wbuf, fbase, t0, grp, sub, lane);   peer_v_token<5>(r, eA, eB, wB, wA, rs, eid16, wbuf, fbase, t0, grp, sub, lane);
        peer_v_token<6>(r, eB, eA, wA, wB, rs, eid16, wbuf, fbase, t0, grp, sub, lane);   peer_v_token<7>(r, eA, eB, wB, wA, rs, eid16, wbuf, fbase, t0, grp, sub, lane);
        peer_v_token<8>(r, eB, eA, wA, wB, rs, eid16, wbuf, fbase, t0, grp, sub, lane);   peer_v_token<9>(r, eA, eB, wB, wA, rs, eid16, wbuf, fbase, t0, grp, sub, lane);
        peer_v_token<10>(r, eB, eA, wA, wB, rs, eid16, wbuf, fbase, t0, grp, sub, lane);  peer_v_token<11>(r, eA, eB, wB, wA, rs, eid16, wbuf, fbase, t0, grp, sub, lane);
        peer_v_token<12>(r, eB, eA, wA, wB, rs, eid16, wbuf, fbase, t0, grp, sub, lane);  peer_v_token<13>(r, eA, eB, wB, wA, rs, eid16, wbuf, fbase, t0, grp, sub, lane);
        peer_v_token<14>(r, eB, eA, wA, wB, rs, eid16, wbuf, fbase, t0, grp, sub, lane);  peer_v_token<15>(r, eA, eB, wB, wA, rs, eid16, wbuf, fbase, t0, grp, sub, lane);
    }
}
DI void peer_ln_pass(const bf16* H2, const bf16* ff, const float* g, const float* bt, float* out, int gw, int NGW, int lane) {
    using namespace cfg;
    for (int t = gw; t < NTOK; t += NGW) {
        const bf16* xr = H2 + (size_t)t * D_MODEL + lane * 16; const bf16* fr = ff + (size_t)t * D_MODEL + lane * 16;
        const u32x4 xa = *(const u32x4*)xr, xb = *(const u32x4*)(xr + 8), fa = *(const u32x4*)fr, fb = *(const u32x4*)(fr + 8);
        float z[16] = {ALPHA * bf_lo(xa.x) + bf_lo(fa.x), ALPHA * bf_hi(xa.x) + bf_hi(fa.x), ALPHA * bf_lo(xa.y) + bf_lo(fa.y), ALPHA * bf_hi(xa.y) + bf_hi(fa.y), ALPHA * bf_lo(xa.z) + bf_lo(fa.z), ALPHA * bf_hi(xa.z) + bf_hi(fa.z), ALPHA * bf_lo(xa.w) + bf_lo(fa.w), ALPHA * bf_hi(xa.w) + bf_hi(fa.w),
                       ALPHA * bf_lo(xb.x) + bf_lo(fb.x), ALPHA * bf_hi(xb.x) + bf_hi(fb.x), ALPHA * bf_lo(xb.y) + bf_lo(fb.y), ALPHA * bf_hi(xb.y) + bf_hi(fb.y), ALPHA * bf_lo(xb.z) + bf_lo(fb.z), ALPHA * bf_hi(xb.z) + bf_hi(fb.z), ALPHA * bf_lo(xb.w) + bf_lo(fb.w), ALPHA * bf_hi(xb.w) + bf_hi(fb.w)};
        float s = 0.f;
#pragma unroll
        for (int i = 0; i < 16; ++i) s += z[i];
        const float mean = wave_sum(s) * (1.f / 1024.f); float qv = 0.f;
#pragma unroll
        for (int i = 0; i < 16; ++i) { z[i] -= mean; qv += z[i] * z[i]; }
        const float rstd = 1.0f / sqrtf(wave_sum(qv) * (1.f / 1024.f) + LN_EPS);
        float* op = out + (size_t)t * D_MODEL + lane * 16;
#pragma unroll
        for (int q4 = 0; q4 < 4; ++q4) { const f32x4 g0 = *(const f32x4*)(g + lane * 16 + 4 * q4), b0 = *(const f32x4*)(bt + lane * 16 + 4 * q4); f32x4 o;
#pragma unroll
            for (int i = 0; i < 4; ++i) o[i] = z[4 * q4 + i] * rstd * g0[i] + b0[i];
            *(f32x4*)(op + 4 * q4) = o; }
    }
}
constexpr int PROJ_LD = 5632;
constexpr int PC_Q = 0, PC_K = 512, PC_V = 1024, PC_R = 2048, PC_G = 3072, PC_Z = 3088, PC_XBC = 4112, PC_DT = 5392;
struct MixBufs { const bf16* proj; const float* glow; const float* dtraw; bf16* gS; float* gdec; bf16* sS; float* sdec; bf16* oy; int nbatch; };

DI float log_sigmoid_f(float z) { return fminf(z, 0.f) - __logf(1.0f + __expf(-fabsf(z))); }
DI float silu_f(float x) { return x / (1.0f + __expf(-x)); }
DI float bf2f(bf16 v) { return __uint_as_float((unsigned)v << 16); }
DI bf16 f2bf16(float f) { return (bf16)(cvt2(f, 0.f) & 0xffffu); }

DI void gla_gate(LAS unsigned char* lds, const float* glow_rows, const float* wg2, const float* bg, int h, int tid, float (&b)[16], float& blast) {
    LAS float* gl = (LAS float*)lds; LAS float* tot = (LAS float*)(lds + 4096);
    gl[tid] = glow_rows[tid]; gl[tid + 512] = glow_rows[tid + 512];
    const int d = tid & 127, tb = tid >> 7;
    float wc[16];
#pragma unroll
    for (int r = 0; r < 16; ++r) wc[r] = wg2[r * 512 + h * 128 + d];
    const float bgv = bg[h * 128 + d];
    WG_SYNC();
    float run = 0.f;
#pragma unroll
    for (int i = 0; i < 16; ++i) { const LAS float* g = gl + (tb * 16 + i) * 16; float z = bgv;
#pragma unroll
        for (int r = 0; r < 16; ++r) z += g[r] * wc[r];
        run += log_sigmoid_f(z) * 0.0625f; b[i] = run; }
    tot[tb * 128 + d] = run;
    WG_SYNC();
    const float t0 = tot[d], t1 = tot[128 + d], t2 = tot[256 + d], t3 = tot[384 + d];
    const float off = tb == 0 ? 0.f : tb == 1 ? t0 : tb == 2 ? t0 + t1 : t0 + t1 + t2;
    blast = (t0 + t1) + (t2 + t3);
#pragma unroll
    for (int i = 0; i < 16; ++i) b[i] += off;
}

constexpr int GA_KH = 8192, GA_KHP = 320, GA_V = GA_KH + 64 * GA_KHP, GA_VP = 576, GA_ST = GA_V + 64 * GA_VP, GA_STP = 272;
static_assert(GA_ST + 256 * GA_STP <= 152 * 1024, "GLA-A LDS");
DI void gla_a_phase(LAS unsigned char* lds, const MixBufs& mb, const float* wg2, const float* bg, int G, int bx, int tid) {
    using namespace cfg;
    const int wave = tid >> 6;
    const int nitem = mb.nbatch * GLA_HEADS * (SEQ / 64);
    for (int it = bx; it < nitem; it += G) {
        int lane = tid & 63; asm volatile("" : "+v"(lane));
        const int i16 = lane & 15, gi = (lane >> 4) & 1, hh = lane >> 5;
        const int bh = it / (SEQ / 64), c = it % (SEQ / 64), bl = bh / GLA_HEADS, h = bh % GLA_HEADS;
        const size_t row0 = (size_t)bl * SEQ + (size_t)c * 64;
        const bf16* prow = mb.proj + row0 * PROJ_LD;
        float b[16], blast;
        gla_gate(lds, mb.glow + row0 * 16, wg2, bg, h, tid, b, blast);
        const int d = tid & 127, tb = tid >> 7;
#pragma unroll
        for (int i = 0; i < 16; ++i) { const int t = tb * 16 + i; const float kv = bf2f(prow[(size_t)t * PROJ_LD + PC_K + h * 128 + d]);
            *(LAS bf16*)(lds + GA_KH + t * GA_KHP + d * 2) = f2bf16(kv * __expf(blast - b[i])); }
        if (tb == 0) mb.gdec[((size_t)bh * (SEQ / 64) + c) * 128 + d] = __expf(blast);
#pragma unroll
        for (int j = 0; j < 4; ++j) { const int id = tid + 512 * j, t = id >> 5, ch = id & 31;
            *(LAS u32x4*)(lds + GA_V + t * GA_VP + ch * 16) = *(const u32x4*)(prow + (size_t)t * PROJ_LD + PC_V + h * 256 + ch * 8); }
        WG_SYNC();
        const int dtile = wave & 3, eq = wave >> 2;
        f32x16 acc[4];
#pragma unroll
        for (int j = 0; j < 4; ++j)
#pragma unroll
            for (int i = 0; i < 16; ++i) acc[j][i] = 0.f;
        const LAS unsigned char* ka = lds + GA_KH + (8 * hh + (i16 >> 2)) * GA_KHP + (dtile * 32 + 16 * gi + 4 * (i16 & 3)) * 2;
        const LAS unsigned char* va = lds + GA_V + (8 * hh + (i16 >> 2)) * GA_VP + (eq * 128 + 16 * gi + 4 * (i16 & 3)) * 2;
#pragma unroll
        for (int s = 0; s < 4; ++s) {
            const bf16x8 af = cat8(tr_read(ka + 16 * s * GA_KHP), tr_read(ka + (16 * s + 4) * GA_KHP));
#pragma unroll
            for (int j = 0; j < 4; ++j) { const bf16x8 bfr = cat8(tr_read(va + 16 * s * GA_VP + j * 64), tr_read(va + (16 * s + 4) * GA_VP + j * 64)); acc[j] = MFMA32(af, bfr, acc[j]); }
        }
#pragma unroll
        for (int j = 0; j < 4; ++j)
#pragma unroll
            for (int r4 = 0; r4 < 4; ++r4) { u32x2 w; w.x = cvt2(acc[j][4 * r4], acc[j][4 * r4 + 1]); w.y = cvt2(acc[j][4 * r4 + 2], acc[j][4 * r4 + 3]);
                *(LAS u32x2*)(lds + GA_ST + ((eq * 4 + j) * 32 + (lane & 31)) * GA_STP + (dtile * 32 + 8 * r4 + 4 * hh) * 2) = w; }
        WG_SYNC();
        bf16* so = mb.gS + ((size_t)bh * (SEQ / 64) + c) * (256 * 128);
#pragma unroll
        for (int j = 0; j < 8; ++j) { const int id = tid + 512 * j, e = id >> 4, ch = id & 15;
            *(u32x4*)(so + e * 128 + ch * 8) = *(const LAS u32x4*)(lds + GA_ST + e * GA_STP + ch * 16); }
        WG_SYNC();
    }
}

DI void gla_b_phase(const MixBufs& mb, long gtid, long nthr) {
    using namespace cfg;
    const long total = (long)mb.nbatch * GLA_HEADS * 256 * 16;
    for (long i = gtid; i < total; i += nthr) {
        const int dg = (int)(i & 15), e = (int)((i >> 4) & 255), bh = (int)(i >> 12);
        bf16* sp = mb.gS + (size_t)bh * (SEQ / 64) * (256 * 128) + e * 128 + dg * 8;
        const float* dp = mb.gdec + (size_t)bh * (SEQ / 64) * 128 + dg * 8;
        float st[8];
#pragma unroll
        for (int k = 0; k < 8; ++k) st[k] = 0.f;
        for (int c0 = 0; c0 < SEQ / 64; c0 += 4) {
            u32x4 kv[4]; f32x4 d0[4], d1[4];
#pragma unroll
            for (int u = 0; u < 4; ++u) { kv[u] = *(const u32x4*)(sp + (size_t)(c0 + u) * (256 * 128)); d0[u] = *(const f32x4*)(dp + (c0 + u) * 128); d1[u] = *(const f32x4*)(dp + (c0 + u) * 128 + 4); }
#pragma unroll
            for (int u = 0; u < 4; ++u) {
                u32x4 o; o.x = cvt2(st[0], st[1]); o.y = cvt2(st[2], st[3]); o.z = cvt2(st[4], st[5]); o.w = cvt2(st[6], st[7]);
                *(u32x4*)(sp + (size_t)(c0 + u) * (256 * 128)) = o;
                st[0] = d0[u][0] * st[0] + bf_lo(kv[u].x); st[1] = d0[u][1] * st[1] + bf_hi(kv[u].x); st[2] = d0[u][2] * st[2] + bf_lo(kv[u].y); st[3] = d0[u][3] * st[3] + bf_hi(kv[u].y);
                st[4] = d1[u][0] * st[4] + bf_lo(kv[u].z); st[5] = d1[u][1] * st[5] + bf_hi(kv[u].z); st[6] = d1[u][2] * st[6] + bf_lo(kv[u].w); st[7] = d1[u][3] * st[7] + bf_hi(kv[u].w);
            }
        }
    }
}

constexpr int GC_SSQ = 6144, GC_QT = 8192, GC_QKP = 272, GC_KT = GC_QT + 64 * GC_QKP, GC_V = GC_KT + 64 * GC_QKP, GC_VP = 576, GC_P = GC_V + 64 * GC_VP, GC_PP = 144, GC_O = GC_P + 64 * GC_PP, GC_OP = 528;
static_assert(GC_O + 64 * GC_OP <= 152 * 1024, "GLA-C LDS");
DI void gla_c_phase(LAS unsigned char* lds, const MixBufs& mb, const float* wg2, const float* bg, const float* norm_g, int G, int bx, int tid) {
    using namespace cfg;
    const int wave = tid >> 6;
    const int nitem = mb.nbatch * GLA_HEADS * (SEQ / 64);
    for (int it = bx; it < nitem; it += G) {
        int lane = tid & 63; asm volatile("" : "+v"(lane));
        const int i16 = lane & 15, gi = (lane >> 4) & 1, hh = lane >> 5, l31 = lane & 31;
        const int bh = it / (SEQ / 64), c = it % (SEQ / 64), bl = bh / GLA_HEADS, h = bh % GLA_HEADS;
        const size_t row0 = (size_t)bl * SEQ + (size_t)c * 64;
        const bf16* prow = mb.proj + row0 * PROJ_LD;
        float b[16], blast;
        gla_gate(lds, mb.glow + row0 * 16, wg2, bg, h, tid, b, blast);
        const int d = tid & 127, tb = tid >> 7;
#pragma unroll
        for (int i = 0; i < 16; ++i) { const int t = tb * 16 + i; const bf16* pr = prow + (size_t)t * PROJ_LD + h * 128 + d;
            *(LAS bf16*)(lds + GC_QT + t * GC_QKP + d * 2) = f2bf16(bf2f(pr[PC_Q]) * 0.08838834764831845f * __expf(b[i]));
            *(LAS bf16*)(lds + GC_KT + t * GC_QKP + d * 2) = f2bf16(bf2f(pr[PC_K]) * __expf(-b[i])); }
#pragma unroll
        for (int j = 0; j < 4; ++j) { const int id = tid + 512 * j, t = id >> 5, ch = id & 31;
            *(LAS u32x4*)(lds + GC_V + t * GC_VP + ch * 16) = *(const u32x4*)(prow + (size_t)t * PROJ_LD + PC_V + h * 256 + ch * 8); }
        WG_SYNC();
        if (wave < 3) {
            const int st = wave == 2 ? 1 : 0, tt = wave == 0 ? 0 : 1;
            f32x16 p;
#pragma unroll
            for (int i = 0; i < 16; ++i) p[i] = 0.f;
#pragma unroll
            for (int ks = 0; ks < 8; ++ks) { const bf16x8 af = *(const LAS bf16x8*)(lds + GC_KT + (st * 32 + l31) * GC_QKP + (16 * ks + 8 * hh) * 2);
                const bf16x8 bfr = *(const LAS bf16x8*)(lds + GC_QT + (tt * 32 + l31) * GC_QKP + (16 * ks + 8 * hh) * 2); p = MFMA32(af, bfr, p); }
            const int t = tt * 32 + l31;
#pragma unroll
            for (int r4 = 0; r4 < 4; ++r4) { const int s0 = st * 32 + 8 * r4 + 4 * hh; u32x2 w;
                w.x = cvt2(s0 <= t ? p[4 * r4] : 0.f, s0 + 1 <= t ? p[4 * r4 + 1] : 0.f); w.y = cvt2(s0 + 2 <= t ? p[4 * r4 + 2] : 0.f, s0 + 3 <= t ? p[4 * r4 + 3] : 0.f);
                *(LAS u32x2*)(lds + GC_P + t * GC_PP + s0 * 2) = w; }
        }
        WG_SYNC();
        f32x16 o[2];
#pragma unroll
        for (int tt = 0; tt < 2; ++tt)
#pragma unroll
            for (int i = 0; i < 16; ++i) o[tt][i] = 0.f;
        const LAS unsigned char* va = lds + GC_V + (8 * hh + (i16 >> 2)) * GC_VP + (wave * 32 + 16 * gi + 4 * (i16 & 3)) * 2;
#pragma unroll
        for (int ks = 0; ks < 4; ++ks) {
            const bf16x8 af = cat8(tr_read(va + 16 * ks * GC_VP), tr_read(va + (16 * ks + 4) * GC_VP));
            if (ks < 2) { const bf16x8 b0 = *(const LAS bf16x8*)(lds + GC_P + l31 * GC_PP + (16 * ks + 8 * hh) * 2); o[0] = MFMA32(af, b0, o[0]); }
            const bf16x8 b1 = *(const LAS bf16x8*)(lds + GC_P + (32 + l31) * GC_PP + (16 * ks + 8 * hh) * 2); o[1] = MFMA32(af, b1, o[1]);
        }
        const bf16* sin = mb.gS + (((size_t)bh * (SEQ / 64) + c) * 256 + wave * 32 + l31) * 128 + 8 * hh;
#pragma unroll
        for (int ks = 0; ks < 8; ++ks) { const bf16x8 af = *(const bf16x8*)(sin + 16 * ks);
#pragma unroll
            for (int tt = 0; tt < 2; ++tt) { const bf16x8 bfr = *(const LAS bf16x8*)(lds + GC_QT + (tt * 32 + l31) * GC_QKP + (16 * ks + 8 * hh) * 2); o[tt] = MFMA32(af, bfr, o[tt]); } }
#pragma unroll
        for (int tt = 0; tt < 2; ++tt) { float q = 0.f;
#pragma unroll
            for (int i = 0; i < 16; ++i) q += o[tt][i] * o[tt][i];
            q += __shfl_xor(q, 32);
            if (hh == 0) ((LAS float*)(lds + GC_SSQ))[wave * 64 + tt * 32 + l31] = q;
#pragma unroll
            for (int r4 = 0; r4 < 4; ++r4) { u32x2 w; w.x = cvt2(o[tt][4 * r4], o[tt][4 * r4 + 1]); w.y = cvt2(o[tt][4 * r4 + 2], o[tt][4 * r4 + 3]);
                *(LAS u32x2*)(lds + GC_O + (tt * 32 + l31) * GC_OP + (wave * 32 + 8 * r4 + 4 * hh) * 2) = w; } }
        WG_SYNC();
#pragma unroll
        for (int j = 0; j < 4; ++j) { const int id = tid + 512 * j, t = id >> 5, ch = id & 31;
            const LAS float* sq = (const LAS float*)(lds + GC_SSQ) + t; float ss = 0.f;
#pragma unroll
            for (int w = 0; w < 8; ++w) ss += sq[w * 64];
            const float rs = 1.0f / sqrtf(ss * (1.0f / 256.0f) + RMS_EPS);
            const u32x4 ov = *(const LAS u32x4*)(lds + GC_O + t * GC_OP + ch * 16);
            const u32x4 rv = *(const u32x4*)(prow + (size_t)t * PROJ_LD + PC_R + h * 256 + ch * 8);
            const f32x4 g0 = *(const f32x4*)(norm_g + ch * 8), g1 = *(const f32x4*)(norm_g + ch * 8 + 4);
            u32x4 w;
            w.x = cvt2(bf_lo(ov.x) * rs * g0[0] * silu_f(bf_lo(rv.x)), bf_hi(ov.x) * rs * g0[1] * silu_f(bf_hi(rv.x)));
            w.y = cvt2(bf_lo(ov.y) * rs * g0[2] * silu_f(bf_lo(rv.y)), bf_hi(ov.y) * rs * g0[3] * silu_f(bf_hi(rv.y)));
            w.z = cvt2(bf_lo(ov.z) * rs * g1[0] * silu_f(bf_lo(rv.z)), bf_hi(ov.z) * rs * g1[1] * silu_f(bf_hi(rv.z)));
            w.w = cvt2(bf_lo(ov.w) * rs * g1[2] * silu_f(bf_lo(rv.w)), bf_hi(ov.w) * rs * g1[3] * silu_f(bf_hi(rv.w)));
            *(u32x4*)(mb.oy + (row0 + t) * D_MIX + h * 256 + ch * 8) = w; }
        WG_SYNC();
    }
}

constexpr int SD_DT = 0, SD_AC = 2048, SD_XS = 4096, SD_XP = 1088, SD_BM = SD_XS + 64 * SD_XP, SD_BP_TR = 192, SD_BP = 144, SD_CM = SD_BM + 64 * SD_BP_TR, SD_Y = SD_CM + 64 * SD_BP, SD_YP = 1040, SD_STP = 144;
static_assert(SD_Y + 64 * SD_YP <= 159 * 1024, "SSD LDS");
DI float ssd_dt_scan(LAS unsigned char* lds, const float* dtraw_rows, const float* dt_bias, const float* a_log, int g, int wave, int lane) {
    const int hd = g * 8 + wave;
    const float x = dtraw_rows[lane * 16 + hd] + dt_bias[hd];
    const float dtv = x > 0.f ? x + __logf(1.0f + __expf(-x)) : __logf(1.0f + __expf(x));
    float a = dtv * -__expf(a_log[hd]);
#pragma unroll
    for (int o = 1; o < 64; o <<= 1) { const float v = __shfl_up(a, o); if (lane >= o) a += v; }
    ((LAS float*)(lds + SD_DT))[lane * 8 + wave] = dtv; ((LAS float*)(lds + SD_AC))[lane * 8 + wave] = a;
    return __shfl(a, 63);
}
template <int MODE> DI void ssd_conv_wu(LAS unsigned char* lds, const bf16* prow, const float* cw, const float* cb, int g, int c, int oc, int t0) {
    using namespace cfg;
    const int xch = oc < 64 ? g * 512 + oc * 8 : oc < 72 ? 1024 + g * 64 + (oc - 64) * 8 : 1152 + g * 64 + (oc - 72) * 8;
    float w[4][8], bias[8];
#pragma unroll
    for (int k = 0; k < 4; ++k) { const f32x4 a = *(const f32x4*)(cw + k * SSD_CONV_DIM + xch), b = *(const f32x4*)(cw + k * SSD_CONV_DIM + xch + 4);
        w[k][0] = a[0]; w[k][1] = a[1]; w[k][2] = a[2]; w[k][3] = a[3]; w[k][4] = b[0]; w[k][5] = b[1]; w[k][6] = b[2]; w[k][7] = b[3]; }
    { const f32x4 a = *(const f32x4*)(cb + xch), b = *(const f32x4*)(cb + xch + 4); bias[0] = a[0]; bias[1] = a[1]; bias[2] = a[2]; bias[3] = a[3]; bias[4] = b[0]; bias[5] = b[1]; bias[6] = b[2]; bias[7] = b[3]; }
    u32x4 xin[11];
#pragma unroll
    for (int i = 0; i < 11; ++i) { const int t = t0 - 3 + i; xin[i] = (c == 0 && t < 0) ? (u32x4){0u, 0u, 0u, 0u} : *(const u32x4*)(prow + (long)t * PROJ_LD + PC_XBC + xch); }
#pragma unroll
    for (int i = 0; i < 8; ++i) {
        float y[8];
#pragma unroll
        for (int j = 0; j < 8; ++j) y[j] = bias[j];
#pragma unroll
        for (int k = 0; k < 4; ++k) { const u32x4 v = xin[i + k];
            y[0] += w[k][0] * bf_lo(v.x); y[1] += w[k][1] * bf_hi(v.x); y[2] += w[k][2] * bf_lo(v.y); y[3] += w[k][3] * bf_hi(v.y);
            y[4] += w[k][4] * bf_lo(v.z); y[5] += w[k][5] * bf_hi(v.z); y[6] += w[k][6] * bf_lo(v.w); y[7] += w[k][7] * bf_hi(v.w); }
        const int t = t0 + i; float sc = 1.f;
        if (MODE == 0 && oc < 64) sc = ((const LAS float*)(lds + SD_DT))[t * 8 + (oc >> 3)];
#pragma unroll
        for (int j = 0; j < 8; ++j) y[j] = silu_f(y[j]) * sc;
        u32x4 o; o.x = cvt2(y[0], y[1]); o.y = cvt2(y[2], y[3]); o.z = cvt2(y[4], y[5]); o.w = cvt2(y[6], y[7]);
        if (oc < 64) *(LAS u32x4*)(lds + SD_XS + t * SD_XP + oc * 16) = o;
        else if (oc < 72) *(LAS u32x4*)(lds + SD_BM + t * (MODE == 0 ? SD_BP_TR : SD_BP) + (oc - 64) * 16) = o;
        else *(LAS u32x4*)(lds + SD_CM + t * SD_BP + (oc - 72) * 16) = o;
    }
}
DI void ssd_a_phase(LAS unsigned char* lds, const MixBufs& mb, const float* cw, const float* cb, const float* dt_bias, const float* a_log, int G, int bx, int tid) {
    using namespace cfg;
    const int wave = tid >> 6;
    const int nitem = mb.nbatch * SSD_GROUPS * (SEQ / 64);
    for (int it = bx; it < nitem; it += G) {
        int lane = tid & 63; asm volatile("" : "+v"(lane));
        const int i16 = lane & 15, gi = (lane >> 4) & 1, hh = lane >> 5, l31 = lane & 31;
        const int bg = it / (SEQ / 64), c = it % (SEQ / 64), bl = bg / SSD_GROUPS, g = bg % SSD_GROUPS;
        const size_t row0 = (size_t)bl * SEQ + (size_t)c * 64;
        const bf16* prow = mb.proj + row0 * PROJ_LD;
        const float alast = ssd_dt_scan(lds, mb.dtraw + row0 * 16, dt_bias, a_log, g, wave, lane);
        { LAS float* dtp = (LAS float*)(lds + SD_DT) + lane * 8 + wave; const float ac = ((LAS float*)(lds + SD_AC))[lane * 8 + wave]; *dtp = *dtp * __expf(alast - ac); }
        if (lane == 0) mb.sdec[((size_t)bl * SSD_HEADS + g * 8 + wave) * (SEQ / 64) + c] = __expf(alast);
        WG_SYNC();
        for (int wu = tid; wu < 72 * 8; wu += NTHR) ssd_conv_wu<0>(lds, prow, cw, cb, g, c, wu % 72, (wu / 72) * 8);
        WG_SYNC();
        f32x16 acc[2][2];
#pragma unroll
        for (int a = 0; a < 2; ++a)
#pragma unroll
            for (int b = 0; b < 2; ++b)
#pragma unroll
                for (int i = 0; i < 16; ++i) acc[a][b][i] = 0.f;
        const LAS unsigned char* ba = lds + SD_BM + (8 * hh + (i16 >> 2)) * SD_BP_TR + (16 * gi + 4 * (i16 & 3)) * 2;
        const LAS unsigned char* xa = lds + SD_XS + (8 * hh + (i16 >> 2)) * SD_XP + (wave * 64 + 16 * gi + 4 * (i16 & 3)) * 2;
#pragma unroll
        for (int s = 0; s < 4; ++s) {
            bf16x8 af[2], bfr[2];
#pragma unroll
            for (int nt = 0; nt < 2; ++nt) af[nt] = cat8(tr_read(ba + 16 * s * SD_BP_TR + nt * 64), tr_read(ba + (16 * s + 4) * SD_BP_TR + nt * 64));
#pragma unroll
            for (int pt = 0; pt < 2; ++pt) bfr[pt] = cat8(tr_read(xa + 16 * s * SD_XP + pt * 64), tr_read(xa + (16 * s + 4) * SD_XP + pt * 64));
#pragma unroll
            for (int nt = 0; nt < 2; ++nt)
#pragma unroll
                for (int pt = 0; pt < 2; ++pt) acc[nt][pt] = MFMA32(af[nt], bfr[pt], acc[nt][pt]);
        }
        WG_SYNC();
#pragma unroll
        for (int nt = 0; nt < 2; ++nt)
#pragma unroll
            for (int pt = 0; pt < 2; ++pt)
#pragma unroll
                for (int r4 = 0; r4 < 4; ++r4) { u32x2 w; w.x = cvt2(acc[nt][pt][4 * r4], acc[nt][pt][4 * r4 + 1]); w.y = cvt2(acc[nt][pt][4 * r4 + 2], acc[nt][pt][4 * r4 + 3]);
                    *(LAS u32x2*)(lds + SD_XS + (wave * 64 + pt * 32 + l31) * SD_STP + (nt * 32 + 8 * r4 + 4 * hh) * 2) = w; }
        WG_SYNC();
#pragma unroll
        for (int j = 0; j < 8; ++j) { const int id = tid + 512 * j, hd = id >> 9, p = (id >> 3) & 63, ch = id & 7;
            *(u32x4*)(mb.sS + ((((size_t)bl * SSD_HEADS + g * 8 + hd) * (SEQ / 64) + c) * 64 + p) * 64 + ch * 8) = *(const LAS u32x4*)(lds + SD_XS + (hd * 64 + p) * SD_STP + ch * 16); }
        WG_SYNC();
    }
}
DI void ssd_b_phase(const MixBufs& mb, long gtid, long nthr) {
    using namespace cfg;
    const long total = (long)mb.nbatch * SSD_HEADS * 64 * 8;
    for (long i = gtid; i < total; i += nthr) {
        const int ng = (int)(i & 7), p = (int)((i >> 3) & 63), bh = (int)(i >> 9);
        bf16* sp = mb.sS + (size_t)bh * (SEQ / 64) * 4096 + p * 64 + ng * 8;
        const float* dp = mb.sdec + (size_t)bh * (SEQ / 64);
        float st[8];
#pragma unroll
        for (int k = 0; k < 8; ++k) st[k] = 0.f;
        for (int c0 = 0; c0 < SEQ / 64; c0 += 4) {
            u32x4 kv[4]; float dc[4];
#pragma unroll
            for (int u = 0; u < 4; ++u) { kv[u] = *(const u32x4*)(sp + (size_t)(c0 + u) * 4096); dc[u] = dp[c0 + u]; }
#pragma unroll
            for (int u = 0; u < 4; ++u) {
                u32x4 o; o.x = cvt2(st[0], st[1]); o.y = cvt2(st[2], st[3]); o.z = cvt2(st[4], st[5]); o.w = cvt2(st[6], st[7]);
                *(u32x4*)(sp + (size_t)(c0 + u) * 4096) = o;
                st[0] = dc[u] * st[0] + bf_lo(kv[u].x); st[1] = dc[u] * st[1] + bf_hi(kv[u].x); st[2] = dc[u] * st[2] + bf_lo(kv[u].y); st[3] = dc[u] * st[3] + bf_hi(kv[u].y);
                st[4] = dc[u] * st[4] + bf_lo(kv[u].z); st[5] = dc[u] * st[5] + bf_hi(kv[u].z); st[6] = dc[u] * st[6] + bf_lo(kv[u].w); st[7] = dc[u] * st[7] + bf_hi(kv[u].w);
            }
        }
    }
}
DI void ssd_c_phase(LAS unsigned char* lds, const MixBufs& mb, const float* cw, const float* cb, const float* dt_bias, const float* a_log, const float* dskip, const float* norm_g, int G, int bx, int tid) {
    using namespace cfg;
    const int wave = tid >> 6;
    const int nitem = mb.nbatch * SSD_GROUPS * (SEQ / 64);
    for (int it = bx; it < nitem; it += G) {
        int lane = tid & 63; asm volatile("" : "+v"(lane));
        const int i16 = lane & 15, gi = (lane >> 4) & 1, hh = lane >> 5, l31 = lane & 31;
        const int bg = it / (SEQ / 64), c = it % (SEQ / 64), bl = bg / SSD_GROUPS, g = bg % SSD_GROUPS, hd = g * 8 + wave;
        const size_t row0 = (size_t)bl * SEQ + (size_t)c * 64;
        const bf16* prow = mb.proj + row0 * PROJ_LD;
        (void)ssd_dt_scan(lds, mb.dtraw + row0 * 16, dt_bias, a_log, g, wave, lane);
        for (int wu = tid; wu < 80 * 8; wu += NTHR) ssd_conv_wu<1>(lds, prow, cw, cb, g, c, wu % 80, (wu / 80) * 8);
        WG_SYNC();
        const LAS float* dtl = (const LAS float*)(lds + SD_DT); const LAS float* acl = (const LAS float*)(lds + SD_AC);
        f32x16 gt[3];
#pragma unroll
        for (int q = 0; q < 3; ++q) { const int st = q == 2 ? 1 : 0, tt = q == 0 ? 0 : 1;
#pragma unroll
            for (int i = 0; i < 16; ++i) gt[q][i] = 0.f;
#pragma unroll
            for (int ks = 0; ks < 4; ++ks) { const bf16x8 af = *(const LAS bf16x8*)(lds + SD_BM + (st * 32 + l31) * SD_BP + (16 * ks + 8 * hh) * 2);
                const bf16x8 bfr = *(const LAS bf16x8*)(lds + SD_CM + (tt * 32 + l31) * SD_BP + (16 * ks + 8 * hh) * 2); gt[q] = MFMA32(af, bfr, gt[q]); } }
        bf16x8 mf[3][2];
#pragma unroll
        for (int q = 0; q < 3; ++q) { const int st = q == 2 ? 1 : 0, tt = q == 0 ? 0 : 1; const int t = tt * 32 + l31; const float at = acl[t * 8 + wave];
            float e[16];
#pragma unroll
            for (int i = 0; i < 16; ++i) { const int s = st * 32 + (i & 3) + 8 * (i >> 2) + 4 * hh; e[i] = s <= t ? gt[q][i] * __expf(at - acl[s * 8 + wave]) * dtl[s * 8 + wave] : 0.f; }
#pragma unroll
            for (int s2 = 0; s2 < 2; ++s2) { u32x4 w; w.x = cvt2(e[8 * s2], e[8 * s2 + 1]); w.y = cvt2(e[8 * s2 + 2], e[8 * s2 + 3]); w.z = cvt2(e[8 * s2 + 4], e[8 * s2 + 5]); w.w = cvt2(e[8 * s2 + 6], e[8 * s2 + 7]); mf[q][s2] = __builtin_bit_cast(bf16x8, w); } }
        f32x16 yd[2][2], yo[2][2];
#pragma unroll
        for (int a = 0; a < 2; ++a)
#pragma unroll
            for (int b = 0; b < 2; ++b)
#pragma unroll
                for (int i = 0; i < 16; ++i) { yd[a][b][i] = 0.f; yo[a][b][i] = 0.f; }
        const LAS unsigned char* xa = lds + SD_XS + (4 * hh + (i16 >> 2)) * SD_XP + (wave * 64 + 16 * gi + 4 * (i16 & 3)) * 2;
#pragma unroll
        for (int pt = 0; pt < 2; ++pt)
#pragma unroll
            for (int st = 0; st < 2; ++st)
#pragma unroll
                for (int s2 = 0; s2 < 2; ++s2) { const LAS unsigned char* a = xa + (st * 32 + 16 * s2) * SD_XP + pt * 64; const bf16x8 xf = cat8(tr_read(a), tr_read(a + 8 * SD_XP));
                    if (st == 0) { yd[pt][0] = MFMA32(xf, mf[0][s2], yd[pt][0]); yd[pt][1] = MFMA32(xf, mf[1][s2], yd[pt][1]); }
                    else yd[pt][1] = MFMA32(xf, mf[2][s2], yd[pt][1]); }
        const bf16* hin = mb.sS + ((((size_t)bl * SSD_HEADS + hd) * (SEQ / 64) + c) * 64 + l31) * 64 + 8 * hh;
#pragma unroll
        for (int ks = 0; ks < 4; ++ks) { bf16x8 cf[2];
#pragma unroll
            for (int tt = 0; tt < 2; ++tt) cf[tt] = *(const LAS bf16x8*)(lds + SD_CM + (tt * 32 + l31) * SD_BP + (16 * ks + 8 * hh) * 2);
#pragma unroll
            for (int pt = 0; pt < 2; ++pt) { const bf16x8 hf = *(const bf16x8*)(hin + pt * 32 * 64 + 16 * ks);
#pragma unroll
                for (int tt = 0; tt < 2; ++tt) yo[pt][tt] = MFMA32(hf, cf[tt], yo[pt][tt]); } }
        const float dsk = dskip[hd];
#pragma unroll
        for (int tt = 0; tt < 2; ++tt) { const int t = tt * 32 + l31; const float ea = __expf(acl[t * 8 + wave]);
#pragma unroll
            for (int pt = 0; pt < 2; ++pt)
#pragma unroll
                for (int r4 = 0; r4 < 4; ++r4) { const int p = pt * 32 + 8 * r4 + 4 * hh; const u32x2 xv = *(const LAS u32x2*)(lds + SD_XS + t * SD_XP + (wave * 64 + p) * 2);
                    const float y0 = yd[pt][tt][4 * r4] + ea * yo[pt][tt][4 * r4] + dsk * bf_lo(xv.x), y1 = yd[pt][tt][4 * r4 + 1] + ea * yo[pt][tt][4 * r4 + 1] + dsk * bf_hi(xv.x);
                    const float y2 = yd[pt][tt][4 * r4 + 2] + ea * yo[pt][tt][4 * r4 + 2] + dsk * bf_lo(xv.y), y3 = yd[pt][tt][4 * r4 + 3] + ea * yo[pt][tt][4 * r4 + 3] + dsk * bf_hi(xv.y);
                    u32x2 w; w.x = cvt2(y0, y1); w.y = cvt2(y2, y3); *(LAS u32x2*)(lds + SD_Y + t * SD_YP + (wave * 64 + p) * 2) = w; } }
        WG_SYNC();
        { const int t = tid >> 3, sub = tid & 7; float u[8][8]; float ss = 0.f;
#pragma unroll
            for (int j = 0; j < 8; ++j) { const int ch = 8 * j + sub; const u32x4 yv = *(const LAS u32x4*)(lds + SD_Y + t * SD_YP + ch * 16);
                const u32x4 zv = *(const u32x4*)(prow + (size_t)t * PROJ_LD + PC_Z + g * 512 + ch * 8);
                u[j][0] = bf_lo(yv.x) * silu_f(bf_lo(zv.x)); u[j][1] = bf_hi(yv.x) * silu_f(bf_hi(zv.x)); u[j][2] = bf_lo(yv.y) * silu_f(bf_lo(zv.y)); u[j][3] = bf_hi(yv.y) * silu_f(bf_hi(zv.y));
                u[j][4] = bf_lo(yv.z) * silu_f(bf_lo(zv.z)); u[j][5] = bf_hi(yv.z) * silu_f(bf_hi(zv.z)); u[j][6] = bf_lo(yv.w) * silu_f(bf_lo(zv.w)); u[j][7] = bf_hi(yv.w) * silu_f(bf_hi(zv.w));
#pragma unroll
                for (int k = 0; k < 8; ++k) ss += u[j][k] * u[j][k]; }
            ss += __shfl_xor(ss, 1); ss += __shfl_xor(ss, 2); ss += __shfl_xor(ss, 4);
            const float rs = 1.0f / sqrtf(ss * (1.0f / 512.0f) + RMS_EPS);
#pragma unroll
            for (int j = 0; j < 8; ++j) { const int ch = 8 * j + sub; const float* ng = norm_g + g * 512 + ch * 8; const f32x4 g0 = *(const f32x4*)ng, g1 = *(const f32x4*)(ng + 4);
                u32x4 w; w.x = cvt2(u[j][0] * rs * g0[0], u[j][1] * rs * g0[1]); w.y = cvt2(u[j][2] * rs * g0[2], u[j][3] * rs * g0[3]);
                w.z = cvt2(u[j][4] * rs * g1[0], u[j][5] * rs * g1[1]); w.w = cvt2(u[j][6] * rs * g1[2], u[j][7] * rs * g1[3]);
                *(u32x4*)(mb.oy + (row0 + t) * D_MIX + GLA_DV + g * 512 + ch * 8) = w; } }
        WG_SYNC();
    }
}

using namespace cfg;
constexpr int RING_OFF = 0, LDSCTL_OFF = 159 * 1024, MISC_OFF = LDSCTL_OFF + 320, LDS_BYTES = 160 * 1024;
constexpr size_t MiB = 1u << 20;
constexpr size_t WS_CTL = 0, CTL_ZERO_BYTES = 1 * MiB;
constexpr int CW_BAR = 4096;
constexpr int HB = 2, MH = HB * SEQ;
constexpr size_t WS_PROJ = 1 * MiB;
constexpr size_t WS_GS = 177 * MiB, WS_GDEC = 241 * MiB, WS_SS = 242 * MiB, WS_SDEC = 274 * MiB, WS_GLOW = 275 * MiB, WS_DTRAW = 276 * MiB;
constexpr size_t WS_H1 = 1 * MiB, WS_QA = 65 * MiB, WS_H2 = 129 * MiB, WS_PICKS = 193 * MiB;
constexpr size_t WS_ACTP = 209 * MiB, WS_WBUF = 337 * MiB, WS_EID = 345 * MiB;
constexpr int CW_PEER = 8192;
constexpr size_t WS_XB = 309 * MiB;
constexpr size_t WS_W = 376 * MiB;
constexpr int N1P = 5632;
constexpr size_t OW_IN = 0, OW_OUT = OW_IN + (size_t)N1P * 1024 * 2, OW_Q = OW_OUT + (size_t)1024 * 2048 * 2, OW_K = OW_Q + 2 * MiB, OW_V = OW_K + 2 * MiB, OW_O = OW_V + 2 * MiB, OW_PQ = OW_O + 2 * MiB, OW_END = OW_PQ + 2 * MiB;
static_assert(OW_END <= 28 * MiB, "weights region");
constexpr size_t WS_U = 404 * MiB, WS_V = 420 * MiB, WS_SU = 436 * MiB, WS_SV = 437 * MiB,
                  WS_MEMB = 468 * MiB, WS_KC = 470 * MiB, WS_VC = 472 * MiB, WS_END = 474 * MiB;

__device__ __forceinline__ void p0_transpose_item(const float* W, int K, int N, bf16* WT, LAS float* scr, int item, int lane) {
    const int nblk = N / 32, kb = item / nblk, nb = item % nblk, k0 = 64 * kb, n0 = 32 * nb;
#pragma unroll 8
    for (int i = 0; i < 32; ++i) { const int kk = 2 * i + (lane >> 5); scr[kk * 33 + (lane & 31)] = W[(size_t)(k0 + kk) * N + n0 + (lane & 31)]; }
    LDS_WAIT(); asm volatile("" ::: "memory");
    const int c = lane & 7;
#pragma unroll
    for (int j = 0; j < 4; ++j) { const int n = (lane >> 3) + 8 * j; const LAS float* s = scr + (8 * c) * 33 + n;
        v4u o; o.x = pk2(s[0 * 33], s[1 * 33]); o.y = pk2(s[2 * 33], s[3 * 33]); o.z = pk2(s[4 * 33], s[5 * 33]); o.w = pk2(s[6 * 33], s[7 * 33]);
        *(GAS v4u*)(WT + (size_t)(n0 + n) * K + k0 + 8 * c) = o; }
    LDS_WAIT(); asm volatile("" ::: "memory");
}
__device__ __forceinline__ void cvt_rows(const float* src, bf16* dst, long n, long gtid, long nthr) {
    for (long i = gtid * 8; i < n; i += nthr * 8) { const f32x4 a = *(const f32x4*)(src + i), b = *(const f32x4*)(src + i + 4);
        v4u o; o.x = cvt2(a.x, a.y); o.y = cvt2(a.z, a.w); o.z = cvt2(b.x, b.y); o.w = cvt2(b.z, b.w); *(v4u*)(dst + i) = o; }
}
__device__ __forceinline__ void cvt_rows_ld(const float* src, bf16* dst, long n, long gtid, long nthr) { cvt_rows(src, dst, n, gtid, nthr); }

struct In27 { const float* p[27]; };
struct Args { In27 in; float* out; unsigned char* ws; };

__global__ void __launch_bounds__(NTHR, 2) mega(Args args) {
    extern __shared__ __attribute__((aligned(16))) unsigned char lds_raw[];
    LAS unsigned char* lds = (LAS unsigned char*)lds_raw;
    volatile LAS unsigned* MISC = (volatile LAS unsigned*)(lds + MISC_OFF);
    const int tid = threadIdx.x, lane = tid & 63, wave = __builtin_amdgcn_readfirstlane(tid >> 6);
    const int G = gridDim.x; const int bx = blockIdx.x; const int vcu = (G % 8 == 0) ? (bx % 8) * (G / 8) + bx / 8 : bx;
    unsigned char* ws = args.ws;
    gu32* ctl = (gu32*)(ws + WS_CTL);
    for (int u = tid; u < (LDS_BYTES - LDSCTL_OFF) / 4; u += NTHR) ((LAS unsigned*)(lds + LDSCTL_OFF))[u] = 0u;
    __syncthreads();
    XcdBarrier bar = xcd_barrier_post((unsigned*)(ctl + CW_BAR), MISC + 8);
    const long nthr = (long)G * NTHR;
    const int gw = vcu * NWAVES + wave, NGW = G * NWAVES;
#define GRID_BAR() xcd_barrier(bar)
    {
        unsigned char* ws = args.ws; asm volatile("" : "+s"(ws));
        unsigned char* wbase = ws + WS_W;
        bf16* w_in_t = (bf16*)(wbase + OW_IN); bf16* w_out_t = (bf16*)(wbase + OW_OUT); bf16* wq_t = (bf16*)(wbase + OW_Q); bf16* wk_t = (bf16*)(wbase + OW_K);
        bf16* wv_t = (bf16*)(wbase + OW_V); bf16* wo_t = (bf16*)(wbase + OW_O); bf16* pwq_t = (bf16*)(wbase + OW_PQ);
        bf16* x_bf = (bf16*)(ws + WS_XB); unsigned char* u8 = ws + WS_U; unsigned char* v8 = ws + WS_V; float* su = (float*)(ws + WS_SU); float* sv = (float*)(ws + WS_SV); bf16* mem_bf = (bf16*)(ws + WS_MEMB);
        bf16* kc = (bf16*)(ws + WS_KC); bf16* vc = (bf16*)(ws + WS_VC);
        bf16* h1 = (bf16*)(ws + WS_H1); bf16* qa = (bf16*)(ws + WS_QA); bf16* h2 = (bf16*)(ws + WS_H2); unsigned* picks = (unsigned*)(ws + WS_PICKS);
        bf16* oy_all = (bf16*)args.out;
        bf16* projb = (bf16*)(ws + WS_PROJ);
        const long gtid = (long)bx * NTHR + tid;
        LAS float* scr = (LAS float*)(lds + RING_OFF + wave * 16384);
        constexpr int I_IN = (D_MODEL / 64) * (D_IN_PROJ / 32), I_OUT = (D_MIX / 64) * (D_MODEL / 32), I_SQ = (D_MODEL / 64) * (D_MODEL / 32);
        constexpr int NITEMS = I_IN + I_OUT + 5 * I_SQ;
        for (int it = gw; it < NITEMS; it += NGW) {
            int r = it; const float* W; int K = D_MODEL, N = D_MODEL; bf16* WT;
            if (r < I_IN) { W = args.in.p[2]; N = D_IN_PROJ; WT = w_in_t; }
            else if ((r -= I_IN) < I_OUT) { W = args.in.p[12]; K = D_MIX; WT = w_out_t; }
            else { r -= I_OUT; const int which = r / I_SQ; r -= which * I_SQ; const int idx = which == 0 ? 15 : which == 1 ? 16 : which == 2 ? 17 : which == 3 ? 18 : 21; W = args.in.p[idx]; WT = wq_t + (size_t)which * D_MODEL * D_MODEL; }
            p0_transpose_item(W, K, N, WT, scr, r, lane);
        }
        for (long i = gtid * 8; i < (long)(N1P - D_IN_PROJ) * D_MODEL; i += nthr * 8) *(v4u*)(w_in_t + (size_t)D_IN_PROJ * D_MODEL + i) = (v4u){0u, 0u, 0u, 0u};
        cvt_fp8_rows(args.in.p[23], u8, su, PEER_EXPERTS, gw, NGW, lane);
        cvt_fp8_rows(args.in.p[24], v8, sv, PEER_EXPERTS, gw, NGW, lane);
        cvt_rows(args.in.p[1], mem_bf, (long)BATCH * MEM_LEN * D_MODEL, gtid, nthr);
        cvt_rows(args.in.p[0], x_bf, (long)NTOK * D_MODEL, gtid, nthr);
        GRID_BAR();
    }
#ifndef REPG
#define REPG 0
#endif
    constexpr int PROG0[] = {0, 1, 2, 3, 4, 5, 6, 7, 8, 9, 10, 11, 12, 13, 14, 15, 16, 17, 18, 19, 20, 21};
    constexpr int PROG1[] = {0, 1, 2, 3, 4, 5, 6, 7, 8, 9, 10, 11, 12, 13, 14, 15, 16, 17, 18, 19, 20, 21, 21};
    constexpr int PROG2[] = {0, 0, 1, 2, 3, 4, 4, 5, 6, 7, 8, 9, 10, 11, 12, 13, 14, 15, 16, 17, 18, 19, 20, 21};
    constexpr int PROG3[] = {0, 1, 2, 3, 1, 2, 3, 4, 5, 6, 7, 5, 6, 7, 8, 9, 10, 11, 12, 13, 14, 15, 16, 17, 18, 19, 20, 21};
    constexpr int PROG4[] = {0, 1, 2, 3, 4, 5, 6, 7, 8, 9, 10, 11, 12, 13, 14, 15, 16, 17, 8, 9, 10, 11, 12, 13, 14, 15, 16, 17, 18, 19, 20, 21};
    constexpr int PROGN = REPG == 0 ? 22 : REPG == 1 ? 23 : REPG == 2 ? 24 : REPG == 3 ? 28 : 32;
    for (int pi = 0; pi < PROGN; ++pi) {
        const int st = REPG == 0 ? PROG0[pi] : REPG == 1 ? PROG1[pi] : REPG == 2 ? PROG2[pi] : REPG == 3 ? PROG3[pi] : PROG4[pi];
        unsigned char* ws = args.ws; asm volatile("" : "+s"(ws));
        unsigned char* wbase = ws + WS_W;
        bf16* w_in_t = (bf16*)(wbase + OW_IN); bf16* w_out_t = (bf16*)(wbase + OW_OUT); bf16* wq_t = (bf16*)(wbase + OW_Q); bf16* wk_t = (bf16*)(wbase + OW_K);
        bf16* wv_t = (bf16*)(wbase + OW_V); bf16* wo_t = (bf16*)(wbase + OW_O); bf16* pwq_t = (bf16*)(wbase + OW_PQ);
        bf16* x_bf = (bf16*)(ws + WS_XB); unsigned char* u8 = ws + WS_U; unsigned char* v8 = ws + WS_V; float* su = (float*)(ws + WS_SU); float* sv = (float*)(ws + WS_SV); bf16* mem_bf = (bf16*)(ws + WS_MEMB);
        bf16* kc = (bf16*)(ws + WS_KC); bf16* vc = (bf16*)(ws + WS_VC);
        bf16* h1 = (bf16*)(ws + WS_H1); bf16* qa = (bf16*)(ws + WS_QA); bf16* h2 = (bf16*)(ws + WS_H2); unsigned* picks = (unsigned*)(ws + WS_PICKS);
        bf16* oy_all = (bf16*)args.out;
        bf16* projb = (bf16*)(ws + WS_PROJ);
        int tid_ = threadIdx.x; asm volatile("" : "+v"(tid_));
        const long gtid = (long)bx * NTHR + tid_;
        int gk = -1; const int hf = st >> 2;
        if (st < 8) {
            MixBufs mb{projb, (const float*)(ws + WS_GLOW), (const float*)(ws + WS_DTRAW), (bf16*)(ws + WS_GS), (float*)(ws + WS_GDEC), (bf16*)(ws + WS_SS), (float*)(ws + WS_SDEC), oy_all + (size_t)hf * MH * D_MIX, HB};
            switch (st & 3) {
            case 0: gk = 0; break;
            case 1: ssd_a_phase(lds, mb, args.in.p[6], args.in.p[7], args.in.p[8], args.in.p[9], G, bx, tid_); gla_a_phase(lds, mb, args.in.p[3], args.in.p[4], G, bx, tid_); break;
            case 2: ssd_b_phase(mb, gtid, nthr); gla_b_phase(mb, gtid, nthr); break;
            default: ssd_c_phase(lds, mb, args.in.p[6], args.in.p[7], args.in.p[8], args.in.p[9], args.in.p[10], args.in.p[11], G, bx, tid_);
                     gla_c_phase(lds, mb, args.in.p[3], args.in.p[4], args.in.p[5], G, bx, tid_); break;
            }
        } else {
            switch (st) {
            case 8: gk = 1; break;
            case 9: ln_rows_bf16(h1, args.in.p[13], args.in.p[14], NTOK, gw, NGW, tid_ & 63); break;
            case 10: gk = 2; break;
            case 11: gk = 3; break;
            case 12: gk = 4; break;
            case 13: attn_phase(lds, qa, kc, vc, G, bx, tid_); break;
            case 14: gk = 5; break;
            case 15: ln_rows_bf16(h2, args.in.p[19], args.in.p[20], NTOK, gw, NGW, tid_ & 63); break;
            case 16: gk = 6; break;
            case 17: topk_phase(lds, qa, args.in.p[22], picks, (bf16*)(ws + WS_EID), G, bx, tid_); break;
            case 18: peer_u_phase(MISC + 16, h2, (const bf16*)(ws + WS_EID), u8, (float*)(ws + WS_ACTP), ctl + CW_PEER, tid_); break;
            case 19: peer_w_pass(picks, (const float*)(ws + WS_ACTP), su, sv, (bf16*)(ws + WS_WBUF), gw, NGW, tid_ & 63); break;
            case 20: peer_v_phase(MISC + 16, (const bf16*)(ws + WS_EID), (const bf16*)(ws + WS_WBUF), v8, qa, ctl + CW_PEER + 1024, tid_); break;
            default: peer_ln_pass(h2, qa, args.in.p[25], args.in.p[26], args.out, gw, NGW, tid_ & 63); break;
            }
        }
        if (gk >= 0) {
            const bf16* A; const bf16* Bt; int M = NTOK, N = D_MODEL, K = D_MODEL; pg8::EpiGen E{0, nullptr, D_MODEL, nullptr, nullptr, nullptr};
            switch (gk) {
            case 0: A = x_bf + (size_t)hf * MH * D_MODEL; Bt = w_in_t; M = MH; N = N1P; E.out = projb; E.ldc = N1P; E.side0 = (float*)(ws + WS_GLOW); E.side1 = (float*)(ws + WS_DTRAW); break;
            case 1: A = oy_all; Bt = w_out_t; K = D_MIX; E.mode = 1; E.out = h1; E.res = args.in.p[0]; break;
            case 2: A = h1; Bt = wq_t; E.out = qa; break;
            case 3: A = mem_bf; Bt = wk_t; M = BATCH * MEM_LEN; E.out = kc; break;
            case 4: A = mem_bf; Bt = wv_t; M = BATCH * MEM_LEN; E.out = vc; break;
            case 5: A = qa; Bt = wo_t; E.mode = 2; E.out = h2; E.res = h1; break;
            default: A = h2; Bt = pwq_t; E.out = qa; break;
            }
            pg8::Gemm g{(const pg8::bf16_t*)A, (const pg8::bf16_t*)Bt, M, N, K}; pg8::StaticOrder S; S.init(M, N, G, bx);
            pg8::gemm_phase<pg8::EpiGen, pg8::StaticOrder, true, true>(lds + RING_OFF, g, S, E);
        }
        GRID_BAR();
    }
}

extern "C" void kernel_launch(void* const* d_in, const int* in_sizes, int n_in, void* d_out, int out_size, void* d_ws, size_t ws_size, hipStream_t stream) {
    static int grid = 0;
    if (grid == 0) {
        int dev = 0, cus = 0, per_cu = 0;
        if (hipGetDevice(&dev) != hipSuccess || hipDeviceGetAttribute(&cus, hipDeviceAttributeMultiprocessorCount, dev) != hipSuccess) { fprintf(stderr, "kernel_launch: device query failed\n"); grid = -1; return; }
        if (hipFuncSetAttribute((const void*)mega, hipFuncAttributeMaxDynamicSharedMemorySize, LDS_BYTES) != hipSuccess) { fprintf(stderr, "kernel_launch: hipFuncSetAttribute failed\n"); grid = -1; return; }
        if (hipOccupancyMaxActiveBlocksPerMultiprocessor(&per_cu, (const void*)mega, NTHR, LDS_BYTES) != hipSuccess || per_cu < 1) fprintf(stderr, "kernel_launch: occupancy query says %d\n", per_cu);
        (void)hipGetLastError();
        if (ws_size < WS_END) { fprintf(stderr, "kernel_launch: workspace too small: ws %zu need %zu\n", ws_size, (size_t)WS_END); grid = -1; return; }
        grid = cus;
    }
    if (grid < 0) return;
    if (hipMemsetAsync((char*)d_ws + WS_CTL, 0, CTL_ZERO_BYTES, stream) != hipSuccess) { fprintf(stderr, "kernel_launch: memset failed\n"); return; }
    Args a{};
    for (int i = 0; i < 27; ++i) a.in.p[i] = (const float*)d_in[i];
    a.out = (float*)d_out; a.ws = (unsigned char*)d_ws;
    hipLaunchKernelGGL(mega, dim3(grid), dim3(NTHR), LDS_BYTES, stream, a);
}
```

```cpp
#include <hip/hip_runtime.h>
#include <cmath>
#include <cstdio>
#include <cstdint>
#define HD __device__ __forceinline__
namespace cfg {
#ifdef SMALL
constexpr int D_MODEL = 128, BATCH = 2, SEQ = 64, GLA_HEADS = 4, GLA_GATE_RANK = 4, SSD_HEADDIM = 16, SSD_GROUPS = 2, SSD_STATE = 16, SSD_CONV = 4,
              MEM_LEN = 16, MEM_HEADS = 2, PEER_HEADS = 2, PEER_N_KEYS = 16, PEER_KEY_DIM = 16, PEER_TOPK = 4;
#else
constexpr int D_MODEL = 1024, BATCH = 4, SEQ = 8192, GLA_HEADS = 4, GLA_GATE_RANK = 16, SSD_HEADDIM = 64, SSD_GROUPS = 2, SSD_STATE = 64, SSD_CONV = 4,
              MEM_LEN = 256, MEM_HEADS = 4, PEER_HEADS = 8, PEER_N_KEYS = 128, PEER_KEY_DIM = 128, PEER_TOPK = 16;
#endif
constexpr int D_MIX = 2 * D_MODEL, GLA_DV = D_MIX / 2, GLA_DK = GLA_DV / 2, GLA_HEAD_K = GLA_DK / GLA_HEADS, GLA_HEAD_V = GLA_DV / GLA_HEADS;
constexpr float GLA_GATE_TAU = 16.0f;
constexpr int SSD_DINNER = D_MIX - GLA_DV, SSD_HEADS = SSD_DINNER / SSD_HEADDIM, SSD_HPG = SSD_HEADS / SSD_GROUPS, SSD_CONV_DIM = SSD_DINNER + 2 * SSD_GROUPS * SSD_STATE;
constexpr int D_IN_PROJ = GLA_DK * 2 + GLA_DV * 2 + GLA_GATE_RANK + SSD_DINNER + SSD_CONV_DIM + SSD_HEADS;
constexpr int MEM_HEAD_DIM = D_MODEL / MEM_HEADS, PEER_EXPERTS = PEER_N_KEYS * PEER_N_KEYS, PEER_HALF = PEER_KEY_DIM / 2;
constexpr float ALPHA = 1.189207115002721f;
constexpr float LN_EPS = 1e-5f, RMS_EPS = 1e-6f;
constexpr int NTOK = BATCH * SEQ;
}
namespace pg8 {
#define PG8_LAS __attribute__((address_space(3)))
typedef unsigned short bf16_t;
typedef short bf16x8 __attribute__((ext_vector_type(8)));
typedef float f32x4 __attribute__((ext_vector_type(4)));
typedef unsigned u32x4 __attribute__((ext_vector_type(4)));
constexpr int BM = 256, BK = 64, HALF = 128, HTB = HALF * BK * 2  , STAGE_BYTES = 8 * HTB, NXCD = 8, WGM = 8;

__host__ __device__ __forceinline__ int lds_byte(int r, int c) { const int st = (r >> 4) * 2 + (c >> 5), rr = r & 15, cc = c & 31, ob = rr * 64 + cc * 2; return st * 1024 + (ob ^ (((ob >> 9) & 1) << 5)); }
__host__ __device__ __forceinline__ void stage_rc(int b, int& R, int& C) { const int st = b / 1024, sb = b % 1024, swz = sb ^ (((sb >> 9) & 1) << 5); R = (st >> 1) * 16 + swz / 64; C = (st & 1) * 32 + (swz % 64) / 2; }
__host__ __device__ __forceinline__ int perm32(int rho) { const int n = rho >> 4, i = rho & 15; return 8 * (i >> 2) + 4 * n + (i & 3); }

struct Unit { int pm, pn; };
struct Gemm { const bf16_t* A; const bf16_t* Bt; int M, N, K; };

struct StaticOrder {
    int nM, nN, nwg, G, c;
    __host__ __device__ void init(int M, int N, int G_, int c_) { nM = M / BM; nN = N / BM; nwg = nM * nN; G = G_; c = c_; }
    __host__ __device__ bool next(int i, Unit& u) const {
        const long L = (long)i * G + c; if (L >= nwg) return false;
        int wgid = (int)L; { const int q = nwg / NXCD, r = nwg % NXCD, xcd = wgid % NXCD, off = wgid / NXCD; wgid = (xcd < r ? xcd * (q + 1) : r * (q + 1) + (xcd - r) * q) + off; }
        const int nig = WGM * nN, gid = wgid / nig, fm = gid * WGM, gsz = (nM - fm) < WGM ? (nM - fm) : WGM;
        u.pm = fm + ((wgid % nig) % gsz); u.pn = (wgid % nig) / gsz; return true;
    }
    __device__ __forceinline__ void a_ready(const Unit&) const {}
    __device__ __forceinline__ void done(const Unit&) const {}
};

__device__ __forceinline__ unsigned cvt_pk_bf16(float lo, float hi) { unsigned r; asm volatile("v_cvt_pk_bf16_f32 %0, %1, %2" : "=v"(r) : "v"(lo), "v"(hi)); return r; }
typedef float f32x2 __attribute__((ext_vector_type(2)));
struct EpiF32 {
    static constexpr bool PERM = false, AFTER_DRAIN = false;
    float* C; int ldc; int ncols;
    __device__ __forceinline__ void operator()(const f32x4 (&acc)[2][2][4][2], const Unit& u, int wr, int wc, int fr, int fq) const {
        const int row0 = u.pm * BM + wr * 64 + fr, col0 = u.pn * BM + wc * 32 + 4 * fq;
#pragma unroll
        for (int ai = 0; ai < 2; ++ai)
#pragma unroll
            for (int m = 0; m < 4; ++m) { float* rowp = C + (size_t)(row0 + ai * HALF + m * 16) * ldc + col0;
#pragma unroll
                for (int bj = 0; bj < 2; ++bj)
#pragma unroll
                    for (int n = 0; n < 2; ++n) if (col0 + bj * HALF + n * 16 < ncols) *(f32x4*)(rowp + bj * HALF + n * 16) = acc[ai][bj][m][n]; }
    }
};
template <class Epi, class Sched, bool ALIGN_EPI = false, bool SP2 = false>
__device__ __forceinline__ void gemm_phase(PG8_LAS unsigned char* lds, const Gemm g, const Sched& S, const Epi& E) {
    int tid_o = threadIdx.x; asm volatile("" : "+v"(tid_o));
    const int tid = tid_o, wid = __builtin_amdgcn_readfirstlane(tid >> 6), lane = tid & 63, wr = wid >> 2, wc = wid & 3, fr = lane & 15, fq = lane >> 4;
    const int K = g.K, nt = K / BK;
    unsigned voffA[2], voffB[2];
#pragma unroll
    for (int i = 0; i < 2; ++i) { int R, C; stage_rc(tid * 16 + i * 8192, R, C); const int Rb = Epi::PERM ? ((R & ~31) + perm32(R & 31)) : R;
        voffA[i] = (unsigned)(R * K + C) * 2u; voffB[i] = (unsigned)(Rb * K + C) * 2u; }
    const size_t kstep = (size_t)(BK * 2);
    const size_t hstep = (size_t)HALF * K * 2;
    const size_t tstep = 2 * hstep;
    const unsigned ldsw = (unsigned)wid * 1024u;
    const int aoff = lds_byte(wr * 64 + fr, fq * 8), boff = lds_byte(wc * 32 + fr, fq * 8);
#define PG8_SA(b, h) (((b) * 2 + (h)) * HTB)
#define PG8_SB(b, h) ((4 + (b) * 2 + (h)) * HTB)
#define PG8_STAGE(bufoff, gbase, voff) do { _Pragma("unroll") for (int _i = 0; _i < 2; ++_i) \
        __builtin_amdgcn_global_load_lds((const unsigned*)((const char*)(gbase) + (voff)[_i]), (PG8_LAS unsigned*)(lds + (bufoff) + ldsw + _i * 8192), 16, 0, 0); } while (0)
#define PG8_LDA(dst, b, h) do { _Pragma("unroll") for (int m = 0; m < 4; ++m) _Pragma("unroll") for (int k = 0; k < 2; ++k) dst[m][k] = *(const PG8_LAS bf16x8*)(lds + PG8_SA(b, h) + aoff + m * 2048 + k * 1024); } while (0)
#define PG8_LDB(dst, b, h) do { _Pragma("unroll") for (int n = 0; n < 2; ++n) _Pragma("unroll") for (int k = 0; k < 2; ++k) dst[n][k] = *(const PG8_LAS bf16x8*)(lds + PG8_SB(b, h) + boff + n * 2048 + k * 1024); } while (0)
#define PG8_MMA(ai, bj, At, Bt) do { __builtin_amdgcn_s_setprio(1); _Pragma("unroll") for (int m = 0; m < 4; ++m) _Pragma("unroll") for (int n = 0; n < 2; ++n) _Pragma("unroll") for (int k = 0; k < 2; ++k) \
        acc[ai][bj][m][n] = __builtin_amdgcn_mfma_f32_16x16x32_bf16(Bt[n][k], At[m][k], acc[ai][bj][m][n], 0, 0, 0); __builtin_amdgcn_s_setprio(0); } while (0)
#define PG8_WAIT_V(n) asm volatile("s_waitcnt vmcnt(" #n ")" ::: "memory")
#define PG8_WAIT_L(n) asm volatile("s_waitcnt lgkmcnt(" #n ")" ::: "memory")
#define PG8_BAR __builtin_amdgcn_s_barrier()
#define PG8_SCHED __builtin_amdgcn_sched_barrier(0)
    Unit cur, nxt; int ui = 0;
    if (!S.next(0, cur)) return;
    f32x4 acc[2][2][4][2];
#pragma unroll
    for (int a = 0; a < 2; ++a)
#pragma unroll
        for (int b = 0; b < 2; ++b)
#pragma unroll
            for (int m = 0; m < 4; ++m)
#pragma unroll
                for (int n = 0; n < 2; ++n) acc[a][b][m][n] = (f32x4){0.f, 0.f, 0.f, 0.f};
    bf16x8 At[4][2], B0[2][2], B1[2][2];
    const char* cA = (const char*)g.A + (size_t)cur.pm * tstep; const char* cB = (const char*)g.Bt + (size_t)cur.pn * tstep;
    S.a_ready(cur);
    if constexpr (SP2) {
        PG8_STAGE(PG8_SB(0, 0), cB, voffB); PG8_STAGE(PG8_SB(0, 1), cB + hstep, voffB); PG8_STAGE(PG8_SA(0, 0), cA, voffA); PG8_STAGE(PG8_SA(0, 1), cA + hstep, voffA);
        if (wr == 1) PG8_BAR;
        PG8_WAIT_V(2); PG8_BAR;
        PG8_STAGE(PG8_SB(1, 0), cB + kstep, voffB); PG8_STAGE(PG8_SA(1, 0), cA + kstep, voffA); PG8_STAGE(PG8_SB(1, 1), cB + hstep + kstep, voffB);
        PG8_WAIT_V(6); PG8_BAR;
    } else {
        PG8_STAGE(PG8_SB(0, 0), cB, voffB); PG8_STAGE(PG8_SA(0, 0), cA, voffA); PG8_STAGE(PG8_SB(0, 1), cB + hstep, voffB); PG8_STAGE(PG8_SA(0, 1), cA + hstep, voffA);
        if (wr == 1) PG8_BAR;
        PG8_WAIT_V(4); PG8_BAR;
        PG8_STAGE(PG8_SB(1, 0), cB + kstep, voffB); PG8_STAGE(PG8_SA(1, 0), cA + kstep, voffA); PG8_STAGE(PG8_SB(1, 1), cB + hstep + kstep, voffB);
        PG8_WAIT_V(6); PG8_BAR;
    }
    for (;;) {
        const bool has_next = S.next(ui + 1, nxt);
        const char* nA = has_next ? (const char*)g.A + (size_t)nxt.pm * tstep : cA; const char* nB = has_next ? (const char*)g.Bt + (size_t)nxt.pn * tstep : cB;
        for (int t = 0; t < nt; t += 2) {
            const bool last = (t == nt - 2);
            const char* a1 = cA + (size_t)(t + 1) * kstep;
            const char* a2 = last ? nA : cA + (size_t)(t + 2) * kstep; const char* b2 = last ? nB : cB + (size_t)(t + 2) * kstep;
            const char* a3 = a2 + kstep; const char* b3 = b2 + kstep;
            if (last && has_next) S.a_ready(nxt);
            if constexpr (SP2) {
            PG8_LDB(B0, 0, 0); PG8_LDB(B1, 0, 1); PG8_SCHED; PG8_LDA(At, 0, 0); PG8_STAGE(PG8_SA(1, 1), a1 + hstep, voffA);
            PG8_WAIT_V(8); PG8_WAIT_L(0); PG8_BAR; PG8_MMA(0, 0, At, B0); PG8_MMA(0, 1, At, B1); PG8_BAR; PG8_SCHED;
            PG8_LDA(At, 0, 1); PG8_STAGE(PG8_SB(0, 0), b2, voffB); PG8_STAGE(PG8_SB(0, 1), b2 + hstep, voffB); PG8_STAGE(PG8_SA(0, 0), a2, voffA);
            PG8_WAIT_V(8); PG8_WAIT_L(0); PG8_BAR; PG8_MMA(1, 0, At, B0); PG8_MMA(1, 1, At, B1); PG8_BAR; PG8_SCHED;
            PG8_LDB(B0, 1, 0); PG8_LDB(B1, 1, 1); PG8_SCHED; PG8_LDA(At, 1, 0); PG8_STAGE(PG8_SA(0, 1), a2 + hstep, voffA);
            PG8_WAIT_V(8); PG8_WAIT_L(0); PG8_BAR; PG8_MMA(0, 0, At, B0); PG8_MMA(0, 1, At, B1); PG8_BAR; PG8_SCHED;
            PG8_LDA(At, 1, 1); PG8_STAGE(PG8_SB(1, 0), b3, voffB); PG8_STAGE(PG8_SB(1, 1), b3 + hstep, voffB); PG8_STAGE(PG8_SA(1, 0), a3, voffA);
            PG8_WAIT_V(8); PG8_WAIT_L(0); PG8_BAR; PG8_MMA(1, 0, At, B0); PG8_MMA(1, 1, At, B1); PG8_BAR; PG8_SCHED;
            } else {
            PG8_LDB(B0, 0, 0); PG8_SCHED; PG8_LDA(At, 0, 0); PG8_STAGE(PG8_SA(1, 1), a1 + hstep, voffA);
            PG8_WAIT_L(8); PG8_BAR; PG8_WAIT_L(0); PG8_MMA(0, 0, At, B0); PG8_BAR; PG8_SCHED;
            PG8_LDB(B1, 0, 1); PG8_STAGE(PG8_SB(0, 0), b2, voffB);
            PG8_BAR; PG8_WAIT_L(0); PG8_MMA(0, 1, At, B1); PG8_BAR;
            PG8_LDA(At, 0, 1); PG8_STAGE(PG8_SA(0, 0), a2, voffA);
            PG8_BAR; PG8_WAIT_L(0); PG8_MMA(1, 0, At, B0); PG8_BAR; PG8_SCHED;
            PG8_STAGE(PG8_SB(0, 1), b2 + hstep, voffB);
            PG8_WAIT_V(6); PG8_BAR; PG8_MMA(1, 1, At, B1); PG8_BAR;
            PG8_LDB(B0, 1, 0); PG8_SCHED; PG8_LDA(At, 1, 0); PG8_STAGE(PG8_SA(0, 1), a2 + hstep, voffA);
            PG8_WAIT_L(8); PG8_BAR; PG8_WAIT_L(0); PG8_MMA(0, 0, At, B0); PG8_BAR; PG8_SCHED;
            PG8_LDB(B1, 1, 1); PG8_STAGE(PG8_SB(1, 0), b3, voffB);
            PG8_BAR; PG8_WAIT_L(0); PG8_MMA(0, 1, At, B1); PG8_BAR;
            PG8_LDA(At, 1, 1); PG8_STAGE(PG8_SA(1, 0), a3, voffA);
            PG8_BAR; PG8_WAIT_L(0); PG8_MMA(1, 0, At, B0); PG8_BAR; PG8_SCHED;
            PG8_STAGE(PG8_SB(1, 1), b3 + hstep, voffB);
            PG8_WAIT_V(6); PG8_BAR; PG8_MMA(1, 1, At, B1); PG8_BAR;
            }
        }
        if constexpr (ALIGN_EPI) { if (wr == 0) PG8_BAR; }
        if constexpr (!Epi::AFTER_DRAIN) { E(acc, cur, wr, wc, fr, fq); S.done(cur); }
        if (!has_next) break;
#pragma unroll
        for (int a = 0; a < 2; ++a)
#pragma unroll
            for (int b = 0; b < 2; ++b)
#pragma unroll
                for (int m = 0; m < 4; ++m)
#pragma unroll
                    for (int n = 0; n < 2; ++n) acc[a][b][m][n] = (f32x4){0.f, 0.f, 0.f, 0.f};
        cur = nxt; cA = nA; cB = nB; ++ui;
        if constexpr (ALIGN_EPI) { if (wr == 1) PG8_BAR; }
    }
    PG8_WAIT_V(0);
    if constexpr (!ALIGN_EPI) { if (wr == 0) PG8_BAR; }
    PG8_BAR;
    if constexpr (Epi::AFTER_DRAIN) { E.fused(acc, cur, wr, wc, fr, fq, lds, wid, lane); S.done(cur); }
#undef PG8_SA
#undef PG8_SB
#undef PG8_STAGE
#undef PG8_LDA
#undef PG8_LDB
#undef PG8_MMA
#undef PG8_WAIT_V
#undef PG8_WAIT_L
#undef PG8_BAR
#undef PG8_SCHED
}
}
#define GAS __attribute__((address_space(1)))
#define LAS __attribute__((address_space(3)))
typedef unsigned short bf16;
typedef unsigned v4u __attribute__((ext_vector_type(4)));
typedef float f32x4 __attribute__((ext_vector_type(4)));
typedef short bf16x8 __attribute__((ext_vector_type(8)));
typedef GAS unsigned gu32;
typedef GAS unsigned long long gu64;
#define RLX_AGENT __ATOMIC_RELAXED, __HIP_MEMORY_SCOPE_AGENT
#define LDS_WAIT() asm volatile("s_waitcnt lgkmcnt(0)" ::: "memory")
#define VM_WAIT() asm volatile("s_waitcnt vmcnt(0)" ::: "memory")
__device__ __forceinline__ unsigned long long rt() { return __builtin_amdgcn_s_memrealtime(); }
__device__ __forceinline__ unsigned f2bf(float f) { unsigned u = __builtin_bit_cast(unsigned, f); return (u + 0x7fffu + ((u >> 16) & 1u)) >> 16; }
__device__ __forceinline__ unsigned pk2(float lo, float hi) { return f2bf(lo) | (f2bf(hi) << 16); }
#define XB_TMO      128
#define XB_XCNT(j)  (256  + 64 * (j))
#define XB_XSUB(j)  (1280 + 64 * (j))
#define XB_XGEN(j)  (2304 + 64 * (j))
#define XB_TOP      3328
#define XB_TOPGEN   3392
#define XCD_BAR_WORDS 3456
#define XB_SPIN_CAP (1u << 27)

__device__ __forceinline__ unsigned xb_ld(unsigned* p)              { return __hip_atomic_load(p, __ATOMIC_RELAXED, __HIP_MEMORY_SCOPE_AGENT); }
__device__ __forceinline__ unsigned xb_add(unsigned* p, unsigned v) { return __hip_atomic_fetch_add(p, v, __ATOMIC_RELAXED, __HIP_MEMORY_SCOPE_AGENT); }
__device__ __forceinline__ unsigned xb_xcc_id() { return (unsigned)__builtin_amdgcn_s_getreg((3 << 11) | 20) & 0xFu; }
#define XB_SPIN(cond, bar) do { unsigned _sp = 0; while (cond) { __builtin_amdgcn_s_sleep(1); \
    if ((++_sp & 255u) == 0u) { if (xb_ld(&(bar)[XB_TMO])) break; if (_sp > XB_SPIN_CAP) { atomicAdd(&(bar)[XB_TMO], 1u); break; } } } } while (0)

struct XcdBarrier {
    unsigned* bar; unsigned x;
    volatile LAS unsigned* st;
};

__device__ __forceinline__ XcdBarrier xcd_barrier_post(unsigned* bar, volatile LAS unsigned* st) {
    XcdBarrier b; b.bar = bar; b.x = xb_xcc_id(); b.st = st;
    if (threadIdx.x == 0) (void)xb_add(&bar[XB_XCNT(b.x)], 1u);
    return b;
}
__device__ __forceinline__ void xcd_barrier_complete(unsigned* bar, unsigned x, unsigned& nloc, unsigned& nx) {
    const unsigned G = gridDim.x * gridDim.y * gridDim.z;
    unsigned sum, cnt, mine, sp = 0u;
    for (;;) {
        sum = 0u; cnt = 0u; mine = 0u;
#pragma unroll
        for (unsigned j = 0; j < 16; ++j) { const unsigned c = xb_ld(&bar[XB_XCNT(j)]); sum += c; cnt += (c > 0u) ? 1u : 0u; mine = (j == x) ? c : mine; }
        if (sum == G) break;
        __builtin_amdgcn_s_sleep(1);
        if ((++sp & 255u) == 0u) { if (xb_ld(&bar[XB_TMO])) break; if (sp > XB_SPIN_CAP) { atomicAdd(&bar[XB_TMO], 1u); break; } }
    }
    nloc = mine > 0u ? mine : 1u; nx = cnt > 0u ? cnt : 1u;
}

__device__ __forceinline__ void xcd_barrier(const XcdBarrier& b) {
    asm volatile("s_waitcnt vmcnt(0)" ::: "memory");
    __syncthreads();
    if (threadIdx.x == 0) {
        unsigned* bar = b.bar;
        __builtin_amdgcn_s_waitcnt(0);
        unsigned nloc = b.st[0], nx = b.st[1];
        if (nloc == 0u) { xcd_barrier_complete(bar, b.x, nloc, nx); b.st[0] = nloc; b.st[1] = nx; }
        const unsigned old = xb_add(&bar[XB_XSUB(b.x)], 1u);
        const unsigned gen = old / nloc;
        if (old + 1u == (gen + 1u) * nloc) {
            __builtin_amdgcn_fence(__ATOMIC_RELEASE, "agent");
            asm volatile("s_waitcnt vmcnt(0)" ::: "memory");
            const unsigned og = xb_add(&bar[XB_TOP], 1u);
            const unsigned tg = og / nx;
            if (og + 1u == (tg + 1u) * nx) xb_add(&bar[XB_TOPGEN], 1u);
            else XB_SPIN(xb_ld(&bar[XB_TOPGEN]) == tg, bar);
            __builtin_amdgcn_fence(__ATOMIC_ACQUIRE, "agent");
            xb_add(&bar[XB_XGEN(b.x)], 1u);
            asm volatile("s_waitcnt vmcnt(0)" ::: "memory");
        } else {
            XB_SPIN(xb_ld(&bar[XB_XGEN(b.x)]) == gen, bar);
            __builtin_amdgcn_fence(__ATOMIC_ACQUIRE, "agent");
            asm volatile("s_waitcnt vmcnt(0)" ::: "memory");
        }
    }
    __syncthreads();
}
typedef float f32x16 __attribute__((ext_vector_type(16)));
typedef short s16x4 __attribute__((ext_vector_type(4)));
typedef short v4i16_t __attribute__((ext_vector_type(4)));
typedef __bf16 bf2_t __attribute__((ext_vector_type(2)));
typedef float f32x2_t __attribute__((ext_vector_type(2)));
typedef unsigned u32x2 __attribute__((ext_vector_type(2)));
typedef unsigned u32x4 __attribute__((ext_vector_type(4)));
#define DI __device__ __forceinline__
constexpr int NWAVES = 8, NTHR = 512;
DI unsigned cvt2(float a, float b) { f32x2_t v = {a, b}; return __builtin_bit_cast(unsigned, __builtin_convertvector(v, bf2_t)); }
DI float bf_lo(unsigned u) { return __uint_as_float(u << 16); }
DI float bf_hi(unsigned u) { return __uint_as_float(u & 0xffff0000u); }
DI s16x4 tr_read(const LAS unsigned char* p) { return __builtin_bit_cast(s16x4, __builtin_amdgcn_ds_read_tr16_b64_v4i16((LAS v4i16_t*)p)); }
DI bf16x8 cat8(s16x4 a, s16x4 b) { bf16x8 r; r[0] = a[0]; r[1] = a[1]; r[2] = a[2]; r[3] = a[3]; r[4] = b[0]; r[5] = b[1]; r[6] = b[2]; r[7] = b[3]; return r; }
DI float wave_sum(float v) {
#pragma unroll
    for (int o = 1; o < 64; o <<= 1) v += __shfl_xor(v, o);
    return v;
}
#define MFMA32(a, b, c) __builtin_amdgcn_mfma_f32_32x32x16_bf16((a), (b), (c), 0, 0, 0)
#define WG_SYNC() __syncthreads()

namespace pg8 {
struct EpiGen {
    static constexpr bool PERM = true, AFTER_DRAIN = false;
    int mode; bf16_t* out; int ldc; const void* res; float* side0; float* side1;
    __device__ __forceinline__ void operator()(const f32x4 (&acc)[2][2][4][2], const Unit& u, int wr, int wc, int fr, int fq) const {
        const int row0 = u.pm * BM + wr * 64 + fr, col0 = u.pn * BM + wc * 32 + 8 * fq; const float alpha = cfg::ALPHA;
#pragma unroll
        for (int ai = 0; ai < 2; ++ai)
#pragma unroll
            for (int m = 0; m < 4; ++m) { const size_t row = (size_t)(row0 + ai * HALF + m * 16);
#pragma unroll
                for (int bj = 0; bj < 2; ++bj) { const int col = col0 + bj * HALF; f32x4 v0 = acc[ai][bj][m][0], v1 = acc[ai][bj][m][1];
                    if (mode == 1) { const float* r = (const float*)res + row * 1024 + col; const f32x4 r0 = *(const f32x4*)r, r1 = *(const f32x4*)(r + 4); v0 += alpha * r0; v1 += alpha * r1; }
                    else if (mode == 2) { const u32x4 r = *(const u32x4*)((const bf16_t*)res + row * 1024 + col);
                        v0[0] += alpha * bf_lo(r.x); v0[1] += alpha * bf_hi(r.x); v0[2] += alpha * bf_lo(r.y); v0[3] += alpha * bf_hi(r.y);
                        v1[0] += alpha * bf_lo(r.z); v1[1] += alpha * bf_hi(r.z); v1[2] += alpha * bf_lo(r.w); v1[3] += alpha * bf_hi(r.w); }
                    u32x4 w; w.x = cvt2(v0[0], v0[1]); w.y = cvt2(v0[2], v0[3]); w.z = cvt2(v1[0], v1[1]); w.w = cvt2(v1[2], v1[3]);
                    *(u32x4*)(out + row * ldc + col) = w;
                    if (side0 && bj == 0) { if (col == 3072 || col == 3080) { float* p = side0 + row * 16 + (col - 3072); *(f32x4*)p = v0; *(f32x4*)(p + 4) = v1; }
                                            if (col == 5392 || col == 5400) { float* p = side1 + row * 16 + (col - 5392); *(f32x4*)p = v0; *(f32x4*)(p + 4) = v1; } } }
                asm volatile("" ::: "memory"); }
    }
};
}

DI void ln_rows_bf16(bf16* buf, const float* g, const float* bt, int rows, int gw, int NGW, int lane) {
    for (int r = gw; r < rows; r += NGW) {
        bf16* p = buf + (size_t)r * 1024 + lane * 8;
        const u32x4 a = *(const u32x4*)p, b = *(const u32x4*)(p + 512);
        float v[16] = {bf_lo(a.x), bf_hi(a.x), bf_lo(a.y), bf_hi(a.y), bf_lo(a.z), bf_hi(a.z), bf_lo(a.w), bf_hi(a.w), bf_lo(b.x), bf_hi(b.x), bf_lo(b.y), bf_hi(b.y), bf_lo(b.z), bf_hi(b.z), bf_lo(b.w), bf_hi(b.w)};
        float s = 0.f;
#pragma unroll
        for (int i = 0; i < 16; ++i) s += v[i];
        const float mean = wave_sum(s) * (1.f / 1024.f); float q = 0.f;
#pragma unroll
        for (int i = 0; i < 16; ++i) { v[i] -= mean; q += v[i] * v[i]; }
        const float rstd = 1.0f / sqrtf(wave_sum(q) * (1.f / 1024.f) + cfg::LN_EPS);
        const f32x4 g0 = *(const f32x4*)(g + lane * 8), g1 = *(const f32x4*)(g + lane * 8 + 4), g2 = *(const f32x4*)(g + 512 + lane * 8), g3 = *(const f32x4*)(g + 512 + lane * 8 + 4);
        const f32x4 b0 = *(const f32x4*)(bt + lane * 8), b1 = *(const f32x4*)(bt + lane * 8 + 4), b2 = *(const f32x4*)(bt + 512 + lane * 8), b3 = *(const f32x4*)(bt + 512 + lane * 8 + 4);
        u32x4 oa, ob;
        oa.x = cvt2(v[0] * rstd * g0[0] + b0[0], v[1] * rstd * g0[1] + b0[1]); oa.y = cvt2(v[2] * rstd * g0[2] + b0[2], v[3] * rstd * g0[3] + b0[3]);
        oa.z = cvt2(v[4] * rstd * g1[0] + b1[0], v[5] * rstd * g1[1] + b1[1]); oa.w = cvt2(v[6] * rstd * g1[2] + b1[2], v[7] * rstd * g1[3] + b1[3]);
        ob.x = cvt2(v[8] * rstd * g2[0] + b2[0], v[9] * rstd * g2[1] + b2[1]); ob.y = cvt2(v[10] * rstd * g2[2] + b2[2], v[11] * rstd * g2[3] + b2[3]);
        ob.z = cvt2(v[12] * rstd * g3[0] + b3[0], v[13] * rstd * g3[1] + b3[1]); ob.w = cvt2(v[14] * rstd * g3[2] + b3[2], v[15] * rstd * g3[3] + b3[3]);
        *(u32x4*)p = oa; *(u32x4*)(p + 512) = ob;
    }
}

constexpr int ATT_KP = 528, ATT_VP = 576;
DI void attn_phase(LAS unsigned char* lds, bf16* QO, const bf16* Kc, const bf16* Vc, int G, int bx, int tid) {
    using namespace cfg;
    const int wave = tid >> 6;
    constexpr int NU = (NTOK / 256) * MEM_HEADS;
    for (int u = bx; u < NU; u += G) {
        int lane = tid & 63; asm volatile("" : "+v"(lane));
        const int q = lane & 31, h = lane >> 5;
        const int bh = u / (SEQ / 256), qb = u % (SEQ / 256), b = bh / MEM_HEADS, hd = bh % MEM_HEADS;
        const bf16* Kg = Kc + (size_t)(b * MEM_LEN) * D_MODEL + hd * MEM_HEAD_DIM;
        const bf16* Vg = Vc + (size_t)(b * MEM_LEN) * D_MODEL + hd * MEM_HEAD_DIM;
        bf16* Qg = QO + ((size_t)b * SEQ + (size_t)qb * 256 + wave * 32 + q) * D_MODEL + hd * MEM_HEAD_DIM;
        WG_SYNC();
#pragma unroll 4
        for (int p = 0; p < 16; ++p) { const int key = p * 16 + (tid >> 5), ch = tid & 31;
            const u32x4 v = *(const u32x4*)(Kg + (size_t)key * D_MODEL + ch * 8); *(LAS u32x4*)(lds + key * ATT_KP + ch * 16) = v; }
        bf16x8 qf[16];
#pragma unroll
        for (int s = 0; s < 16; ++s) qf[s] = *(const bf16x8*)(Qg + 16 * s + 8 * h);
        WG_SYNC();
        f32x16 sc[8];
#pragma unroll
        for (int kt = 0; kt < 8; ++kt) {
#pragma unroll
            for (int i = 0; i < 16; ++i) sc[kt][i] = 0.f;
#pragma unroll
            for (int s = 0; s < 16; ++s) { const bf16x8 kf = *(const LAS bf16x8*)(lds + (kt * 32 + q) * ATT_KP + (16 * s + 8 * h) * 2); sc[kt] = MFMA32(kf, qf[s], sc[kt]); }
        }
        float m = sc[0][0];
#pragma unroll
        for (int kt = 0; kt < 8; ++kt)
#pragma unroll
            for (int i = 0; i < 16; ++i) m = fmaxf(m, sc[kt][i]);
        m = fmaxf(m, __shfl_xor(m, 32));
        const float c = 0.0625f * 1.44269504088896f; float l = 0.f; const float mc = m * c;
        bf16x8 pf[8][2];
#pragma unroll
        for (int kt = 0; kt < 8; ++kt) {
            float e[16];
#pragma unroll
            for (int i = 0; i < 16; ++i) { e[i] = __builtin_amdgcn_exp2f(sc[kt][i] * c - mc); l += e[i]; }
#pragma unroll
            for (int s = 0; s < 2; ++s) { u32x4 w; w.x = cvt2(e[8 * s], e[8 * s + 1]); w.y = cvt2(e[8 * s + 2], e[8 * s + 3]); w.z = cvt2(e[8 * s + 4], e[8 * s + 5]); w.w = cvt2(e[8 * s + 6], e[8 * s + 7]); pf[kt][s] = __builtin_bit_cast(bf16x8, w); }
        }
        l += __shfl_xor(l, 32);
        const float inv = 1.0f / l;
        WG_SYNC();
#pragma unroll 4
        for (int p = 0; p < 16; ++p) { const int key = p * 16 + (tid >> 5), ch = tid & 31;
            const u32x4 v = *(const u32x4*)(Vg + (size_t)key * D_MODEL + ch * 8); *(LAS u32x4*)(lds + key * ATT_VP + ch * 16) = v; }
        WG_SYNC();
        const int gi = (lane >> 4) & 1, i16 = lane & 15;
        const LAS unsigned char* vb = lds + (4 * h + (i16 >> 2)) * ATT_VP + (16 * gi + 4 * (i16 & 3)) * 2;
#pragma unroll
        for (int et = 0; et < 8; ++et) {
            f32x16 o;
#pragma unroll
            for (int i = 0; i < 16; ++i) o[i] = 0.f;
#pragma unroll
            for (int kt = 0; kt < 8; ++kt)
#pragma unroll
                for (int s = 0; s < 2; ++s) { const LAS unsigned char* a = vb + (kt * 32 + 16 * s) * ATT_VP + et * 64;
                    const bf16x8 vf = cat8(tr_read(a), tr_read(a + 8 * ATT_VP)); o = MFMA32(vf, pf[kt][s], o); }
#pragma unroll
            for (int r4 = 0; r4 < 4; ++r4) { u32x2 w; w.x = cvt2(o[4 * r4] * inv, o[4 * r4 + 1] * inv); w.y = cvt2(o[4 * r4 + 2] * inv, o[4 * r4 + 3] * inv);
                *(u32x2*)(Qg + et * 32 + 8 * r4 + 4 * h) = w; }
        }
    }
    WG_SYNC();
}

DI int f2key(float s) { int k = __float_as_int(s); return k ^ ((k >> 31) & 0x7fffffff); }
DI float key2f(int k) { return __int_as_float(k ^ ((k >> 31) & 0x7fffffff)); }
#define CE_DESC(a, b) do { const int _hi = max((a), (b)), _lo = min((a), (b)); (a) = _hi; (b) = _lo; } while (0)
DI void sort16_desc(int (&t)[16]) {
#pragma unroll
    for (int k = 2; k <= 16; k <<= 1)
#pragma unroll
        for (int j = k >> 1; j > 0; j >>= 1)
#pragma unroll
            for (int i = 0; i < 16; ++i) { const int l = i ^ j; if (l > i) { if ((i & k) == 0) CE_DESC(t[i], t[l]); else CE_DESC(t[l], t[i]); } }
}
DI void merge16_desc(int (&a)[16], const int (&b)[16]) {
#pragma unroll
    for (int i = 0; i < 16; ++i) a[i] = max(a[i], b[15 - i]);
#pragma unroll
    for (int j = 8; j > 0; j >>= 1)
#pragma unroll
        for (int i = 0; i < 16; ++i) { const int l = i ^ j; if (l > i) CE_DESC(a[i], a[l]); }
}
constexpr int TK_KP = 144;
DI void topk_phase(LAS unsigned char* lds, const bf16* PQ, const float* keys, unsigned* picks, bf16* eid16, int G, int bx, int tid) {
    using namespace cfg;
    const int lane = tid & 63, wave = tid >> 6, q = lane & 31, h = lane >> 5;
    for (int i = tid; i < 2 * PEER_N_KEYS * PEER_HALF / 2; i += NTHR) { const int row = i / (PEER_HALF / 2), c2 = i % (PEER_HALF / 2);
        const float a = keys[row * PEER_HALF + 2 * c2], b = keys[row * PEER_HALF + 2 * c2 + 1]; *(LAS unsigned*)(lds + row * TK_KP + c2 * 4) = cvt2(a, b); }
    LAS unsigned* lut = (LAS unsigned*)(lds + 40960) + (wave * 64 + lane) * 33;
    WG_SYNC();
    constexpr int NTASK = (NTOK / 32) * PEER_HEADS;
    for (int task = bx * NWAVES + wave; task < NTASK; task += G * NWAVES) {
        const int tb = task / PEER_HEADS, hd = task % PEER_HEADS;
        const bf16* qg = PQ + (size_t)(tb * 32 + q) * D_MODEL + hd * PEER_KEY_DIM;
        int top[2][16];
#pragma unroll
        for (int p = 0; p < 2; ++p) {
            bf16x8 qf[4];
#pragma unroll
            for (int s = 0; s < 4; ++s) qf[s] = *(const bf16x8*)(qg + p * PEER_HALF + 16 * s + 8 * h);
            int grp[4][16];
#pragma unroll
            for (int kt = 0; kt < 4; ++kt) {
                f32x16 sc;
#pragma unroll
                for (int i = 0; i < 16; ++i) sc[i] = 0.f;
#pragma unroll
                for (int s = 0; s < 4; ++s) { const bf16x8 kf = *(const LAS bf16x8*)(lds + (p * PEER_N_KEYS + kt * 32 + q) * TK_KP + (16 * s + 8 * h) * 2); sc = MFMA32(kf, qf[s], sc); }
#pragma unroll
                for (int i = 0; i < 16; ++i) { const int idx = kt * 32 + (i & 3) + 8 * (i >> 2) + 4 * h; grp[kt][i] = (f2key(sc[i]) & ~127) | (127 - idx); }
                sort16_desc(grp[kt]);
            }
            merge16_desc(grp[0], grp[1]); merge16_desc(grp[2], grp[3]); merge16_desc(grp[0], grp[2]);
            int other[16];
#pragma unroll
            for (int i = 0; i < 16; ++i) other[i] = __shfl_xor(grp[0][i], 32);
            merge16_desc(grp[0], other);
#pragma unroll
            for (int i = 0; i < 16; ++i) top[p][i] = grp[0][i];
        }
        float s1[16], s2[16];
#pragma unroll
        for (int i = 0; i < 16; ++i) { s1[i] = key2f(top[0][i] & ~127); s2[i] = key2f(top[1][i] & ~127); lut[i] = 127 - (top[0][i] & 127); lut[16 + i] = 127 - (top[1][i] & 127); }
        int L[16];
#pragma unroll
        for (int j = 0; j < 16; ++j) L[j] = (f2key(s1[0] + s2[j]) & ~255) | (255 - j);
#pragma unroll
        for (int i = 1; i < 16; ++i)
#pragma unroll
            for (int j = 0; j < 16; ++j) if ((i + 1) * (j + 1) <= 16) {
                int x = (f2key(s1[i] + s2[j]) & ~255) | (255 - (16 * i + j));
#pragma unroll
                for (int pz = (i + 1) * (j + 1) - 1; pz < 16; ++pz) CE_DESC(L[pz], x);
            }
        const float best0 = key2f(L[0] & ~255); float ge[16], gs = 0.f;
#pragma unroll
        for (int n = 0; n < 16; ++n) { ge[n] = __expf(key2f(L[n] & ~255) - best0); gs += ge[n]; }
        const float ginv = 1.0f / gs;
        asm volatile("s_waitcnt lgkmcnt(0)" ::: "memory");
        unsigned* pk = picks + ((size_t)(tb * 32 + q) * PEER_HEADS + hd) * 16 + 8 * h;
        unsigned wv[16];
#pragma unroll
        for (int n = 0; n < 16; ++n) { const int c = 255 - (L[n] & 255); const unsigned e = lut[c >> 4] * PEER_N_KEYS + lut[16 + (c & 15)];
            wv[n] = (e << 16) | (cvt2(ge[n] * ginv, 0.f) & 0xffffu); }
        u32x4 o0, o1;
        o0.x = h ? wv[8] : wv[0]; o0.y = h ? wv[9] : wv[1]; o0.z = h ? wv[10] : wv[2]; o0.w = h ? wv[11] : wv[3];
        o1.x = h ? wv[12] : wv[4]; o1.y = h ? wv[13] : wv[5]; o1.z = h ? wv[14] : wv[6]; o1.w = h ? wv[15] : wv[7];
        *(u32x4*)pk = o0; *(u32x4*)(pk + 4) = o1;
        u32x4 e16; e16.x = (o0.x >> 16) | (o0.y & 0xffff0000u); e16.y = (o0.z >> 16) | (o0.w & 0xffff0000u); e16.z = (o1.x >> 16) | (o1.y & 0xffff0000u); e16.w = (o1.z >> 16) | (o1.w & 0xffff0000u);
        *(u32x4*)(eid16 + ((size_t)(tb * 32 + q) * PEER_HEADS + hd) * 16 + 8 * h) = e16;
    }
    WG_SYNC();
}

DI float gelu_erf(float v) {
    const float av = fabsf(v), t = __builtin_amdgcn_rcpf(av * 0.2316418882f + 1.0f);
    float qv = t * 0.5307027145f - 0.7265760135f; qv = qv * t + 0.7107068705f; qv = qv * t - 0.142248368f; qv = qv * t + 0.127414796f; qv = qv * t;
    const float e = __builtin_amdgcn_exp2f(v * v * -0.72134752044f), mm = v * (qv * e);
    return v < 0.f ? mm : v - mm;
}
typedef __bf16 bf8_t __attribute__((ext_vector_type(8)));
DI float dot8(const u32x4 a, const u32x4 b, float acc) {
    const bf8_t a8 = __builtin_bit_cast(bf8_t, a), b8 = __builtin_bit_cast(bf8_t, b);
    acc = __builtin_amdgcn_fdot2_f32_bf16(a8.s01, b8.s01, acc, false);
    acc = __builtin_amdgcn_fdot2_f32_bf16(a8.s23, b8.s23, acc, false);
    acc = __builtin_amdgcn_fdot2_f32_bf16(a8.s45, b8.s45, acc, false);
    acc = __builtin_amdgcn_fdot2_f32_bf16(a8.s67, b8.s67, acc, false);
    return acc;
}
DI void axpy8(float (&o)[8], float w, const u32x4 v) {
    o[0] += w * bf_lo(v.x); o[1] += w * bf_hi(v.x); o[2] += w * bf_lo(v.y); o[3] += w * bf_hi(v.y); o[4] += w * bf_lo(v.z); o[5] += w * bf_hi(v.z); o[6] += w * bf_lo(v.w); o[7] += w * bf_hi(v.w);
}
template <int XM> DI float swz_xor(float v) { return __int_as_float(__builtin_amdgcn_ds_swizzle(__float_as_int(v), (XM << 10) | 0x1f)); }
template <int D> DI void treduce_stage(float (&p)[16], int lane) {
    const bool up = (lane & D) != 0;
#pragma unroll
    for (int k = 0; k < D; ++k) { const float keep = up ? p[k + D] : p[k], send = up ? p[k] : p[k + D]; p[k] = keep + swz_xor<D>(send); }
}
DI float treduce16(float (&p)[16], int lane) {
    treduce_stage<8>(p, lane); treduce_stage<4>(p, lane); treduce_stage<2>(p, lane); treduce_stage<1>(p, lane);
    float r = p[0]; r += swz_xor<16>(r); r += __shfl_xor(r, 32); return r;
}
DI u32x4 bload(__amdgpu_buffer_rsrc_t r, int voff, int soff) { return __builtin_bit_cast(u32x4, __builtin_amdgcn_raw_buffer_load_b128(r, voff, soff, 0)); }
DI void cvt_fp8_rows(const float* src, unsigned char* dst, float* scales, int rows, int gw, int NGW, int lane) {
    for (int r = gw; r < rows; r += NGW) {
        const float* p = src + (size_t)r * 1024 + lane * 16;
        const f32x4 a = *(const f32x4*)p, b = *(const f32x4*)(p + 4), c = *(const f32x4*)(p + 8), d = *(const f32x4*)(p + 12);
        float m = fmaxf(fmaxf(fmaxf(fabsf(a[0]), fabsf(a[1])), fmaxf(fabsf(a[2]), fabsf(a[3]))), fmaxf(fmaxf(fabsf(b[0]), fabsf(b[1])), fmaxf(fabsf(b[2]), fabsf(b[3]))));
        m = fmaxf(m, fmaxf(fmaxf(fmaxf(fabsf(c[0]), fabsf(c[1])), fmaxf(fabsf(c[2]), fabsf(c[3]))), fmaxf(fmaxf(fabsf(d[0]), fabsf(d[1])), fmaxf(fabsf(d[2]), fabsf(d[3])))));
#pragma unroll
        for (int o = 1; o < 64; o <<= 1) m = fmaxf(m, __shfl_xor(m, o));
        const float sc = m > 0.f ? m * (1.0f / 448.0f) : 1.0f, inv = 1.0f / sc;
        u32x4 o;
        o.x = (unsigned)__builtin_amdgcn_cvt_pk_fp8_f32(a[2] * inv, a[3] * inv, __builtin_amdgcn_cvt_pk_fp8_f32(a[0] * inv, a[1] * inv, 0, false), true);
        o.y = (unsigned)__builtin_amdgcn_cvt_pk_fp8_f32(b[2] * inv, b[3] * inv, __builtin_amdgcn_cvt_pk_fp8_f32(b[0] * inv, b[1] * inv, 0, false), true);
        o.z = (unsigned)__builtin_amdgcn_cvt_pk_fp8_f32(c[2] * inv, c[3] * inv, __builtin_amdgcn_cvt_pk_fp8_f32(c[0] * inv, c[1] * inv, 0, false), true);
        o.w = (unsigned)__builtin_amdgcn_cvt_pk_fp8_f32(d[2] * inv, d[3] * inv, __builtin_amdgcn_cvt_pk_fp8_f32(d[0] * inv, d[1] * inv, 0, false), true);
        *(u32x4*)(dst + (size_t)(lane >> 3) * (2u << 20) + (size_t)r * 128 + (lane & 7) * 16) = o;
        if (lane == 0) scales[r] = sc;
    }
}
DI void unpack_fp8x16(const u32x4 v, float (&f)[16]) {
    const f32x2_t a0 = __builtin_amdgcn_cvt_pk_f32_fp8((int)v.x, false), a1 = __builtin_amdgcn_cvt_pk_f32_fp8((int)v.x, true), b0 = __builtin_amdgcn_cvt_pk_f32_fp8((int)v.y, false), b1 = __builtin_amdgcn_cvt_pk_f32_fp8((int)v.y, true);
    const f32x2_t c0 = __builtin_amdgcn_cvt_pk_f32_fp8((int)v.z, false), c1 = __builtin_amdgcn_cvt_pk_f32_fp8((int)v.z, true), d0 = __builtin_amdgcn_cvt_pk_f32_fp8((int)v.w, false), d1 = __builtin_amdgcn_cvt_pk_f32_fp8((int)v.w, true);
    f[0] = a0.x; f[1] = a0.y; f[2] = a1.x; f[3] = a1.y; f[4] = b0.x; f[5] = b0.y; f[6] = b1.x; f[7] = b1.y; f[8] = c0.x; f[9] = c0.y; f[10] = c1.x; f[11] = c1.y; f[12] = d0.x; f[13] = d0.y; f[14] = d1.x; f[15] = d1.y;
}

constexpr int PEER_BLK = 128, PEER_NBLK = cfg::NTOK / PEER_BLK;
DI bool peer_next_item(volatile LAS unsigned* slot, gu32* cnt, int tid, int& s, int& blk) {
    if (tid == 0) { const int myx = (int)(xb_xcc_id() & 7u); int found = -1; unsigned tk = 0u;
        for (int a = 0; a < 8 && found < 0; ++a) { const int ss = (myx + a) & 7; const unsigned t = __hip_atomic_fetch_add(cnt + ss * 64, 1u, __ATOMIC_RELAXED, __HIP_MEMORY_SCOPE_AGENT); if (t < (unsigned)PEER_NBLK) { found = ss; tk = t; } }
        slot[0] = (unsigned)found; slot[1] = tk; }
    __syncthreads();
    s = __builtin_amdgcn_readfirstlane((int)slot[0]); blk = __builtin_amdgcn_readfirstlane((int)slot[1]);
    __syncthreads();
    return s >= 0;
}
template <int LB> DI float xor_lane(float v) { if constexpr (LB < 32) return __int_as_float(__builtin_amdgcn_ds_swizzle(__float_as_int(v), (LB << 10) | 0x1f)); else return __shfl_xor(v, 32); }
template <int AH, int LB> DI void halve_stage(float (&p)[16], int lane) {
    const bool up = (lane & LB) != 0;
#pragma unroll
    for (int k = 0; k < AH; ++k) { const float keep = up ? p[k + AH] : p[k], send = up ? p[k] : p[k + AH]; p[k] = keep + xor_lane<LB>(send); }
}
DI int peer_voff(const u32x4 (&pk)[2], int i, int sub) { const unsigned p = pk[i >> 3][(i >> 1) & 3]; const unsigned e = (i & 1) ? (p >> 16) : (p & 0xffffu); return (int)(e * 128u) + sub * 16; }
DI void peer_load_pk(u32x4 (&pk)[2], const bf16* arr16, int t, int grp) {
    pk[0] = *(const u32x4*)(arr16 + (size_t)t * 128 + grp * 16); pk[1] = *(const u32x4*)(arr16 + (size_t)t * 128 + grp * 16 + 8);
}
typedef int i32x4_t __attribute__((ext_vector_type(4)));
DI i32x4_t peer_rsrc(const void* base, unsigned bytes) {
    const unsigned long long a = (unsigned long long)base; i32x4_t r;
    r.x = __builtin_amdgcn_readfirstlane((int)(unsigned)a); r.y = __builtin_amdgcn_readfirstlane((int)((unsigned)(a >> 32) & 0xffffu)); r.z = __builtin_amdgcn_readfirstlane((int)bytes); r.w = __builtin_amdgcn_readfirstlane(0x00020000);
    return r;
}
#define PEER_ROW_ISSUE(dst, voff, rs) dst = bload(__builtin_amdgcn_make_buffer_rsrc((void*)(((unsigned long long)(unsigned)rs.x) | ((unsigned long long)(unsigned)rs.y << 32)), 0, 2 << 20, 0x00020000), voff, 0)
#define PEER_ROW_ISSUE_FIRST(dst, voff, rs) PEER_ROW_ISSUE(dst, voff, rs)
#define PEER_G_ISSUE(dst, ptr) dst = *(const u32x4*)(ptr)
template <int N> DI void peer_wait(u32x4& r) { }
template <int N> DI void peer_wait2(u32x4& a, u32x4& b, u32x4& c, u32x4& d) { }
template <int IT> DI void peer_u_token(u32x4 (&r)[16], u32x4 (&eNext)[2], u32x4 (&eLoad)[2], u32x4 (&xCur)[2], u32x4 (&xLoad)[2], const i32x4_t rs, const bf16* eid16, const bf16* xbase, float* abase, int t0, int grp, int sub, int lane) {
    constexpr int NTOP = IT <= 13 ? 4 : IT == 14 ? 2 : 0;
    constexpr int NW = IT <= 14 ? 15 + NTOP : 0;
    if constexpr (IT <= 13) { const bf16* ep = eid16 + (size_t)(t0 + IT + 2) * 128 + grp * 16; PEER_G_ISSUE(eLoad[0], ep); PEER_G_ISSUE(eLoad[1], ep + 8); }
    if constexpr (IT <= 14) { const bf16* xp = xbase + (size_t)(t0 + IT + 1) * cfg::D_MODEL; PEER_G_ISSUE(xLoad[0], xp); PEER_G_ISSUE(xLoad[1], xp + 8); }
    float xs[16]; float part[16];
#pragma unroll
    for (int i = 0; i < 16; ++i) {
        if (i == 0) { if constexpr (IT <= 14) peer_wait2<NW>(r[0], eNext[0], eNext[1], xCur[0]); else peer_wait2<15>(r[0], eNext[0], eNext[1], xCur[0]);
            asm volatile("" : "+v"(xCur[1]));
            const u32x4 xa = xCur[0], xb = xCur[1];
            xs[0] = bf_lo(xa.x); xs[1] = bf_hi(xa.x); xs[2] = bf_lo(xa.y); xs[3] = bf_hi(xa.y); xs[4] = bf_lo(xa.z); xs[5] = bf_hi(xa.z); xs[6] = bf_lo(xa.w); xs[7] = bf_hi(xa.w);
            xs[8] = bf_lo(xb.x); xs[9] = bf_hi(xb.x); xs[10] = bf_lo(xb.y); xs[11] = bf_hi(xb.y); xs[12] = bf_lo(xb.z); xs[13] = bf_hi(xb.z); xs[14] = bf_lo(xb.w); xs[15] = bf_hi(xb.w); }
        else { if constexpr (IT <= 14) peer_wait<NW>(r[i]); else { if (i == 1) peer_wait<14>(r[i]); else if (i == 2) peer_wait<13>(r[i]); else if (i == 3) peer_wait<12>(r[i]); else if (i == 4) peer_wait<11>(r[i]); else if (i == 5) peer_wait<10>(r[i]);
                else if (i == 6) peer_wait<9>(r[i]); else if (i == 7) peer_wait<8>(r[i]); else if (i == 8) peer_wait<7>(r[i]); else if (i == 9) peer_wait<6>(r[i]); else if (i == 10) peer_wait<5>(r[i]); else if (i == 11) peer_wait<4>(r[i]);
                else if (i == 12) peer_wait<3>(r[i]); else if (i == 13) peer_wait<2>(r[i]); else if (i == 14) peer_wait<1>(r[i]); else peer_wait<0>(r[i]); } }
        float f[16]; unpack_fp8x16(r[i], f);
        if constexpr (IT <= 14) { const int vo = peer_voff(eNext, i, sub); PEER_ROW_ISSUE(r[i], vo, rs); }
        float a[8];
#pragma unroll
        for (int k = 0; k < 8; ++k) a[k] = f[k] * xs[k];
#pragma unroll
        for (int k = 0; k < 8; ++k) a[k] += f[k + 8] * xs[k + 8];
        part[i] = ((a[0] + a[1]) + (a[2] + a[3])) + ((a[4] + a[5]) + (a[6] + a[7]));
        asm volatile("" : "+v"(part[i]));
    }
    halve_stage<8, 4>(part, lane); halve_stage<4, 2>(part, lane); halve_stage<2, 1>(part, lane);
    *(f32x2_t*)(abase + (size_t)(t0 + IT) * 128) = (f32x2_t){part[0], part[1]};
}
DI void peer_u_phase(volatile LAS unsigned* slot, const bf16* H2, const bf16* eid16, const unsigned char* U8S, float* actp, gu32* cnt, int tid) {
    using namespace cfg;
    const int wave = tid >> 6;
    int s, blk;
    while (peer_next_item(slot, cnt, tid, s, blk)) {
        int lane = tid & 63; asm volatile("" : "+v"(lane));
        const int grp = lane >> 3, sub = lane & 7;
        const i32x4_t rs = peer_rsrc(U8S + (size_t)s * (2u << 20), 2u << 20);
        const int t0 = blk * PEER_BLK + wave * 16;
        const bf16* xbase = H2 + (size_t)s * 128 + sub * 16;
        float* abase = actp + ((size_t)s * NTOK) * 128 + grp * 16 + 2 * sub;
        u32x4 eA[2], eB[2], xA[2], xB[2], r[16];
        { const bf16* ep = eid16 + (size_t)t0 * 128 + grp * 16; PEER_G_ISSUE(eA[0], ep); PEER_G_ISSUE(eA[1], ep + 8); PEER_G_ISSUE(eB[0], ep + 128); PEER_G_ISSUE(eB[1], ep + 136);
          const bf16* xp = xbase + (size_t)t0 * D_MODEL; PEER_G_ISSUE(xA[0], xp); PEER_G_ISSUE(xA[1], xp + 8); }
        peer_wait2<4>(eA[0], eA[1], eA[0], eA[1]);
#pragma unroll
        for (int i = 0; i < 16; ++i) { const int vo = peer_voff(eA, i, sub); if (i == 0) PEER_ROW_ISSUE_FIRST(r[i], vo, rs); else PEER_ROW_ISSUE(r[i], vo, rs); }
        peer_u_token<0>(r, eB, eA, xA, xB, rs, eid16, xbase, abase, t0, grp, sub, lane);   peer_u_token<1>(r, eA, eB, xB, xA, rs, eid16, xbase, abase, t0, grp, sub, lane);
        peer_u_token<2>(r, eB, eA, xA, xB, rs, eid16, xbase, abase, t0, grp, sub, lane);   peer_u_token<3>(r, eA, eB, xB, xA, rs, eid16, xbase, abase, t0, grp, sub, lane);
        peer_u_token<4>(r, eB, eA, xA, xB, rs, eid16, xbase, abase, t0, grp, sub, lane);   peer_u_token<5>(r, eA, eB, xB, xA, rs, eid16, xbase, abase, t0, grp, sub, lane);
        peer_u_token<6>(r, eB, eA, xA, xB, rs, eid16, xbase, abase, t0, grp, sub, lane);   peer_u_token<7>(r, eA, eB, xB, xA, rs, eid16, xbase, abase, t0, grp, sub, lane);
        peer_u_token<8>(r, eB, eA, xA, xB, rs, eid16, xbase, abase, t0, grp, sub, lane);   peer_u_token<9>(r, eA, eB, xB, xA, rs, eid16, xbase, abase, t0, grp, sub, lane);
        peer_u_token<10>(r, eB, eA, xA, xB, rs, eid16, xbase, abase, t0, grp, sub, lane);  peer_u_token<11>(r, eA, eB, xB, xA, rs, eid16, xbase, abase, t0, grp, sub, lane);
        peer_u_token<12>(r, eB, eA, xA, xB, rs, eid16, xbase, abase, t0, grp, sub, lane);  peer_u_token<13>(r, eA, eB, xB, xA, rs, eid16, xbase, abase, t0, grp, sub, lane);
        peer_u_token<14>(r, eB, eA, xA, xB, rs, eid16, xbase, abase, t0, grp, sub, lane);  peer_u_token<15>(r, eA, eB, xB, xA, rs, eid16, xbase, abase, t0, grp, sub, lane);
    }
}
DI bf16 f2bf16w(float f) { return (bf16)(cvt2(f, 0.f) & 0xffffu); }
DI void peer_w_pass(const unsigned* picks, const float* actp, const float* su, const float* sv, bf16* wbuf, int gw, int NGW, int lane) {
    using namespace cfg;
    for (int t = gw; t < NTOK; t += NGW) {
#pragma unroll
        for (int hf = 0; hf < 2; ++hf) { const int pos = hf * 64 + lane; const unsigned pk = picks[(size_t)t * 128 + pos]; const int e = (int)(pk >> 16); float a = 0.f;
#pragma unroll
            for (int s = 0; s < 8; ++s) a += actp[((size_t)s * NTOK + t) * 128 + pos];
            wbuf[(size_t)t * 128 + pos] = f2bf16w(__uint_as_float(pk << 16) * gelu_erf(a * su[e]) * sv[e]); }
    }
}
template <int IT> DI void peer_v_token(u32x4 (&r)[16], u32x4 (&eNext)[2], u32x4 (&eLoad)[2], u32x4 (&wCur)[2], u32x4 (&wLoad)[2], const i32x4_t rs, const bf16* eid16, const bf16* wbuf, bf16* fbase, int t0, int grp, int sub, int lane) {
    constexpr int NTOP = IT <= 13 ? 4 : IT == 14 ? 2 : 0;
    constexpr int NW = IT <= 14 ? 15 + NTOP : 0;
    if constexpr (IT <= 13) { const bf16* ep = eid16 + (size_t)(t0 + IT + 2) * 128 + grp * 16; PEER_G_ISSUE(eLoad[0], ep); PEER_G_ISSUE(eLoad[1], ep + 8); }
    if constexpr (IT <= 14) { const bf16* wp = wbuf + (size_t)(t0 + IT + 1) * 128 + grp * 16; PEER_G_ISSUE(wLoad[0], wp); PEER_G_ISSUE(wLoad[1], wp + 8); }
    float acc[16];
#pragma unroll
    for (int k = 0; k < 16; ++k) acc[k] = 0.f;
#pragma unroll
    for (int i = 0; i < 16; ++i) {
        if (i == 0) { if constexpr (IT <= 14) peer_wait2<NW>(r[0], eNext[0], eNext[1], wCur[0]); else peer_wait2<15>(r[0], eNext[0], eNext[1], wCur[0]); asm volatile("" : "+v"(wCur[1])); }
        else { if constexpr (IT <= 14) peer_wait<NW>(r[i]); else { if (i == 1) peer_wait<14>(r[i]); else if (i == 2) peer_wait<13>(r[i]); else if (i == 3) peer_wait<12>(r[i]); else if (i == 4) peer_wait<11>(r[i]); else if (i == 5) peer_wait<10>(r[i]);
                else if (i == 6) peer_wait<9>(r[i]); else if (i == 7) peer_wait<8>(r[i]); else if (i == 8) peer_wait<7>(r[i]); else if (i == 9) peer_wait<6>(r[i]); else if (i == 10) peer_wait<5>(r[i]); else if (i == 11) peer_wait<4>(r[i]);
                else if (i == 12) peer_wait<3>(r[i]); else if (i == 13) peer_wait<2>(r[i]); else if (i == 14) peer_wait<1>(r[i]); else peer_wait<0>(r[i]); } }
        float f[16]; unpack_fp8x16(r[i], f);
        if constexpr (IT <= 14) { const int vo = peer_voff(eNext, i, sub); PEER_ROW_ISSUE(r[i], vo, rs); }
        const unsigned wp = wCur[i >> 3][(i >> 1) & 3]; const float w = (i & 1) ? bf_hi(wp) : bf_lo(wp);
#pragma unroll
        for (int k = 0; k < 16; ++k) acc[k] += w * f[k];
    }
    halve_stage<8, 8>(acc, lane); halve_stage<4, 16>(acc, lane); halve_stage<2, 32>(acc, lane);
    *(unsigned*)(fbase + (size_t)(t0 + IT) * cfg::D_MODEL) = cvt2(acc[0], acc[1]);
}
DI void peer_v_phase(volatile LAS unsigned* slot, const bf16* eid16, const bf16* wbuf, const unsigned char* V8S, bf16* ff, gu32* cnt, int tid) {
    using namespace cfg;
    const int wave = tid >> 6;
    int s, blk;
    while (peer_next_item(slot, cnt, tid, s, blk)) {
        int lane = tid & 63; asm volatile("" : "+v"(lane));
        const int grp = lane >> 3, sub = lane & 7;
        const i32x4_t rs = peer_rsrc(V8S + (size_t)s * (2u << 20), 2u << 20);
        const int t0 = blk * PEER_BLK + wave * 16;
        bf16* fbase = ff + (size_t)s * 128 + sub * 16 + 8 * (grp & 1) + 4 * ((grp >> 1) & 1) + 2 * (grp >> 2);
        u32x4 eA[2], eB[2], wA[2], wB[2], r[16];
        { const bf16* ep = eid16 + (size_t)t0 * 128 + grp * 16; PEER_G_ISSUE(eA[0], ep); PEER_G_ISSUE(eA[1], ep + 8); PEER_G_ISSUE(eB[0], ep + 128); PEER_G_ISSUE(eB[1], ep + 136);
          const bf16* wp = wbuf + (size_t)t0 * 128 + grp * 16; PEER_G_ISSUE(wA[0], wp); PEER_G_ISSUE(wA[1], wp + 8); }
        peer_wait2<4>(eA[0], eA[1], eA[0], eA[1]);
#pragma unroll
        for (int i = 0; i < 16; ++i) { const int vo = peer_voff(eA, i, sub); if (i == 0) PEER_ROW_ISSUE_FIRST(r[i], vo, rs); else PEER_ROW_ISSUE(r[i], vo, rs); }
        peer_v_token<0>(r, eB, eA, wA, wB, rs, eid16, wbuf, fbase, t0, grp, sub, lane);   peer_v_token<1>(r, eA, eB, wB, wA, rs, eid16, wbuf, fbase, t0, grp, sub, lane);
        peer_v_token<2>(r, eB, eA, wA, wB, rs, eid16, wbuf, fbase, t0, grp, sub, lane);   peer_v_token<3>(r, eA, eB, wB, wA, rs, eid16, wbuf, fbase, t0, grp, sub, lane);
        peer_v_token<4>(r, eB, eA, wA, wB, rs, eid16, wbuf, fbase, t0, grp, sub, lane);   peer_v_token<5>(r, eA, eB, wB, wA, rs, eid16, wbuf, fbase, t0, grp, sub, lane);
        peer_v_token<6>(r, eB, eA, wA, wB, rs, eid16, wbuf, fbase, t0, grp, sub, lane);   peer_v_token<7>(r, eA, eB, wB, wA, rs, eid16, wbuf, fbase, t0, grp, sub, lane);
        peer_v_token<8>(r, eB, eA, wA, wB, rs, eid16, wbuf, fbase, t0, grp, sub, lane);   peer_v_token<9>(r, eA, eB, wB, wA, rs, eid16, wbuf, fbase, t0, grp, sub, lane);
        peer_v_token<10>(r, eB, eA, wA, wB, rs, eid16, wbuf, fbase, t0, grp, sub, lane);  peer_v_token<11>(r, eA, eB, wB, wA, rs, eid16, wbuf, fbase, t0, grp, sub, lane);
        peer_v_token<12>(r, eB, eA, wA, wB, rs, eid16, wbuf, fbase, t0, grp, sub, lane);  peer_v_token<13>(r, eA, eB, wB, wA, rs, eid16, wbuf, fbase, t0, grp, sub, lane);
        peer_v_token<14>(r, eB, eA, wA, wB, rs, eid16, wbuf, fbase, t0, grp, sub, lane);  peer_v_token<15>(r, eA, eB, wB, wA, rs, eid16, wbuf, fbase, t0, grp, sub, lane);
    }
}
DI void peer_ln_pass(const bf16* H2, const bf16* ff, const float* g, const float* bt, float* out, int gw, int NGW, int lane) {
    using namespace cfg;
    for (int t = gw; t < NTOK; t += NGW) {
        const bf16* xr = H2 + (size_t)t * D_MODEL + lane * 16; const bf16* fr = ff + (size_t)t * D_MODEL + lane * 16;
        const u32x4 xa = *(const u32x4*)xr, xb = *(const u32x4*)(xr + 8), fa = *(const u32x4*)fr, fb = *(const u32x4*)(fr + 8);
        float z[16] = {ALPHA * bf_lo(xa.x) + bf_lo(fa.x), ALPHA * bf_hi(xa.x) + bf_hi(fa.x), ALPHA * bf_lo(xa.y) + bf_lo(fa.y), ALPHA * bf_hi(xa.y) + bf_hi(fa.y), ALPHA * bf_lo(xa.z) + bf_lo(fa.z), ALPHA * bf_hi(xa.z) + bf_hi(fa.z), ALPHA * bf_lo(xa.w) + bf_lo(fa.w), ALPHA * bf_hi(xa.w) + bf_hi(fa.w),
                       ALPHA * bf_lo(xb.x) + bf_lo(fb.x), ALPHA * bf_hi(xb.x) + bf_hi(fb.x), ALPHA * bf_lo(xb.y) + bf_lo(fb.y), ALPHA * bf_hi(xb.y) + bf_hi(fb.y), ALPHA * bf_lo(xb.z) + bf_lo(fb.z), ALPHA * bf_hi(xb.z) + bf_hi(fb.z), ALPHA * bf_lo(xb.w) + bf_lo(fb.w), ALPHA * bf_hi(xb.w) + bf_hi(fb.w)};
        float s = 0.f;
#pragma unroll
        for (int i = 0; i < 16; ++i) s += z[i];
        const float mean = wave_sum(s) * (1.f / 1024.f); float qv = 0.f;
#pragma unroll
        for (int i = 0; i < 16; ++i) { z[i] -= mean; qv += z[i] * z[i]; }
        const float rstd = 1.0f / sqrtf(wave_sum(qv) * (1.f / 1024.f) + LN_EPS);
        float* op = out + (size_t)t * D_MODEL + lane * 16;
#pragma unroll
        for (int q4 = 0; q4 < 4; ++q4) { const f32x4 g0 = *(const f32x4*)(g + lane * 16 + 4 * q4), b0 = *(const f32x4*)(bt + lane * 16 + 4 * q4); f32x4 o;
#pragma unroll
            for (int i = 0; i < 4; ++i) o[i] = z[4 * q4 + i] * rstd * g0[i] + b0[i];
            *(f32x4*)(op + 4 * q4) = o; }
    }
}
constexpr int PROJ_LD = 5632;
constexpr int PC_Q = 0, PC_K = 512, PC_V = 1024, PC_R = 2048, PC_G = 3072, PC_Z = 3088, PC_XBC = 4112, PC_DT = 5392;
struct MixBufs { const bf16* proj; const float* glow; const float* dtraw; bf16* gS; float* gdec; bf16* sS; float* sdec; bf16* oy; int nbatch; };

DI float log_sigmoid_f(float z) { return fminf(z, 0.f) - __logf(1.0f + __expf(-fabsf(z))); }
DI float silu_f(float x) { return x / (1.0f + __expf(-x)); }
DI float bf2f(bf16 v) { return __uint_as_float((unsigned)v << 16); }
DI bf16 f2bf16(float f) { return (bf16)(cvt2(f, 0.f) & 0xffffu); }

DI void gla_gate(LAS unsigned char* lds, const float* glow_rows, const float* wg2, const float* bg, int h, int tid, float (&b)[16], float& blast) {
    LAS float* gl = (LAS float*)lds; LAS float* tot = (LAS float*)(lds + 4096);
    gl[tid] = glow_rows[tid]; gl[tid + 512] = glow_rows[tid + 512];
    const int d = tid & 127, tb = tid >> 7;
    float wc[16];
#pragma unroll
    for (int r = 0; r < 16; ++r) wc[r] = wg2[r * 512 + h * 128 + d];
    const float bgv = bg[h * 128 + d];
    WG_SYNC();
    float run = 0.f;
#pragma unroll
    for (int i = 0; i < 16; ++i) { const LAS float* g = gl + (tb * 16 + i) * 16; float z = bgv;
#pragma unroll
        for (int r = 0; r < 16; ++r) z += g[r] * wc[r];
        run += log_sigmoid_f(z) * 0.0625f; b[i] = run; }
    tot[tb * 128 + d] = run;
    WG_SYNC();
    const float t0 = tot[d], t1 = tot[128 + d], t2 = tot[256 + d], t3 = tot[384 + d];
    const float off = tb == 0 ? 0.f : tb == 1 ? t0 : tb == 2 ? t0 + t1 : t0 + t1 + t2;
    blast = (t0 + t1) + (t2 + t3);
#pragma unroll
    for (int i = 0; i < 16; ++i) b[i] += off;
}

DI void gla_gate_pre(LAS unsigned char* lds, const float (&wc)[16], float bgv, int tid, float (&b)[16], float& blast) {
    LAS float* gl = (LAS float*)lds; LAS float* tot = (LAS float*)(lds + 4096);
    const int d = tid & 127, tb = tid >> 7;
    float run = 0.f;
#pragma unroll
    for (int i = 0; i < 16; ++i) { const LAS float* g = gl + (tb * 16 + i) * 16; float z = bgv;
#pragma unroll
        for (int r = 0; r < 16; ++r) z += g[r] * wc[r];
        run += log_sigmoid_f(z) * 0.0625f; b[i] = run; }
    tot[tb * 128 + d] = run;
    WG_SYNC();
    const float t0 = tot[d], t1 = tot[128 + d], t2 = tot[256 + d], t3 = tot[384 + d];
    const float off = tb == 0 ? 0.f : tb == 1 ? t0 : tb == 2 ? t0 + t1 : t0 + t1 + t2;
    blast = (t0 + t1) + (t2 + t3);
#pragma unroll
    for (int i = 0; i < 16; ++i) b[i] += off;
}

constexpr int GA_KH = 8192, GA_KHP = 320, GA_V = GA_KH + 64 * GA_KHP, GA_VP = 576, GA_ST = GA_V + 64 * GA_VP, GA_STP = 272;
static_assert(GA_ST + 256 * GA_STP <= 152 * 1024, "GLA-A LDS");
DI void gla_a_phase(LAS unsigned char* lds, const MixBufs& mb, const float* wg2, const float* bg, int G, int bx, int tid) {
    using namespace cfg;
    const int wave = tid >> 6;
    const int nitem = mb.nbatch * GLA_HEADS * (SEQ / 64);
    for (int it = bx; it < nitem; it += G) {
        int lane = tid & 63; asm volatile("" : "+v"(lane));
        const int i16 = lane & 15, gi = (lane >> 4) & 1, hh = lane >> 5;
        const int bh = it / (SEQ / 64), c = it % (SEQ / 64), bl = bh / GLA_HEADS, h = bh % GLA_HEADS;
        const size_t row0 = (size_t)bl * SEQ + (size_t)c * 64;
        const bf16* prow = mb.proj + row0 * PROJ_LD;
        const int d = tid & 127, tb = tid >> 7;
        const float g0 = mb.glow[row0 * 16 + tid], g1 = mb.glow[row0 * 16 + tid + 512];
        float wc[16];
#pragma unroll
        for (int r = 0; r < 16; ++r) wc[r] = wg2[r * 512 + h * 128 + d];
        const float bgv = bg[h * 128 + d];
        u32x4 kraw[2], vraw[4];
#pragma unroll
        for (int j = 0; j < 2; ++j) { const int id = tid + 512 * j, t = id >> 4, ch = id & 15; kraw[j] = *(const u32x4*)(prow + (size_t)t * PROJ_LD + PC_K + h * 128 + ch * 8); }
#pragma unroll
        for (int j = 0; j < 4; ++j) { const int id = tid + 512 * j, t = id >> 5, ch = id & 31; vraw[j] = *(const u32x4*)(prow + (size_t)t * PROJ_LD + PC_V + h * 256 + ch * 8); }
        ((LAS float*)lds)[tid] = g0; ((LAS float*)lds)[tid + 512] = g1;
#pragma unroll
        for (int j = 0; j < 2; ++j) { const int id = tid + 512 * j, t = id >> 4, ch = id & 15; *(LAS u32x4*)(lds + GA_KH + t * GA_KHP + ch * 16) = kraw[j]; }
#pragma unroll
        for (int j = 0; j < 4; ++j) { const int id = tid + 512 * j, t = id >> 5, ch = id & 31; *(LAS u32x4*)(lds + GA_V + t * GA_VP + ch * 16) = vraw[j]; }
        WG_SYNC();
        float b[16], blast;
        gla_gate_pre(lds, wc, bgv, tid, b, blast);
#pragma unroll
        for (int i = 0; i < 16; ++i) { const int t = tb * 16 + i; LAS bf16* kp = (LAS bf16*)(lds + GA_KH + t * GA_KHP + d * 2); *kp = f2bf16(bf2f(*kp) * __expf(blast - b[i])); }
        if (tb == 0) mb.gdec[((size_t)bh * (SEQ / 64) + c) * 128 + d] = __expf(blast);
        WG_SYNC();
        const int dtile = wave & 3, eq = wave >> 2;
        f32x16 acc[4];
#pragma unroll
        for (int j = 0; j < 4; ++j)
#pragma unroll
            for (int i = 0; i < 16; ++i) acc[j][i] = 0.f;
        const LAS unsigned char* ka = lds + GA_KH + (8 * hh + (i16 >> 2)) * GA_KHP + (dtile * 32 + 16 * gi + 4 * (i16 & 3)) * 2;
        const LAS unsigned char* va = lds + GA_V + (8 * hh + (i16 >> 2)) * GA_VP + (eq * 128 + 16 * gi + 4 * (i16 & 3)) * 2;
#pragma unroll
        for (int s = 0; s < 4; ++s) {
            const bf16x8 af = cat8(tr_read(ka + 16 * s * GA_KHP), tr_read(ka + (16 * s + 4) * GA_KHP));
#pragma unroll
            for (int j = 0; j < 4; ++j) { const bf16x8 bfr = cat8(tr_read(va + 16 * s * GA_VP + j * 64), tr_read(va + (16 * s + 4) * GA_VP + j * 64)); acc[j] = MFMA32(af, bfr, acc[j]); }
        }
#pragma unroll
        for (int j = 0; j < 4; ++j)
#pragma unroll
            for (int r4 = 0; r4 < 4; ++r4) { u32x2 w; w.x = cvt2(acc[j][4 * r4], acc[j][4 * r4 + 1]); w.y = cvt2(acc[j][4 * r4 + 2], acc[j][4 * r4 + 3]);
                *(LAS u32x2*)(lds + GA_ST + ((eq * 4 + j) * 32 + (lane & 31)) * GA_STP + (dtile * 32 + 8 * r4 + 4 * hh) * 2) = w; }
        WG_SYNC();
        bf16* so = mb.gS + ((size_t)bh * (SEQ / 64) + c) * (256 * 128);
#pragma unroll
        for (int j = 0; j < 8; ++j) { const int id = tid + 512 * j, e = id >> 4, ch = id & 15;
            *(u32x4*)(so + e * 128 + ch * 8) = *(const LAS u32x4*)(lds + GA_ST + e * GA_STP + ch * 16); }
        WG_SYNC();
    }
}

DI void scan_b_phase(const MixBufs& mb, long gtid, long nthr) {
    using namespace cfg;
    const long ngla = (long)mb.nbatch * GLA_HEADS * 256 * 16, nssd = (long)mb.nbatch * SSD_HEADS * 64 * 8;
    for (long i = gtid; i < ngla + nssd; i += nthr) {
        const bool isg = i < ngla;
        bf16* sp; const float* dp; size_t cstride; int dstride;
        if (isg) { const int dg = (int)(i & 15), e = (int)((i >> 4) & 255), bh = (int)(i >> 12); sp = mb.gS + (size_t)bh * (SEQ / 64) * (256 * 128) + e * 128 + dg * 8; dp = mb.gdec + (size_t)bh * (SEQ / 64) * 128 + dg * 8; cstride = 256 * 128; dstride = 128; }
        else { const long j = i - ngla; const int ng = (int)(j & 7), p = (int)((j >> 3) & 63), bh = (int)(j >> 9); sp = mb.sS + (size_t)bh * (SEQ / 64) * 4096 + p * 64 + ng * 8; dp = mb.sdec + (size_t)bh * (SEQ / 64); cstride = 4096; dstride = 1; }
        float st[8];
#pragma unroll
        for (int k = 0; k < 8; ++k) st[k] = 0.f;
        for (int c0 = 0; c0 < SEQ / 64; c0 += 16) {
            u32x4 kv[16];
#pragma unroll
            for (int u = 0; u < 16; ++u) kv[u] = *(const u32x4*)(sp + (size_t)(c0 + u) * cstride);
#pragma unroll
            for (int u4 = 0; u4 < 16; u4 += 4) {
                f32x4 d0[4], d1[4];
#pragma unroll
                for (int u = 0; u < 4; ++u) { if (isg) { d0[u] = *(const f32x4*)(dp + (c0 + u4 + u) * dstride); d1[u] = *(const f32x4*)(dp + (c0 + u4 + u) * dstride + 4); } else { const float dc = dp[c0 + u4 + u]; d0[u] = (f32x4){dc, dc, dc, dc}; d1[u] = d0[u]; } }
#pragma unroll
                for (int u = 0; u < 4; ++u) { const u32x4 k4 = kv[u4 + u];
                    u32x4 o; o.x = cvt2(st[0], st[1]); o.y = cvt2(st[2], st[3]); o.z = cvt2(st[4], st[5]); o.w = cvt2(st[6], st[7]);
                    *(u32x4*)(sp + (size_t)(c0 + u4 + u) * cstride) = o;
                    st[0] = d0[u][0] * st[0] + bf_lo(k4.x); st[1] = d0[u][1] * st[1] + bf_hi(k4.x); st[2] = d0[u][2] * st[2] + bf_lo(k4.y); st[3] = d0[u][3] * st[3] + bf_hi(k4.y);
                    st[4] = d1[u][0] * st[4] + bf_lo(k4.z); st[5] = d1[u][1] * st[5] + bf_hi(k4.z); st[6] = d1[u][2] * st[6] + bf_lo(k4.w); st[7] = d1[u][3] * st[7] + bf_hi(k4.w); }
            }
        }
    }
}

constexpr int GC_SSQ = 6144, GC_QT = 8192, GC_QKP = 272, GC_KT = GC_QT + 64 * GC_QKP, GC_V = GC_KT + 64 * GC_QKP, GC_VP = 576, GC_P = GC_V + 64 * GC_VP, GC_PP = 144, GC_O = GC_P + 64 * GC_PP, GC_OP = 528;
static_assert(GC_O + 64 * GC_OP <= 152 * 1024, "GLA-C LDS");
DI void gla_c_phase(LAS unsigned char* lds, const MixBufs& mb, const float* wg2, const float* bg, const float* norm_g, int G, int bx, int tid) {
    using namespace cfg;
    const int wave = tid >> 6;
    const int nitem = mb.nbatch * GLA_HEADS * (SEQ / 64);
    for (int it = bx; it < nitem; it += G) {
        int lane = tid & 63; asm volatile("" : "+v"(lane));
        const int i16 = lane & 15, gi = (lane >> 4) & 1, hh = lane >> 5, l31 = lane & 31;
        const int bh = it / (SEQ / 64), c = it % (SEQ / 64), bl = bh / GLA_HEADS, h = bh % GLA_HEADS;
        const size_t row0 = (size_t)bl * SEQ + (size_t)c * 64;
        const bf16* prow = mb.proj + row0 * PROJ_LD;
        const int d = tid & 127, tb = tid >> 7;
        const float g0 = mb.glow[row0 * 16 + tid], g1 = mb.glow[row0 * 16 + tid + 512];
        float wc[16];
#pragma unroll
        for (int r = 0; r < 16; ++r) wc[r] = wg2[r * 512 + h * 128 + d];
        const float bgv = bg[h * 128 + d];
        u32x4 qraw[2], kraw[2], vraw[4], rraw[4]; bf16x8 sfr[8];
#pragma unroll
        for (int j = 0; j < 2; ++j) { const int id = tid + 512 * j, t = id >> 4, ch = id & 15; const bf16* pr = prow + (size_t)t * PROJ_LD + h * 128 + ch * 8; qraw[j] = *(const u32x4*)(pr + PC_Q); kraw[j] = *(const u32x4*)(pr + PC_K); }
#pragma unroll
        for (int j = 0; j < 4; ++j) { const int id = tid + 512 * j, t = id >> 5, ch = id & 31; vraw[j] = *(const u32x4*)(prow + (size_t)t * PROJ_LD + PC_V + h * 256 + ch * 8); }
        { const bf16* sin = mb.gS + (((size_t)bh * (SEQ / 64) + c) * 256 + wave * 32 + l31) * 128 + 8 * hh;
#pragma unroll
          for (int ks = 0; ks < 8; ++ks) sfr[ks] = *(const bf16x8*)(sin + 16 * ks); }
#pragma unroll
        for (int j = 0; j < 4; ++j) { const int id = tid + 512 * j, t = id >> 5, ch = id & 31; rraw[j] = *(const u32x4*)(prow + (size_t)t * PROJ_LD + PC_R + h * 256 + ch * 8); }
        ((LAS float*)lds)[tid] = g0; ((LAS float*)lds)[tid + 512] = g1;
#pragma unroll
        for (int j = 0; j < 2; ++j) { const int id = tid + 512 * j, t = id >> 4, ch = id & 15; *(LAS u32x4*)(lds + GC_QT + t * GC_QKP + ch * 16) = qraw[j]; *(LAS u32x4*)(lds + GC_KT + t * GC_QKP + ch * 16) = kraw[j]; }
#pragma unroll
        for (int j = 0; j < 4; ++j) { const int id = tid + 512 * j, t = id >> 5, ch = id & 31; *(LAS u32x4*)(lds + GC_V + t * GC_VP + ch * 16) = vraw[j]; }
        WG_SYNC();
        float b[16], blast;
        gla_gate_pre(lds, wc, bgv, tid, b, blast);
#pragma unroll
        for (int i = 0; i < 16; ++i) { const int t = tb * 16 + i; LAS bf16* qp = (LAS bf16*)(lds + GC_QT + t * GC_QKP + d * 2); LAS bf16* kp = (LAS bf16*)(lds + GC_KT + t * GC_QKP + d * 2);
            *qp = f2bf16(bf2f(*qp) * 0.08838834764831845f * __expf(b[i])); *kp = f2bf16(bf2f(*kp) * __expf(-b[i])); }
        WG_SYNC();
        if (wave < 3) {
            const int st = wave == 2 ? 1 : 0, tt = wave == 0 ? 0 : 1;
            f32x16 p;
#pragma unroll
            for (int i = 0; i < 16; ++i) p[i] = 0.f;
#pragma unroll
            for (int ks = 0; ks < 8; ++ks) { const bf16x8 af = *(const LAS bf16x8*)(lds + GC_KT + (st * 32 + l31) * GC_QKP + (16 * ks + 8 * hh) * 2);
                const bf16x8 bfr = *(const LAS bf16x8*)(lds + GC_QT + (tt * 32 + l31) * GC_QKP + (16 * ks + 8 * hh) * 2); p = MFMA32(af, bfr, p); }
            const int t = tt * 32 + l31;
#pragma unroll
            for (int r4 = 0; r4 < 4; ++r4) { const int s0 = st * 32 + 8 * r4 + 4 * hh; u32x2 w;
                w.x = cvt2(s0 <= t ? p[4 * r4] : 0.f, s0 + 1 <= t ? p[4 * r4 + 1] : 0.f); w.y = cvt2(s0 + 2 <= t ? p[4 * r4 + 2] : 0.f, s0 + 3 <= t ? p[4 * r4 + 3] : 0.f);
                *(LAS u32x2*)(lds + GC_P + t * GC_PP + s0 * 2) = w; }
        }
        WG_SYNC();
        f32x16 o[2];
#pragma unroll
        for (int tt = 0; tt < 2; ++tt)
#pragma unroll
            for (int i = 0; i < 16; ++i) o[tt][i] = 0.f;
        const LAS unsigned char* va = lds + GC_V + (8 * hh + (i16 >> 2)) * GC_VP + (wave * 32 + 16 * gi + 4 * (i16 & 3)) * 2;
#pragma unroll
        for (int ks = 0; ks < 4; ++ks) {
            const bf16x8 af = cat8(tr_read(va + 16 * ks * GC_VP), tr_read(va + (16 * ks + 4) * GC_VP));
            if (ks < 2) { const bf16x8 b0 = *(const LAS bf16x8*)(lds + GC_P + l31 * GC_PP + (16 * ks + 8 * hh) * 2); o[0] = MFMA32(af, b0, o[0]); }
            const bf16x8 b1 = *(const LAS bf16x8*)(lds + GC_P + (32 + l31) * GC_PP + (16 * ks + 8 * hh) * 2); o[1] = MFMA32(af, b1, o[1]);
        }
#pragma unroll
        for (int ks = 0; ks < 8; ++ks) { const bf16x8 af = sfr[ks];
#pragma unroll
            for (int tt = 0; tt < 2; ++tt) { const bf16x8 bfr = *(const LAS bf16x8*)(lds + GC_QT + (tt * 32 + l31) * GC_QKP + (16 * ks + 8 * hh) * 2); o[tt] = MFMA32(af, bfr, o[tt]); } }
#pragma unroll
        for (int tt = 0; tt < 2; ++tt) { float q = 0.f;
#pragma unroll
            for (int i = 0; i < 16; ++i) q += o[tt][i] * o[tt][i];
            q += __shfl_xor(q, 32);
            if (hh == 0) ((LAS float*)(lds + GC_SSQ))[wave * 64 + tt * 32 + l31] = q;
#pragma unroll
            for (int r4 = 0; r4 < 4; ++r4) { u32x2 w; w.x = cvt2(o[tt][4 * r4], o[tt][4 * r4 + 1]); w.y = cvt2(o[tt][4 * r4 + 2], o[tt][4 * r4 + 3]);
                *(LAS u32x2*)(lds + GC_O + (tt * 32 + l31) * GC_OP + (wave * 32 + 8 * r4 + 4 * hh) * 2) = w; } }
        WG_SYNC();
#pragma unroll
        for (int j = 0; j < 4; ++j) { const int id = tid + 512 * j, t = id >> 5, ch = id & 31;
            const LAS float* sq = (const LAS float*)(lds + GC_SSQ) + t; float ss = 0.f;
#pragma unroll
            for (int w = 0; w < 8; ++w) ss += sq[w * 64];
            const float rs = 1.0f / sqrtf(ss * (1.0f / 256.0f) + RMS_EPS);
            const u32x4 ov = *(const LAS u32x4*)(lds + GC_O + t * GC_OP + ch * 16);
            const u32x4 rv = rraw[j];
            const f32x4 g0 = *(const f32x4*)(norm_g + ch * 8), g1 = *(const f32x4*)(norm_g + ch * 8 + 4);
            u32x4 w;
            w.x = cvt2(bf_lo(ov.x) * rs * g0[0] * silu_f(bf_lo(rv.x)), bf_hi(ov.x) * rs * g0[1] * silu_f(bf_hi(rv.x)));
            w.y = cvt2(bf_lo(ov.y) * rs * g0[2] * silu_f(bf_lo(rv.y)), bf_hi(ov.y) * rs * g0[3] * silu_f(bf_hi(rv.y)));
            w.z = cvt2(bf_lo(ov.z) * rs * g1[0] * silu_f(bf_lo(rv.z)), bf_hi(ov.z) * rs * g1[1] * silu_f(bf_hi(rv.z)));
            w.w = cvt2(bf_lo(ov.w) * rs * g1[2] * silu_f(bf_lo(rv.w)), bf_hi(ov.w) * rs * g1[3] * silu_f(bf_hi(rv.w)));
            *(u32x4*)(mb.oy + (row0 + t) * D_MIX + h * 256 + ch * 8) = w; }
        WG_SYNC();
    }
}

constexpr int SD_DT = 0, SD_AC = 2048, SD_XS = 4096, SD_XP = 1088, SD_BM = SD_XS + 64 * SD_XP, SD_BP_TR = 192, SD_BP = 144, SD_CM = SD_BM + 64 * SD_BP_TR, SD_CW = SD_CM + 64 * SD_BP, SD_YP = 1040, SD_STP = 144;
static_assert(SD_CW + 5 * 640 * 4 <= 159 * 1024 && SD_XS + 64 * SD_YP <= SD_CW && SD_XS + 512 * SD_STP <= SD_CW, "SSD LDS");
DI float ssd_dt_scan(LAS unsigned char* lds, float dtraw_v, const float* dt_bias, const float* a_log, int g, int wave, int lane) {
    const int hd = g * 8 + wave;
    const float x = dtraw_v + dt_bias[hd];
    const float dtv = x > 0.f ? x + __logf(1.0f + __expf(-x)) : __logf(1.0f + __expf(x));
    float a = dtv * -__expf(a_log[hd]);
#pragma unroll
    for (int o = 1; o < 64; o <<= 1) { const float v = __shfl_up(a, o); if (lane >= o) a += v; }
    ((LAS float*)(lds + SD_DT))[lane * 8 + wave] = dtv; ((LAS float*)(lds + SD_AC))[lane * 8 + wave] = a;
    return __shfl(a, 63);
}
DI int ssd_xch(int g, int oc) { return oc < 64 ? g * 512 + oc * 8 : oc < 72 ? 1024 + g * 64 + (oc - 64) * 8 : 1152 + g * 64 + (oc - 72) * 8; }
DI void ssd_stage_cw(LAS unsigned char* lds, const float* cw, const float* cb, int g, int tid) {
    for (int i = tid; i < 5 * 640; i += NTHR) { const int k = i / 640, j = i % 640, xch = ssd_xch(g, j >> 3) + (j & 7);
        ((LAS float*)(lds + SD_CW))[i] = k < 4 ? cw[k * cfg::SSD_CONV_DIM + xch] : cb[xch]; }
}
template <int NT> DI void ssd_conv_load(u32x4 (&xin)[NT + 3], const bf16* prow, int g, int c, int oc, int t0) {
    const int xch = ssd_xch(g, oc);
#pragma unroll
    for (int i = 0; i < NT + 3; ++i) { const int t = t0 - 3 + i; xin[i] = (c == 0 && t < 0) ? (u32x4){0u, 0u, 0u, 0u} : *(const u32x4*)(prow + (long)t * PROJ_LD + PC_XBC + xch); }
}
template <int MODE, int NT> DI void ssd_conv_compute(LAS unsigned char* lds, const u32x4 (&xin)[NT + 3], int oc, int t0) {
    const LAS float* wl = (const LAS float*)(lds + SD_CW) + oc * 8;
    float w[4][8], bias[8];
#pragma unroll
    for (int k = 0; k < 4; ++k) { const f32x4 a = *(const LAS f32x4*)(wl + k * 640), b = *(const LAS f32x4*)(wl + k * 640 + 4);
        w[k][0] = a[0]; w[k][1] = a[1]; w[k][2] = a[2]; w[k][3] = a[3]; w[k][4] = b[0]; w[k][5] = b[1]; w[k][6] = b[2]; w[k][7] = b[3]; }
    { const f32x4 a = *(const LAS f32x4*)(wl + 4 * 640), b = *(const LAS f32x4*)(wl + 4 * 640 + 4); bias[0] = a[0]; bias[1] = a[1]; bias[2] = a[2]; bias[3] = a[3]; bias[4] = b[0]; bias[5] = b[1]; bias[6] = b[2]; bias[7] = b[3]; }
#pragma unroll
    for (int i = 0; i < NT; ++i) {
        float y[8];
#pragma unroll
        for (int j = 0; j < 8; ++j) y[j] = bias[j];
#pragma unroll
        for (int k = 0; k < 4; ++k) { const u32x4 v = xin[i + k];
            y[0] += w[k][0] * bf_lo(v.x); y[1] += w[k][1] * bf_hi(v.x); y[2] += w[k][2] * bf_lo(v.y); y[3] += w[k][3] * bf_hi(v.y);
            y[4] += w[k][4] * bf_lo(v.z); y[5] += w[k][5] * bf_hi(v.z); y[6] += w[k][6] * bf_lo(v.w); y[7] += w[k][7] * bf_hi(v.w); }
        const int t = t0 + i; float sc = 1.f;
        if (MODE == 0 && oc < 64) sc = ((const LAS float*)(lds + SD_DT))[t * 8 + (oc >> 3)];
#pragma unroll
        for (int j = 0; j < 8; ++j) y[j] = silu_f(y[j]) * sc;
        u32x4 o; o.x = cvt2(y[0], y[1]); o.y = cvt2(y[2], y[3]); o.z = cvt2(y[4], y[5]); o.w = cvt2(y[6], y[7]);
        if (oc < 64) *(LAS u32x4*)(lds + SD_XS + t * SD_XP + oc * 16) = o;
        else if (oc < 72) *(LAS u32x4*)(lds + SD_BM + t * (MODE == 0 ? SD_BP_TR : SD_BP) + (oc - 64) * 16) = o;
        else *(LAS u32x4*)(lds + SD_CM + t * SD_BP + (oc - 72) * 16) = o;
    }
}
DI void ssd_a_phase(LAS unsigned char* lds, const MixBufs& mb, const float* cw, const float* cb, const float* dt_bias, const float* a_log, int G, int bx, int tid) {
    using namespace cfg;
    const int wave = tid >> 6;
    const int nitem = mb.nbatch * SSD_GROUPS * (SEQ / 64);
    int gstaged = -1;
    for (int it = bx; it < nitem; it += G) {
        int lane = tid & 63; asm volatile("" : "+v"(lane));
        const int i16 = lane & 15, gi = (lane >> 4) & 1, hh = lane >> 5, l31 = lane & 31;
        const int bg = it / (SEQ / 64), c = it % (SEQ / 64), bl = bg / SSD_GROUPS, g = bg % SSD_GROUPS;
        const size_t row0 = (size_t)bl * SEQ + (size_t)c * 64;
        const bf16* prow = mb.proj + row0 * PROJ_LD;
        const float dtraw_v = mb.dtraw[row0 * 16 + lane * 16 + g * 8 + wave];
        u32x4 xin0[11], xin1[4];
        ssd_conv_load<8>(xin0, prow, g, c, tid & 63, (tid >> 6) * 8);
        ssd_conv_load<1>(xin1, prow, g, c, 64 + (tid & 7), tid >> 3);
        if (g != gstaged) { ssd_stage_cw(lds, cw, cb, g, tid); gstaged = g; }
        const float alast = ssd_dt_scan(lds, dtraw_v, dt_bias, a_log, g, wave, lane);
        { LAS float* dtp = (LAS float*)(lds + SD_DT) + lane * 8 + wave; const float ac = ((LAS float*)(lds + SD_AC))[lane * 8 + wave]; *dtp = *dtp * __expf(alast - ac); }
        if (lane == 0) mb.sdec[((size_t)bl * SSD_HEADS + g * 8 + wave) * (SEQ / 64) + c] = __expf(alast);
        WG_SYNC();
        ssd_conv_compute<0, 8>(lds, xin0, tid & 63, (tid >> 6) * 8);
        ssd_conv_compute<0, 1>(lds, xin1, 64 + (tid & 7), tid >> 3);
        WG_SYNC();
        f32x16 acc[2][2];
#pragma unroll
        for (int a = 0; a < 2; ++a)
#pragma unroll
            for (int b = 0; b < 2; ++b)
#pragma unroll
                for (int i = 0; i < 16; ++i) acc[a][b][i] = 0.f;
        const LAS unsigned char* ba = lds + SD_BM + (8 * hh + (i16 >> 2)) * SD_BP_TR + (16 * gi + 4 * (i16 & 3)) * 2;
        const LAS unsigned char* xa = lds + SD_XS + (8 * hh + (i16 >> 2)) * SD_XP + (wave * 64 + 16 * gi + 4 * (i16 & 3)) * 2;
#pragma unroll
        for (int s = 0; s < 4; ++s) {
            bf16x8 af[2], bfr[2];
#pragma unroll
            for (int nt = 0; nt < 2; ++nt) af[nt] = cat8(tr_read(ba + 16 * s * SD_BP_TR + nt * 64), tr_read(ba + (16 * s + 4) * SD_BP_TR + nt * 64));
#pragma unroll
            for (int pt = 0; pt < 2; ++pt) bfr[pt] = cat8(tr_read(xa + 16 * s * SD_XP + pt * 64), tr_read(xa + (16 * s + 4) * SD_XP + pt * 64));
#pragma unroll
            for (int nt = 0; nt < 2; ++nt)
#pragma unroll
                for (int pt = 0; pt < 2; ++pt) acc[nt][pt] = MFMA32(af[nt], bfr[pt], acc[nt][pt]);
        }
        WG_SYNC();
#pragma unroll
        for (int nt = 0; nt < 2; ++nt)
#pragma unroll
            for (int pt = 0; pt < 2; ++pt)
#pragma unroll
                for (int r4 = 0; r4 < 4; ++r4) { u32x2 w; w.x = cvt2(acc[nt][pt][4 * r4], acc[nt][pt][4 * r4 + 1]); w.y = cvt2(acc[nt][pt][4 * r4 + 2], acc[nt][pt][4 * r4 + 3]);
                    *(LAS u32x2*)(lds + SD_XS + (wave * 64 + pt * 32 + l31) * SD_STP + (nt * 32 + 8 * r4 + 4 * hh) * 2) = w; }
        WG_SYNC();
#pragma unroll
        for (int j = 0; j < 8; ++j) { const int id = tid + 512 * j, hd = id >> 9, p = (id >> 3) & 63, ch = id & 7;
            *(u32x4*)(mb.sS + ((((size_t)bl * SSD_HEADS + g * 8 + hd) * (SEQ / 64) + c) * 64 + p) * 64 + ch * 8) = *(const LAS u32x4*)(lds + SD_XS + (hd * 64 + p) * SD_STP + ch * 16); }
        WG_SYNC();
    }
}
DI void ssd_c_phase(LAS unsigned char* lds, const MixBufs& mb, const float* cw, const float* cb, const float* dt_bias, const float* a_log, const float* dskip, const float* norm_g, int G, int bx, int tid) {
    using namespace cfg;
    const int wave = tid >> 6;
    const int nitem = mb.nbatch * SSD_GROUPS * (SEQ / 64);
    int gstaged = -1;
    for (int it = bx; it < nitem; it += G) {
        int lane = tid & 63; asm volatile("" : "+v"(lane));
        const int i16 = lane & 15, gi = (lane >> 4) & 1, hh = lane >> 5, l31 = lane & 31;
        const int bg = it / (SEQ / 64), c = it % (SEQ / 64), bl = bg / SSD_GROUPS, g = bg % SSD_GROUPS, hd = g * 8 + wave;
        const size_t row0 = (size_t)bl * SEQ + (size_t)c * 64;
        const bf16* prow = mb.proj + row0 * PROJ_LD;
        const float dtraw_v = mb.dtraw[row0 * 16 + lane * 16 + g * 8 + wave];
        u32x4 xin0[11], xin1[4], xin2[4];
        ssd_conv_load<8>(xin0, prow, g, c, tid & 63, (tid >> 6) * 8);
        ssd_conv_load<1>(xin1, prow, g, c, 64 + (tid & 15), tid >> 4);
        ssd_conv_load<1>(xin2, prow, g, c, 64 + (tid & 15), 32 + (tid >> 4));
        if (g != gstaged) { ssd_stage_cw(lds, cw, cb, g, tid); gstaged = g; WG_SYNC(); }
        (void)ssd_dt_scan(lds, dtraw_v, dt_bias, a_log, g, wave, lane);
        ssd_conv_compute<1, 8>(lds, xin0, tid & 63, (tid >> 6) * 8);
        ssd_conv_compute<1, 1>(lds, xin1, 64 + (tid & 15), tid >> 4);
        ssd_conv_compute<1, 1>(lds, xin2, 64 + (tid & 15), 32 + (tid >> 4));
        bf16x8 hfr[2][4];
        { const bf16* hin = mb.sS + ((((size_t)bl * SSD_HEADS + hd) * (SEQ / 64) + c) * 64 + l31) * 64 + 8 * hh;
#pragma unroll
          for (int pt = 0; pt < 2; ++pt)
#pragma unroll
              for (int ks = 0; ks < 4; ++ks) hfr[pt][ks] = *(const bf16x8*)(hin + pt * 32 * 64 + 16 * ks); }
        WG_SYNC();
        const LAS float* dtl = (const LAS float*)(lds + SD_DT); const LAS float* acl = (const LAS float*)(lds + SD_AC);
        f32x16 gt[3];
#pragma unroll
        for (int q = 0; q < 3; ++q) { const int st = q == 2 ? 1 : 0, tt = q == 0 ? 0 : 1;
#pragma unroll
            for (int i = 0; i < 16; ++i) gt[q][i] = 0.f;
#pragma unroll
            for (int ks = 0; ks < 4; ++ks) { const bf16x8 af = *(const LAS bf16x8*)(lds + SD_BM + (st * 32 + l31) * SD_BP + (16 * ks + 8 * hh) * 2);
                const bf16x8 bfr = *(const LAS bf16x8*)(lds + SD_CM + (tt * 32 + l31) * SD_BP + (16 * ks + 8 * hh) * 2); gt[q] = MFMA32(af, bfr, gt[q]); } }
        bf16x8 mf[3][2];
#pragma unroll
        for (int q = 0; q < 3; ++q) { const int st = q == 2 ? 1 : 0, tt = q == 0 ? 0 : 1; const int t = tt * 32 + l31; const float at = acl[t * 8 + wave];
            float e[16];
#pragma unroll
            for (int i = 0; i < 16; ++i) { const int s = st * 32 + (i & 3) + 8 * (i >> 2) + 4 * hh; e[i] = s <= t ? gt[q][i] * __expf(at - acl[s * 8 + wave]) * dtl[s * 8 + wave] : 0.f; }
#pragma unroll
            for (int s2 = 0; s2 < 2; ++s2) { u32x4 w; w.x = cvt2(e[8 * s2], e[8 * s2 + 1]); w.y = cvt2(e[8 * s2 + 2], e[8 * s2 + 3]); w.z = cvt2(e[8 * s2 + 4], e[8 * s2 + 5]); w.w = cvt2(e[8 * s2 + 6], e[8 * s2 + 7]); mf[q][s2] = __builtin_bit_cast(bf16x8, w); } }
        f32x16 yd[2][2];
#pragma unroll
        for (int a = 0; a < 2; ++a)
#pragma unroll
            for (int b = 0; b < 2; ++b)
#pragma unroll
                for (int i = 0; i < 16; ++i) yd[a][b][i] = 0.f;
#pragma unroll
        for (int ks = 0; ks < 4; ++ks) { bf16x8 cf[2];
#pragma unroll
            for (int tt = 0; tt < 2; ++tt) cf[tt] = *(const LAS bf16x8*)(lds + SD_CM + (tt * 32 + l31) * SD_BP + (16 * ks + 8 * hh) * 2);
#pragma unroll
            for (int pt = 0; pt < 2; ++pt)
#pragma unroll
                for (int tt = 0; tt < 2; ++tt) yd[pt][tt] = MFMA32(hfr[pt][ks], cf[tt], yd[pt][tt]); }
#pragma unroll
        for (int tt = 0; tt < 2; ++tt) { const float ea = __expf(acl[(tt * 32 + l31) * 8 + wave]);
#pragma unroll
            for (int pt = 0; pt < 2; ++pt)
#pragma unroll
                for (int i = 0; i < 16; ++i) yd[pt][tt][i] *= ea; }
        const LAS unsigned char* xa = lds + SD_XS + (4 * hh + (i16 >> 2)) * SD_XP + (wave * 64 + 16 * gi + 4 * (i16 & 3)) * 2;
#pragma unroll
        for (int pt = 0; pt < 2; ++pt)
#pragma unroll
            for (int st = 0; st < 2; ++st)
#pragma unroll
                for (int s2 = 0; s2 < 2; ++s2) { const LAS unsigned char* a = xa + (st * 32 + 16 * s2) * SD_XP + pt * 64; const bf16x8 xf = cat8(tr_read(a), tr_read(a + 8 * SD_XP));
                    if (st == 0) { yd[pt][0] = MFMA32(xf, mf[0][s2], yd[pt][0]); yd[pt][1] = MFMA32(xf, mf[1][s2], yd[pt][1]); }
                    else yd[pt][1] = MFMA32(xf, mf[2][s2], yd[pt][1]); }
        const float dsk = dskip[hd];
        u32x2 yw[2][2][4];
#pragma unroll
        for (int tt = 0; tt < 2; ++tt) { const int t = tt * 32 + l31;
#pragma unroll
            for (int pt = 0; pt < 2; ++pt)
#pragma unroll
                for (int r4 = 0; r4 < 4; ++r4) { const int p = pt * 32 + 8 * r4 + 4 * hh; const u32x2 xv = *(const LAS u32x2*)(lds + SD_XS + t * SD_XP + (wave * 64 + p) * 2);
                    const float y0 = yd[pt][tt][4 * r4] + dsk * bf_lo(xv.x), y1 = yd[pt][tt][4 * r4 + 1] + dsk * bf_hi(xv.x);
                    const float y2 = yd[pt][tt][4 * r4 + 2] + dsk * bf_lo(xv.y), y3 = yd[pt][tt][4 * r4 + 3] + dsk * bf_hi(xv.y);
                    yw[tt][pt][r4].x = cvt2(y0, y1); yw[tt][pt][r4].y = cvt2(y2, y3); } }
        u32x4 zraw[8];
#pragma unroll
        for (int j = 0; j < 8; ++j) zraw[j] = *(const u32x4*)(prow + (size_t)(tid >> 3) * PROJ_LD + PC_Z + g * 512 + (8 * j + (tid & 7)) * 8);
        WG_SYNC();
#pragma unroll
        for (int tt = 0; tt < 2; ++tt)
#pragma unroll
            for (int pt = 0; pt < 2; ++pt)
#pragma unroll
                for (int r4 = 0; r4 < 4; ++r4) *(LAS u32x2*)(lds + SD_XS + (tt * 32 + l31) * SD_YP + (wave * 64 + pt * 32 + 8 * r4 + 4 * hh) * 2) = yw[tt][pt][r4];
        WG_SYNC();
        { const int t = tid >> 3, sub = tid & 7; float u[8][8]; float ss = 0.f;
#pragma unroll
            for (int j = 0; j < 8; ++j) { const int ch = 8 * j + sub; const u32x4 yv = *(const LAS u32x4*)(lds + SD_XS + t * SD_YP + ch * 16);
                const u32x4 zv = zraw[j];
                u[j][0] = bf_lo(yv.x) * silu_f(bf_lo(zv.x)); u[j][1] = bf_hi(yv.x) * silu_f(bf_hi(zv.x)); u[j][2] = bf_lo(yv.y) * silu_f(bf_lo(zv.y)); u[j][3] = bf_hi(yv.y) * silu_f(bf_hi(zv.y));
                u[j][4] = bf_lo(yv.z) * silu_f(bf_lo(zv.z)); u[j][5] = bf_hi(yv.z) * silu_f(bf_hi(zv.z)); u[j][6] = bf_lo(yv.w) * silu_f(bf_lo(zv.w)); u[j][7] = bf_hi(yv.w) * silu_f(bf_hi(zv.w));
#pragma unroll
                for (int k = 0; k < 8; ++k) ss += u[j][k] * u[j][k]; }
            ss += __shfl_xor(ss, 1); ss += __shfl_xor(ss, 2); ss += __shfl_xor(ss, 4);
            const float rs = 1.0f / sqrtf(ss * (1.0f / 512.0f) + RMS_EPS);
#pragma unroll
            for (int j = 0; j < 8; ++j) { const int ch = 8 * j + sub; const float* ng = norm_g + g * 512 + ch * 8; const f32x4 g0 = *(const f32x4*)ng, g1 = *(const f32x4*)(ng + 4);
                u32x4 w; w.x = cvt2(u[j][0] * rs * g0[0], u[j][1] * rs * g0[1]); w.y = cvt2(u[j][2] * rs * g0[2], u[j][3] * rs * g0[3]);
                w.z = cvt2(u[j][4] * rs * g1[0], u[j][5] * rs * g1[1]); w.w = cvt2(u[j][6] * rs * g1[2], u[j][7] * rs * g1[3]);
                *(u32x4*)(mb.oy + (row0 + t) * D_MIX + GLA_DV + g * 512 + ch * 8) = w; } }
        WG_SYNC();
    }
}

using namespace cfg;
constexpr int RING_OFF = 0, LDSCTL_OFF = 159 * 1024, MISC_OFF = LDSCTL_OFF + 320, LDS_BYTES = 160 * 1024;
constexpr size_t MiB = 1u << 20;
constexpr size_t WS_CTL = 0, CTL_ZERO_BYTES = 1 * MiB;
constexpr int CW_BAR = 4096;
constexpr int HB = 2, MH = HB * SEQ;
constexpr size_t WS_PROJ = 1 * MiB;
constexpr size_t WS_GS = 177 * MiB, WS_GDEC = 241 * MiB, WS_SS = 242 * MiB, WS_SDEC = 274 * MiB, WS_GLOW = 275 * MiB, WS_DTRAW = 276 * MiB;
constexpr size_t WS_H1 = 1 * MiB, WS_QA = 65 * MiB, WS_H2 = 129 * MiB, WS_PICKS = 193 * MiB;
constexpr size_t WS_ACTP = 209 * MiB, WS_WBUF = 337 * MiB, WS_EID = 345 * MiB;
constexpr int CW_PEER = 8192;
constexpr size_t WS_XB = 309 * MiB;
constexpr size_t WS_W = 376 * MiB;
constexpr int N1P = 5632;
constexpr size_t OW_IN = 0, OW_OUT = OW_IN + (size_t)N1P * 1024 * 2, OW_Q = OW_OUT + (size_t)1024 * 2048 * 2, OW_K = OW_Q + 2 * MiB, OW_V = OW_K + 2 * MiB, OW_O = OW_V + 2 * MiB, OW_PQ = OW_O + 2 * MiB, OW_END = OW_PQ + 2 * MiB;
static_assert(OW_END <= 28 * MiB, "weights region");
constexpr size_t WS_U = 404 * MiB, WS_V = 420 * MiB, WS_SU = 436 * MiB, WS_SV = 437 * MiB,
                  WS_MEMB = 468 * MiB, WS_KC = 470 * MiB, WS_VC = 472 * MiB, WS_END = 474 * MiB;

__device__ __forceinline__ void p0_transpose_item(const float* W, int K, int N, bf16* WT, LAS float* scr, int item, int lane) {
    const int nblk = N / 32, kb = item / nblk, nb = item % nblk, k0 = 64 * kb, n0 = 32 * nb;
#pragma unroll 8
    for (int i = 0; i < 32; ++i) { const int kk = 2 * i + (lane >> 5); scr[kk * 33 + (lane & 31)] = W[(size_t)(k0 + kk) * N + n0 + (lane & 31)]; }
    LDS_WAIT(); asm volatile("" ::: "memory");
    const int c = lane & 7;
#pragma unroll
    for (int j = 0; j < 4; ++j) { const int n = (lane >> 3) + 8 * j; const LAS float* s = scr + (8 * c) * 33 + n;
        v4u o; o.x = pk2(s[0 * 33], s[1 * 33]); o.y = pk2(s[2 * 33], s[3 * 33]); o.z = pk2(s[4 * 33], s[5 * 33]); o.w = pk2(s[6 * 33], s[7 * 33]);
        *(GAS v4u*)(WT + (size_t)(n0 + n) * K + k0 + 8 * c) = o; }
    LDS_WAIT(); asm volatile("" ::: "memory");
}
__device__ __forceinline__ void cvt_rows(const float* src, bf16* dst, long n, long gtid, long nthr) {
    for (long i = gtid * 8; i < n; i += nthr * 8) { const f32x4 a = *(const f32x4*)(src + i), b = *(const f32x4*)(src + i + 4);
        v4u o; o.x = cvt2(a.x, a.y); o.y = cvt2(a.z, a.w); o.z = cvt2(b.x, b.y); o.w = cvt2(b.z, b.w); *(v4u*)(dst + i) = o; }
}
__device__ __forceinline__ void cvt_rows_ld(const float* src, bf16* dst, long n, long gtid, long nthr) { cvt_rows(src, dst, n, gtid, nthr); }

struct In27 { const float* p[27]; };
struct Args { In27 in; float* out; unsigned char* ws; };

__global__ void __launch_bounds__(NTHR, 2) mega(Args args) {
    extern __shared__ __attribute__((aligned(16))) unsigned char lds_raw[];
    LAS unsigned char* lds = (LAS unsigned char*)lds_raw;
    volatile LAS unsigned* MISC = (volatile LAS unsigned*)(lds + MISC_OFF);
    const int tid = threadIdx.x, lane = tid & 63, wave = __builtin_amdgcn_readfirstlane(tid >> 6);
    const int G = gridDim.x; const int bx = blockIdx.x; const int vcu = (G % 8 == 0) ? (bx % 8) * (G / 8) + bx / 8 : bx;
    unsigned char* ws = args.ws;
    gu32* ctl = (gu32*)(ws + WS_CTL);
    for (int u = tid; u < (LDS_BYTES - LDSCTL_OFF) / 4; u += NTHR) ((LAS unsigned*)(lds + LDSCTL_OFF))[u] = 0u;
    __syncthreads();
    XcdBarrier bar = xcd_barrier_post((unsigned*)(ctl + CW_BAR), MISC + 8);
    const long nthr = (long)G * NTHR;
    const int gw = vcu * NWAVES + wave, NGW = G * NWAVES;
#define GRID_BAR() xcd_barrier(bar)
    {
        unsigned char* ws = args.ws; asm volatile("" : "+s"(ws));
        unsigned char* wbase = ws + WS_W;
        bf16* w_in_t = (bf16*)(wbase + OW_IN); bf16* w_out_t = (bf16*)(wbase + OW_OUT); bf16* wq_t = (bf16*)(wbase + OW_Q); bf16* wk_t = (bf16*)(wbase + OW_K);
        bf16* wv_t = (bf16*)(wbase + OW_V); bf16* wo_t = (bf16*)(wbase + OW_O); bf16* pwq_t = (bf16*)(wbase + OW_PQ);
        bf16* x_bf = (bf16*)(ws + WS_XB); unsigned char* u8 = ws + WS_U; unsigned char* v8 = ws + WS_V; float* su = (float*)(ws + WS_SU); float* sv = (float*)(ws + WS_SV); bf16* mem_bf = (bf16*)(ws + WS_MEMB);
        bf16* kc = (bf16*)(ws + WS_KC); bf16* vc = (bf16*)(ws + WS_VC);
        bf16* h1 = (bf16*)(ws + WS_H1); bf16* qa = (bf16*)(ws + WS_QA); bf16* h2 = (bf16*)(ws + WS_H2); unsigned* picks = (unsigned*)(ws + WS_PICKS);
        bf16* oy_all = (bf16*)args.out;
        bf16* projb = (bf16*)(ws + WS_PROJ);
        const long gtid = (long)bx * NTHR + tid;
        LAS float* scr = (LAS float*)(lds + RING_OFF + wave * 16384);
        constexpr int I_IN = (D_MODEL / 64) * (D_IN_PROJ / 32), I_OUT = (D_MIX / 64) * (D_MODEL / 32), I_SQ = (D_MODEL / 64) * (D_MODEL / 32);
        constexpr int NITEMS = I_IN + I_OUT + 5 * I_SQ;
        for (int it = gw; it < NITEMS; it += NGW) {
            int r = it; const float* W; int K = D_MODEL, N = D_MODEL; bf16* WT;
            if (r < I_IN) { W = args.in.p[2]; N = D_IN_PROJ; WT = w_in_t; }
            else if ((r -= I_IN) < I_OUT) { W = args.in.p[12]; K = D_MIX; WT = w_out_t; }
            else { r -= I_OUT; const int which = r / I_SQ; r -= which * I_SQ; const int idx = which == 0 ? 15 : which == 1 ? 16 : which == 2 ? 17 : which == 3 ? 18 : 21; W = args.in.p[idx]; WT = wq_t + (size_t)which * D_MODEL * D_MODEL; }
            p0_transpose_item(W, K, N, WT, scr, r, lane);
        }
        for (long i = gtid * 8; i < (long)(N1P - D_IN_PROJ) * D_MODEL; i += nthr * 8) *(v4u*)(w_in_t + (size_t)D_IN_PROJ * D_MODEL + i) = (v4u){0u, 0u, 0u, 0u};
        cvt_fp8_rows(args.in.p[23], u8, su, PEER_EXPERTS, gw, NGW, lane);
        cvt_fp8_rows(args.in.p[24], v8, sv, PEER_EXPERTS, gw, NGW, lane);
        cvt_rows(args.in.p[1], mem_bf, (long)BATCH * MEM_LEN * D_MODEL, gtid, nthr);
        cvt_rows(args.in.p[0], x_bf, (long)NTOK * D_MODEL, gtid, nthr);
        GRID_BAR();
    }
#ifndef REPG
#define REPG 0
#endif
    constexpr int PROG0[] = {0, 1, 2, 3, 4, 5, 6, 7, 8, 9, 10, 11, 12, 13, 14, 15, 16, 17, 18, 19, 20, 21};
    constexpr int PROG1[] = {0, 1, 2, 3, 4, 5, 6, 7, 8, 9, 10, 11, 12, 13, 14, 15, 16, 17, 18, 19, 20, 21, 21};
    constexpr int PROG2[] = {0, 0, 1, 2, 3, 4, 4, 5, 6, 7, 8, 9, 10, 11, 12, 13, 14, 15, 16, 17, 18, 19, 20, 21};
    constexpr int PROG3[] = {0, 1, 1, 2, 3, 4, 5, 5, 6, 7, 8, 9, 10, 11, 12, 13, 14, 15, 16, 17, 18, 19, 20, 21};
    constexpr int PROG4[] = {0, 1, 2, 3, 3, 4, 5, 6, 7, 7, 8, 9, 10, 11, 12, 13, 14, 15, 16, 17, 18, 19, 20, 21};
    constexpr int PROG5[] = {0, 1, 2, 1, 2, 3, 4, 5, 6, 5, 6, 7, 8, 9, 10, 11, 12, 13, 14, 15, 16, 17, 18, 19, 20, 21};
    constexpr int PROG6[] = {0, 1, 2, 3, 4, 5, 6, 7, 8, 9, 8, 9, 10, 11, 12, 13, 14, 15, 14, 15, 16, 17, 18, 19, 20, 21};
    constexpr int PROG7[] = {0, 1, 2, 3, 4, 5, 6, 7, 8, 9, 10, 11, 12, 13, 10, 11, 12, 13, 14, 15, 16, 17, 18, 19, 20, 21};
    constexpr int PROG8[] = {0, 1, 2, 3, 4, 5, 6, 7, 8, 9, 10, 11, 12, 13, 14, 15, 16, 17, 16, 17, 18, 19, 20, 21};
    constexpr int PROG9[] = {0, 1, 2, 3, 4, 5, 6, 7, 8, 9, 10, 11, 12, 13, 14, 15, 16, 17, 17, 18, 19, 19, 20, 21};
    constexpr int PROGN = REPG == 0 ? 22 : REPG == 1 ? 23 : REPG == 2 ? 24 : REPG == 3 ? 24 : REPG == 4 ? 24 : REPG == 5 ? 26 : REPG == 6 ? 26 : REPG == 7 ? 26 : REPG == 8 ? 24 : 24;
    for (int pi = 0; pi < PROGN; ++pi) {
        const int st = REPG == 0 ? PROG0[pi] : REPG == 1 ? PROG1[pi] : REPG == 2 ? PROG2[pi] : REPG == 3 ? PROG3[pi] : REPG == 4 ? PROG4[pi] : REPG == 5 ? PROG5[pi] : REPG == 6 ? PROG6[pi] : REPG == 7 ? PROG7[pi] : REPG == 8 ? PROG8[pi] : PROG9[pi];
        unsigned char* ws = args.ws; asm volatile("" : "+s"(ws));
        unsigned char* wbase = ws + WS_W;
        bf16* w_in_t = (bf16*)(wbase + OW_IN); bf16* w_out_t = (bf16*)(wbase + OW_OUT); bf16* wq_t = (bf16*)(wbase + OW_Q); bf16* wk_t = (bf16*)(wbase + OW_K);
        bf16* wv_t = (bf16*)(wbase + OW_V); bf16* wo_t = (bf16*)(wbase + OW_O); bf16* pwq_t = (bf16*)(wbase + OW_PQ);
        bf16* x_bf = (bf16*)(ws + WS_XB); unsigned char* u8 = ws + WS_U; unsigned char* v8 = ws + WS_V; float* su = (float*)(ws + WS_SU); float* sv = (float*)(ws + WS_SV); bf16* mem_bf = (bf16*)(ws + WS_MEMB);
        bf16* kc = (bf16*)(ws + WS_KC); bf16* vc = (bf16*)(ws + WS_VC);
        bf16* h1 = (bf16*)(ws + WS_H1); bf16* qa = (bf16*)(ws + WS_QA); bf16* h2 = (bf16*)(ws + WS_H2); unsigned* picks = (unsigned*)(ws + WS_PICKS);
        bf16* oy_all = (bf16*)args.out;
        bf16* projb = (bf16*)(ws + WS_PROJ);
        int tid_ = threadIdx.x; asm volatile("" : "+v"(tid_));
        const long gtid = (long)bx * NTHR + tid_;
        int gk = -1; const int hf = st >> 2;
        if (st < 8) {
            MixBufs mb{projb, (const float*)(ws + WS_GLOW), (const float*)(ws + WS_DTRAW), (bf16*)(ws + WS_GS), (float*)(ws + WS_GDEC), (bf16*)(ws + WS_SS), (float*)(ws + WS_SDEC), oy_all + (size_t)hf * MH * D_MIX, HB};
            switch (st & 3) {
            case 0: gk = 0; break;
            case 1: ssd_a_phase(lds, mb, args.in.p[6], args.in.p[7], args.in.p[8], args.in.p[9], G, bx, tid_); gla_a_phase(lds, mb, args.in.p[3], args.in.p[4], G, bx, tid_); break;
            case 2: scan_b_phase(mb, gtid, nthr); break;
            default: ssd_c_phase(lds, mb, args.in.p[6], args.in.p[7], args.in.p[8], args.in.p[9], args.in.p[10], args.in.p[11], G, bx, tid_);
                     gla_c_phase(lds, mb, args.in.p[3], args.in.p[4], args.in.p[5], G, bx, tid_); break;
            }
        } else {
            switch (st) {
            case 8: gk = 1; break;
            case 9: ln_rows_bf16(h1, args.in.p[13], args.in.p[14], NTOK, gw, NGW, tid_ & 63); break;
            case 10: gk = 2; break;
            case 11: gk = 3; break;
            case 12: gk = 4; break;
            case 13: attn_phase(lds, qa, kc, vc, G, bx, tid_); break;
            case 14: gk = 5; break;
            case 15: ln_rows_bf16(h2, args.in.p[19], args.in.p[20], NTOK, gw, NGW, tid_ & 63); break;
            case 16: gk = 6; break;
            case 17: topk_phase(lds, qa, args.in.p[22], picks, (bf16*)(ws + WS_EID), G, bx, tid_); break;
            case 18: peer_u_phase(MISC + 16, h2, (const bf16*)(ws + WS_EID), u8, (float*)(ws + WS_ACTP), ctl + CW_PEER, tid_); break;
            case 19: peer_w_pass(picks, (const float*)(ws + WS_ACTP), su, sv, (bf16*)(ws + WS_WBUF), gw, NGW, tid_ & 63); break;
            case 20: peer_v_phase(MISC + 16, (const bf16*)(ws + WS_EID), (const bf16*)(ws + WS_WBUF), v8, qa, ctl + CW_PEER + 1024, tid_); break;
            default: peer_ln_pass(h2, qa, args.in.p[25], args.in.p[26], args.out, gw, NGW, tid_ & 63); break;
            }
        }
        if (gk >= 0) {
            const bf16* A; const bf16* Bt; int M = NTOK, N = D_MODEL, K = D_MODEL; pg8::EpiGen E{0, nullptr, D_MODEL, nullptr, nullptr, nullptr};
            switch (gk) {
            case 0: A = x_bf + (size_t)hf * MH * D_MODEL; Bt = w_in_t; M = MH; N = N1P; E.out = projb; E.ldc = N1P; E.side0 = (float*)(ws + WS_GLOW); E.side1 = (float*)(ws + WS_DTRAW); break;
            case 1: A = oy_all; Bt = w_out_t; K = D_MIX; E.mode = 1; E.out = h1; E.res = args.in.p[0]; break;
            case 2: A = h1; Bt = wq_t; E.out = qa; break;
            case 3: A = mem_bf; Bt = wk_t; M = BATCH * MEM_LEN; E.out = kc; break;
            case 4: A = mem_bf; Bt = wv_t; M = BATCH * MEM_LEN; E.out = vc; break;
            case 5: A = qa; Bt = wo_t; E.mode = 2; E.out = h2; E.res = h1; break;
            default: A = h2; Bt = pwq_t; E.out = qa; break;
            }
            pg8::Gemm g{(const pg8::bf16_t*)A, (const pg8::bf16_t*)Bt, M, N, K}; pg8::StaticOrder S; S.init(M, N, G, bx);
            pg8::gemm_phase<pg8::EpiGen, pg8::StaticOrder, true, true>(lds + RING_OFF, g, S, E);
        }
        GRID_BAR();
    }
}

extern "C" void kernel_launch(void* const* d_in, const int* in_sizes, int n_in, void* d_out, int out_size, void* d_ws, size_t ws_size, hipStream_t stream) {
    static int grid = 0;
    if (grid == 0) {
        int dev = 0, cus = 0, per_cu = 0;
        if (hipGetDevice(&dev) != hipSuccess || hipDeviceGetAttribute(&cus, hipDeviceAttributeMultiprocessorCount, dev) != hipSuccess) { fprintf(stderr, "kernel_launch: device query failed\n"); grid = -1; return; }
        if (hipFuncSetAttribute((const void*)mega, hipFuncAttributeMaxDynamicSharedMemorySize, LDS_BYTES) != hipSuccess) { fprintf(stderr, "kernel_launch: hipFuncSetAttribute failed\n"); grid = -1; return; }
        if (hipOccupancyMaxActiveBlocksPerMultiprocessor(&per_cu, (const void*)mega, NTHR, LDS_BYTES) != hipSuccess || per_cu < 1) fprintf(stderr, "kernel_launch: occupancy query says %d\n", per_cu);
        (void)hipGetLastError();
        if (ws_size < WS_END) { fprintf(stderr, "kernel_launch: workspace too small: ws %zu need %zu\n", ws_size, (size_t)WS_END); grid = -1; return; }
        grid = cus;
    }
    if (grid < 0) return;
    if (hipMemsetAsync((char*)d_ws + WS_CTL, 0, CTL_ZERO_BYTES, stream) != hipSuccess) { fprintf(stderr, "kernel_launch: memset failed\n"); return; }
    Args a{};
    for (int i = 0; i < 27; ++i) a.in.p[i] = (const float*)d_in[i];
    a.out = (float*)d_out; a.ws = (unsigned char*)d_ws;
    hipLaunchKernelGGL(mega, dim3(grid), dim3(NTHR), LDS_BYTES, stream, a);
}
```

```cpp
#include <hip/hip_runtime.h>
#include <cmath>
#include <cstdio>
#include <cstdint>
#define HD __device__ __forceinline__
namespace cfg {
#ifdef SMALL
constexpr int D_MODEL = 128, BATCH = 2, SEQ = 64, GLA_HEADS = 4, GLA_GATE_RANK = 4, SSD_HEADDIM = 16, SSD_GROUPS = 2, SSD_STATE = 16, SSD_CONV = 4,
              MEM_LEN = 16, MEM_HEADS = 2, PEER_HEADS = 2, PEER_N_KEYS = 16, PEER_KEY_DIM = 16, PEER_TOPK = 4;
#else
constexpr int D_MODEL = 1024, BATCH = 4, SEQ = 8192, GLA_HEADS = 4, GLA_GATE_RANK = 16, SSD_HEADDIM = 64, SSD_GROUPS = 2, SSD_STATE = 64, SSD_CONV = 4,
              MEM_LEN = 256, MEM_HEADS = 4, PEER_HEADS = 8, PEER_N_KEYS = 128, PEER_KEY_DIM = 128, PEER_TOPK = 16;
#endif
constexpr int D_MIX = 2 * D_MODEL, GLA_DV = D_MIX / 2, GLA_DK = GLA_DV / 2, GLA_HEAD_K = GLA_DK / GLA_HEADS, GLA_HEAD_V = GLA_DV / GLA_HEADS;
constexpr float GLA_GATE_TAU = 16.0f;
constexpr int SSD_DINNER = D_MIX - GLA_DV, SSD_HEADS = SSD_DINNER / SSD_HEADDIM, SSD_HPG = SSD_HEADS / SSD_GROUPS, SSD_CONV_DIM = SSD_DINNER + 2 * SSD_GROUPS * SSD_STATE;
constexpr int D_IN_PROJ = GLA_DK * 2 + GLA_DV * 2 + GLA_GATE_RANK + SSD_DINNER + SSD_CONV_DIM + SSD_HEADS;
constexpr int MEM_HEAD_DIM = D_MODEL / MEM_HEADS, PEER_EXPERTS = PEER_N_KEYS * PEER_N_KEYS, PEER_HALF = PEER_KEY_DIM / 2;
constexpr float ALPHA = 1.189207115002721f;
constexpr float LN_EPS = 1e-5f, RMS_EPS = 1e-6f;
constexpr int NTOK = BATCH * SEQ;
}
namespace pg8 {
#define PG8_LAS __attribute__((address_space(3)))
typedef unsigned short bf16_t;
typedef short bf16x8 __attribute__((ext_vector_type(8)));
typedef float f32x4 __attribute__((ext_vector_type(4)));
typedef unsigned u32x4 __attribute__((ext_vector_type(4)));
constexpr int BM = 256, BK = 64, HALF = 128, HTB = HALF * BK * 2  , STAGE_BYTES = 8 * HTB, NXCD = 8, WGM = 8;

__host__ __device__ __forceinline__ int lds_byte(int r, int c) { const int st = (r >> 4) * 2 + (c >> 5), rr = r & 15, cc = c & 31, ob = rr * 64 + cc * 2; return st * 1024 + (ob ^ (((ob >> 9) & 1) << 5)); }
__host__ __device__ __forceinline__ void stage_rc(int b, int& R, int& C) { const int st = b / 1024, sb = b % 1024, swz = sb ^ (((sb >> 9) & 1) << 5); R = (st >> 1) * 16 + swz / 64; C = (st & 1) * 32 + (swz % 64) / 2; }
__host__ __device__ __forceinline__ int perm32(int rho) { const int n = rho >> 4, i = rho & 15; return 8 * (i >> 2) + 4 * n + (i & 3); }

struct Unit { int pm, pn; };
struct Gemm { const bf16_t* A; const bf16_t* Bt; int M, N, K; };

struct StaticOrder {
    int nM, nN, nwg, G, c;
    __host__ __device__ void init(int M, int N, int G_, int c_) { nM = M / BM; nN = N / BM; nwg = nM * nN; G = G_; c = c_; }
    __host__ __device__ bool next(int i, Unit& u) const {
        const long L = (long)i * G + c; if (L >= nwg) return false;
        int wgid = (int)L; { const int q = nwg / NXCD, r = nwg % NXCD, xcd = wgid % NXCD, off = wgid / NXCD; wgid = (xcd < r ? xcd * (q + 1) : r * (q + 1) + (xcd - r) * q) + off; }
        const int nig = WGM * nN, gid = wgid / nig, fm = gid * WGM, gsz = (nM - fm) < WGM ? (nM - fm) : WGM;
        u.pm = fm + ((wgid % nig) % gsz); u.pn = (wgid % nig) / gsz; return true;
    }
    __device__ __forceinline__ void a_ready(const Unit&) const {}
    __device__ __forceinline__ void done(const Unit&) const {}
};

__device__ __forceinline__ unsigned cvt_pk_bf16(float lo, float hi) { unsigned r; asm volatile("v_cvt_pk_bf16_f32 %0, %1, %2" : "=v"(r) : "v"(lo), "v"(hi)); return r; }
typedef float f32x2 __attribute__((ext_vector_type(2)));
struct EpiF32 {
    static constexpr bool PERM = false, AFTER_DRAIN = false;
    float* C; int ldc; int ncols;
    __device__ __forceinline__ void operator()(const f32x4 (&acc)[2][2][4][2], const Unit& u, int wr, int wc, int fr, int fq) const {
        const int row0 = u.pm * BM + wr * 64 + fr, col0 = u.pn * BM + wc * 32 + 4 * fq;
#pragma unroll
        for (int ai = 0; ai < 2; ++ai)
#pragma unroll
            for (int m = 0; m < 4; ++m) { float* rowp = C + (size_t)(row0 + ai * HALF + m * 16) * ldc + col0;
#pragma unroll
                for (int bj = 0; bj < 2; ++bj)
#pragma unroll
                    for (int n = 0; n < 2; ++n) if (col0 + bj * HALF + n * 16 < ncols) *(f32x4*)(rowp + bj * HALF + n * 16) = acc[ai][bj][m][n]; }
    }
};
template <class Epi, class Sched, bool ALIGN_EPI = false, bool SP2 = false>
__device__ __forceinline__ void gemm_phase(PG8_LAS unsigned char* lds, const Gemm g, const Sched& S, const Epi& E) {
    int tid_o = threadIdx.x; asm volatile("" : "+v"(tid_o));
    const int tid = tid_o, wid = __builtin_amdgcn_readfirstlane(tid >> 6), lane = tid & 63, wr = wid >> 2, wc = wid & 3, fr = lane & 15, fq = lane >> 4;
    const int K = g.K, nt = K / BK;
    unsigned voffA[2], voffB[2];
#pragma unroll
    for (int i = 0; i < 2; ++i) { int R, C; stage_rc(tid * 16 + i * 8192, R, C); const int Rb = Epi::PERM ? ((R & ~31) + perm32(R & 31)) : R;
        voffA[i] = (unsigned)(R * K + C) * 2u; voffB[i] = (unsigned)(Rb * K + C) * 2u; }
    const size_t kstep = (size_t)(BK * 2);
    const size_t hstep = (size_t)HALF * K * 2;
    const size_t tstep = 2 * hstep;
    const unsigned ldsw = (unsigned)wid * 1024u;
    const int aoff = lds_byte(wr * 64 + fr, fq * 8), boff = lds_byte(wc * 32 + fr, fq * 8);
#define PG8_SA(b, h) (((b) * 2 + (h)) * HTB)
#define PG8_SB(b, h) ((4 + (b) * 2 + (h)) * HTB)
#define PG8_STAGE(bufoff, gbase, voff) do { _Pragma("unroll") for (int _i = 0; _i < 2; ++_i) \
        __builtin_amdgcn_global_load_lds((const unsigned*)((const char*)(gbase) + (voff)[_i]), (PG8_LAS unsigned*)(lds + (bufoff) + ldsw + _i * 8192), 16, 0, 0); } while (0)
#define PG8_LDA(dst, b, h) do { _Pragma("unroll") for (int m = 0; m < 4; ++m) _Pragma("unroll") for (int k = 0; k < 2; ++k) dst[m][k] = *(const PG8_LAS bf16x8*)(lds + PG8_SA(b, h) + aoff + m * 2048 + k * 1024); } while (0)
#define PG8_LDB(dst, b, h) do { _Pragma("unroll") for (int n = 0; n < 2; ++n) _Pragma("unroll") for (int k = 0; k < 2; ++k) dst[n][k] = *(const PG8_LAS bf16x8*)(lds + PG8_SB(b, h) + boff + n * 2048 + k * 1024); } while (0)
#define PG8_MMA(ai, bj, At, Bt) do { __builtin_amdgcn_s_setprio(1); _Pragma("unroll") for (int m = 0; m < 4; ++m) _Pragma("unroll") for (int n = 0; n < 2; ++n) _Pragma("unroll") for (int k = 0; k < 2; ++k) \
        acc[ai][bj][m][n] = __builtin_amdgcn_mfma_f32_16x16x32_bf16(Bt[n][k], At[m][k], acc[ai][bj][m][n], 0, 0, 0); __builtin_amdgcn_s_setprio(0); } while (0)
#define PG8_WAIT_V(n) asm volatile("s_waitcnt vmcnt(" #n ")" ::: "memory")
#define PG8_WAIT_L(n) asm volatile("s_waitcnt lgkmcnt(" #n ")" ::: "memory")
#define PG8_BAR __builtin_amdgcn_s_barrier()
#define PG8_SCHED __builtin_amdgcn_sched_barrier(0)
    Unit cur, nxt; int ui = 0;
    if (!S.next(0, cur)) return;
    f32x4 acc[2][2][4][2];
#pragma unroll
    for (int a = 0; a < 2; ++a)
#pragma unroll
        for (int b = 0; b < 2; ++b)
#pragma unroll
            for (int m = 0; m < 4; ++m)
#pragma unroll
                for (int n = 0; n < 2; ++n) acc[a][b][m][n] = (f32x4){0.f, 0.f, 0.f, 0.f};
    bf16x8 At[4][2], B0[2][2], B1[2][2];
    const char* cA = (const char*)g.A + (size_t)cur.pm * tstep; const char* cB = (const char*)g.Bt + (size_t)cur.pn * tstep;
    S.a_ready(cur);
    if constexpr (SP2) {
        PG8_STAGE(PG8_SB(0, 0), cB, voffB); PG8_STAGE(PG8_SB(0, 1), cB + hstep, voffB); PG8_STAGE(PG8_SA(0, 0), cA, voffA); PG8_STAGE(PG8_SA(0, 1), cA + hstep, voffA);
        if (wr == 1) PG8_BAR;
        PG8_WAIT_V(2); PG8_BAR;
        PG8_STAGE(PG8_SB(1, 0), cB + kstep, voffB); PG8_STAGE(PG8_SA(1, 0), cA + kstep, voffA); PG8_STAGE(PG8_SB(1, 1), cB + hstep + kstep, voffB);
        PG8_WAIT_V(6); PG8_BAR;
    } else {
        PG8_STAGE(PG8_SB(0, 0), cB, voffB); PG8_STAGE(PG8_SA(0, 0), cA, voffA); PG8_STAGE(PG8_SB(0, 1), cB + hstep, voffB); PG8_STAGE(PG8_SA(0, 1), cA + hstep, voffA);
        if (wr == 1) PG8_BAR;
        PG8_WAIT_V(4); PG8_BAR;
        PG8_STAGE(PG8_SB(1, 0), cB + kstep, voffB); PG8_STAGE(PG8_SA(1, 0), cA + kstep, voffA); PG8_STAGE(PG8_SB(1, 1), cB + hstep + kstep, voffB);
        PG8_WAIT_V(6); PG8_BAR;
    }
    for (;;) {
        const bool has_next = S.next(ui + 1, nxt);
        const char* nA = has_next ? (const char*)g.A + (size_t)nxt.pm * tstep : cA; const char* nB = has_next ? (const char*)g.Bt + (size_t)nxt.pn * tstep : cB;
        for (int t = 0; t < nt; t += 2) {
            const bool last = (t == nt - 2);
            const char* a1 = cA + (size_t)(t + 1) * kstep;
            const char* a2 = last ? nA : cA + (size_t)(t + 2) * kstep; const char* b2 = last ? nB : cB + (size_t)(t + 2) * kstep;
            const char* a3 = a2 + kstep; const char* b3 = b2 + kstep;
            if (last && has_next) S.a_ready(nxt);
            if constexpr (SP2) {
            PG8_LDB(B0, 0, 0); PG8_LDB(B1, 0, 1); PG8_SCHED; PG8_LDA(At, 0, 0); PG8_STAGE(PG8_SA(1, 1), a1 + hstep, voffA);
            PG8_WAIT_V(8); PG8_WAIT_L(0); PG8_BAR; PG8_MMA(0, 0, At, B0); PG8_MMA(0, 1, At, B1); PG8_BAR; PG8_SCHED;
            PG8_LDA(At, 0, 1); PG8_STAGE(PG8_SB(0, 0), b2, voffB); PG8_STAGE(PG8_SB(0, 1), b2 + hstep, voffB); PG8_STAGE(PG8_SA(0, 0), a2, voffA);
            PG8_WAIT_V(8); PG8_WAIT_L(0); PG8_BAR; PG8_MMA(1, 0, At, B0); PG8_MMA(1, 1, At, B1); PG8_BAR; PG8_SCHED;
            PG8_LDB(B0, 1, 0); PG8_LDB(B1, 1, 1); PG8_SCHED; PG8_LDA(At, 1, 0); PG8_STAGE(PG8_SA(0, 1), a2 + hstep, voffA);
            PG8_WAIT_V(8); PG8_WAIT_L(0); PG8_BAR; PG8_MMA(0, 0, At, B0); PG8_MMA(0, 1, At, B1); PG8_BAR; PG8_SCHED;
            PG8_LDA(At, 1, 1); PG8_STAGE(PG8_SB(1, 0), b3, voffB); PG8_STAGE(PG8_SB(1, 1), b3 + hstep, voffB); PG8_STAGE(PG8_SA(1, 0), a3, voffA);
            PG8_WAIT_V(8); PG8_WAIT_L(0); PG8_BAR; PG8_MMA(1, 0, At, B0); PG8_MMA(1, 1, At, B1); PG8_BAR; PG8_SCHED;
            } else {
            PG8_LDB(B0, 0, 0); PG8_SCHED; PG8_LDA(At, 0, 0); PG8_STAGE(PG8_SA(1, 1), a1 + hstep, voffA);
            PG8_WAIT_L(8); PG8_BAR; PG8_WAIT_L(0); PG8_MMA(0, 0, At, B0); PG8_BAR; PG8_SCHED;
            PG8_LDB(B1, 0, 1); PG8_STAGE(PG8_SB(0, 0), b2, voffB);
            PG8_BAR; PG8_WAIT_L(0); PG8_MMA(0, 1, At, B1); PG8_BAR;
            PG8_LDA(At, 0, 1); PG8_STAGE(PG8_SA(0, 0), a2, voffA);
            PG8_BAR; PG8_WAIT_L(0); PG8_MMA(1, 0, At, B0); PG8_BAR; PG8_SCHED;
            PG8_STAGE(PG8_SB(0, 1), b2 + hstep, voffB);
            PG8_WAIT_V(6); PG8_BAR; PG8_MMA(1, 1, At, B1); PG8_BAR;
            PG8_LDB(B0, 1, 0); PG8_SCHED; PG8_LDA(At, 1, 0); PG8_STAGE(PG8_SA(0, 1), a2 + hstep, voffA);
            PG8_WAIT_L(8); PG8_BAR; PG8_WAIT_L(0); PG8_MMA(0, 0, At, B0); PG8_BAR; PG8_SCHED;
            PG8_LDB(B1, 1, 1); PG8_STAGE(PG8_SB(1, 0), b3, voffB);
            PG8_BAR; PG8_WAIT_L(0); PG8_MMA(0, 1, At, B1); PG8_BAR;
            PG8_LDA(At, 1, 1); PG8_STAGE(PG8_SA(1, 0), a3, voffA);
            PG8_BAR; PG8_WAIT_L(0); PG8_MMA(1, 0, At, B0); PG8_BAR; PG8_SCHED;
            PG8_STAGE(PG8_SB(1, 1), b3 + hstep, voffB);
            PG8_WAIT_V(6); PG8_BAR; PG8_MMA(1, 1, At, B1); PG8_BAR;
            }
        }
        if constexpr (ALIGN_EPI) { if (wr == 0) PG8_BAR; }
        if constexpr (!Epi::AFTER_DRAIN) { E(acc, cur, wr, wc, fr, fq); S.done(cur); }
        if (!has_next) break;
#pragma unroll
        for (int a = 0; a < 2; ++a)
#pragma unroll
            for (int b = 0; b < 2; ++b)
#pragma unroll
                for (int m = 0; m < 4; ++m)
#pragma unroll
                    for (int n = 0; n < 2; ++n) acc[a][b][m][n] = (f32x4){0.f, 0.f, 0.f, 0.f};
        cur = nxt; cA = nA; cB = nB; ++ui;
        if constexpr (ALIGN_EPI) { if (wr == 1) PG8_BAR; }
    }
    PG8_WAIT_V(0);
    if constexpr (!ALIGN_EPI) { if (wr == 0) PG8_BAR; }
    PG8_BAR;
    if constexpr (Epi::AFTER_DRAIN) { E.fused(acc, cur, wr, wc, fr, fq, lds, wid, lane); S.done(cur); }
#undef PG8_SA
#undef PG8_SB
#undef PG8_STAGE
#undef PG8_LDA
#undef PG8_LDB
#undef PG8_MMA
#undef PG8_WAIT_V
#undef PG8_WAIT_L
#undef PG8_BAR
#undef PG8_SCHED
}
}
#define GAS __attribute__((address_space(1)))
#define LAS __attribute__((address_space(3)))
typedef unsigned short bf16;
typedef unsigned v4u __attribute__((ext_vector_type(4)));
typedef float f32x4 __attribute__((ext_vector_type(4)));
typedef short bf16x8 __attribute__((ext_vector_type(8)));
typedef GAS unsigned gu32;
typedef GAS unsigned long long gu64;
#define RLX_AGENT __ATOMIC_RELAXED, __HIP_MEMORY_SCOPE_AGENT
#define LDS_WAIT() asm volatile("s_waitcnt lgkmcnt(0)" ::: "memory")
#define VM_WAIT() asm volatile("s_waitcnt vmcnt(0)" ::: "memory")
__device__ __forceinline__ unsigned long long rt() { return __builtin_amdgcn_s_memrealtime(); }
__device__ __forceinline__ unsigned f2bf(float f) { unsigned u = __builtin_bit_cast(unsigned, f); return (u + 0x7fffu + ((u >> 16) & 1u)) >> 16; }
__device__ __forceinline__ unsigned pk2(float lo, float hi) { return f2bf(lo) | (f2bf(hi) << 16); }
#define XB_TMO      128
#define XB_XCNT(j)  (256  + 64 * (j))
#define XB_XSUB(j)  (1280 + 64 * (j))
#define XB_XGEN(j)  (2304 + 64 * (j))
#define XB_TOP      3328
#define XB_TOPGEN   3392
#define XCD_BAR_WORDS 3456
#define XB_SPIN_CAP (1u << 27)

__device__ __forceinline__ unsigned xb_ld(unsigned* p)              { return __hip_atomic_load(p, __ATOMIC_RELAXED, __HIP_MEMORY_SCOPE_AGENT); }
__device__ __forceinline__ unsigned xb_add(unsigned* p, unsigned v) { return __hip_atomic_fetch_add(p, v, __ATOMIC_RELAXED, __HIP_MEMORY_SCOPE_AGENT); }
__device__ __forceinline__ unsigned xb_xcc_id() { return (unsigned)__builtin_amdgcn_s_getreg((3 << 11) | 20) & 0xFu; }
#define XB_SPIN(cond, bar) do { unsigned _sp = 0; while (cond) { __builtin_amdgcn_s_sleep(1); \
    if ((++_sp & 255u) == 0u) { if (xb_ld(&(bar)[XB_TMO])) break; if (_sp > XB_SPIN_CAP) { atomicAdd(&(bar)[XB_TMO], 1u); break; } } } } while (0)

struct XcdBarrier {
    unsigned* bar; unsigned x;
    volatile LAS unsigned* st;
};

__device__ __forceinline__ XcdBarrier xcd_barrier_post(unsigned* bar, volatile LAS unsigned* st) {
    XcdBarrier b; b.bar = bar; b.x = xb_xcc_id(); b.st = st;
    if (threadIdx.x == 0) (void)xb_add(&bar[XB_XCNT(b.x)], 1u);
    return b;
}
__device__ __forceinline__ void xcd_barrier_complete(unsigned* bar, unsigned x, unsigned& nloc, unsigned& nx) {
    const unsigned G = gridDim.x * gridDim.y * gridDim.z;
    unsigned sum, cnt, mine, sp = 0u;
    for (;;) {
        sum = 0u; cnt = 0u; mine = 0u;
#pragma unroll
        for (unsigned j = 0; j < 16; ++j) { const unsigned c = xb_ld(&bar[XB_XCNT(j)]); sum += c; cnt += (c > 0u) ? 1u : 0u; mine = (j == x) ? c : mine; }
        if (sum == G) break;
        __builtin_amdgcn_s_sleep(1);
        if ((++sp & 255u) == 0u) { if (xb_ld(&bar[XB_TMO])) break; if (sp > XB_SPIN_CAP) { atomicAdd(&bar[XB_TMO], 1u); break; } }
    }
    nloc = mine > 0u ? mine : 1u; nx = cnt > 0u ? cnt : 1u;
}

__device__ __forceinline__ void xcd_barrier(const XcdBarrier& b) {
    asm volatile("s_waitcnt vmcnt(0)" ::: "memory");
    __syncthreads();
    if (threadIdx.x == 0) {
        unsigned* bar = b.bar;
        __builtin_amdgcn_s_waitcnt(0);
        unsigned nloc = b.st[0], nx = b.st[1];
        if (nloc == 0u) { xcd_barrier_complete(bar, b.x, nloc, nx); b.st[0] = nloc; b.st[1] = nx; }
        const unsigned old = xb_add(&bar[XB_XSUB(b.x)], 1u);
        const unsigned gen = old / nloc;
        if (old + 1u == (gen + 1u) * nloc) {
            __builtin_amdgcn_fence(__ATOMIC_RELEASE, "agent");
            asm volatile("s_waitcnt vmcnt(0)" ::: "memory");
            const unsigned og = xb_add(&bar[XB_TOP], 1u);
            const unsigned tg = og / nx;
            if (og + 1u == (tg + 1u) * nx) xb_add(&bar[XB_TOPGEN], 1u);
            else XB_SPIN(xb_ld(&bar[XB_TOPGEN]) == tg, bar);
            __builtin_amdgcn_fence(__ATOMIC_ACQUIRE, "agent");
            xb_add(&bar[XB_XGEN(b.x)], 1u);
            asm volatile("s_waitcnt vmcnt(0)" ::: "memory");
        } else {
            XB_SPIN(xb_ld(&bar[XB_XGEN(b.x)]) == gen, bar);
            __builtin_amdgcn_fence(__ATOMIC_ACQUIRE, "agent");
            asm volatile("s_waitcnt vmcnt(0)" ::: "memory");
        }
    }
    __syncthreads();
}
typedef float f32x16 __attribute__((ext_vector_type(16)));
typedef short s16x4 __attribute__((ext_vector_type(4)));
typedef short v4i16_t __attribute__((ext_vector_type(4)));
typedef __bf16 bf2_t __attribute__((ext_vector_type(2)));
typedef float f32x2_t __attribute__((ext_vector_type(2)));
typedef unsigned u32x2 __attribute__((ext_vector_type(2)));
typedef unsigned u32x4 __attribute__((ext_vector_type(4)));
#define DI __device__ __forceinline__
constexpr int NWAVES = 8, NTHR = 512;
DI unsigned cvt2(float a, float b) { f32x2_t v = {a, b}; return __builtin_bit_cast(unsigned, __builtin_convertvector(v, bf2_t)); }
DI float bf_lo(unsigned u) { return __uint_as_float(u << 16); }
DI float bf_hi(unsigned u) { return __uint_as_float(u & 0xffff0000u); }
DI s16x4 tr_read(const LAS unsigned char* p) { return __builtin_bit_cast(s16x4, __builtin_amdgcn_ds_read_tr16_b64_v4i16((LAS v4i16_t*)p)); }
DI bf16x8 cat8(s16x4 a, s16x4 b) { bf16x8 r; r[0] = a[0]; r[1] = a[1]; r[2] = a[2]; r[3] = a[3]; r[4] = b[0]; r[5] = b[1]; r[6] = b[2]; r[7] = b[3]; return r; }
DI float wave_sum(float v) {
#pragma unroll
    for (int o = 1; o < 64; o <<= 1) v += __shfl_xor(v, o);
    return v;
}
#define MFMA32(a, b, c) __builtin_amdgcn_mfma_f32_32x32x16_bf16((a), (b), (c), 0, 0, 0)
#define WG_SYNC() __syncthreads()

namespace pg8 {
struct EpiGen {
    static constexpr bool PERM = true, AFTER_DRAIN = false;
    int mode; bf16_t* out; int ldc; const void* res; float* side0; float* side1;
    __device__ __forceinline__ void operator()(const f32x4 (&acc)[2][2][4][2], const Unit& u, int wr, int wc, int fr, int fq) const {
        const int row0 = u.pm * BM + wr * 64 + fr, col0 = u.pn * BM + wc * 32 + 8 * fq; const float alpha = cfg::ALPHA;
#pragma unroll
        for (int ai = 0; ai < 2; ++ai)
#pragma unroll
            for (int m = 0; m < 4; ++m) { const size_t row = (size_t)(row0 + ai * HALF + m * 16);
#pragma unroll
                for (int bj = 0; bj < 2; ++bj) { const int col = col0 + bj * HALF; f32x4 v0 = acc[ai][bj][m][0], v1 = acc[ai][bj][m][1];
                    if (mode == 1) { const float* r = (const float*)res + row * 1024 + col; const f32x4 r0 = *(const f32x4*)r, r1 = *(const f32x4*)(r + 4); v0 += alpha * r0; v1 += alpha * r1; }
                    else if (mode == 2) { const u32x4 r = *(const u32x4*)((const bf16_t*)res + row * 1024 + col);
                        v0[0] += alpha * bf_lo(r.x); v0[1] += alpha * bf_hi(r.x); v0[2] += alpha * bf_lo(r.y); v0[3] += alpha * bf_hi(r.y);
                        v1[0] += alpha * bf_lo(r.z); v1[1] += alpha * bf_hi(r.z); v1[2] += alpha * bf_lo(r.w); v1[3] += alpha * bf_hi(r.w); }
                    u32x4 w; w.x = cvt2(v0[0], v0[1]); w.y = cvt2(v0[2], v0[3]); w.z = cvt2(v1[0], v1[1]); w.w = cvt2(v1[2], v1[3]);
                    *(u32x4*)(out + row * ldc + col) = w;
                    if (side0 && bj == 0) { if (col == 3072 || col == 3080) { float* p = side0 + row * 16 + (col - 3072); *(f32x4*)p = v0; *(f32x4*)(p + 4) = v1; }
                                            if (col == 5392 || col == 5400) { float* p = side1 + row * 16 + (col - 5392); *(f32x4*)p = v0; *(f32x4*)(p + 4) = v1; } } }
                asm volatile("" ::: "memory"); }
    }
};
}

DI void ln_rows_bf16(bf16* buf, const float* g, const float* bt, int rows, int gw, int NGW, int lane) {
    for (int r = gw; r < rows; r += NGW) {
        bf16* p = buf + (size_t)r * 1024 + lane * 8;
        const u32x4 a = *(const u32x4*)p, b = *(const u32x4*)(p + 512);
        float v[16] = {bf_lo(a.x), bf_hi(a.x), bf_lo(a.y), bf_hi(a.y), bf_lo(a.z), bf_hi(a.z), bf_lo(a.w), bf_hi(a.w), bf_lo(b.x), bf_hi(b.x), bf_lo(b.y), bf_hi(b.y), bf_lo(b.z), bf_hi(b.z), bf_lo(b.w), bf_hi(b.w)};
        float s = 0.f;
#pragma unroll
        for (int i = 0; i < 16; ++i) s += v[i];
        const float mean = wave_sum(s) * (1.f / 1024.f); float q = 0.f;
#pragma unroll
        for (int i = 0; i < 16; ++i) { v[i] -= mean; q += v[i] * v[i]; }
        const float rstd = 1.0f / sqrtf(wave_sum(q) * (1.f / 1024.f) + cfg::LN_EPS);
        const f32x4 g0 = *(const f32x4*)(g + lane * 8), g1 = *(const f32x4*)(g + lane * 8 + 4), g2 = *(const f32x4*)(g + 512 + lane * 8), g3 = *(const f32x4*)(g + 512 + lane * 8 + 4);
        const f32x4 b0 = *(const f32x4*)(bt + lane * 8), b1 = *(const f32x4*)(bt + lane * 8 + 4), b2 = *(const f32x4*)(bt + 512 + lane * 8), b3 = *(const f32x4*)(bt + 512 + lane * 8 + 4);
        u32x4 oa, ob;
        oa.x = cvt2(v[0] * rstd * g0[0] + b0[0], v[1] * rstd * g0[1] + b0[1]); oa.y = cvt2(v[2] * rstd * g0[2] + b0[2], v[3] * rstd * g0[3] + b0[3]);
        oa.z = cvt2(v[4] * rstd * g1[0] + b1[0], v[5] * rstd * g1[1] + b1[1]); oa.w = cvt2(v[6] * rstd * g1[2] + b1[2], v[7] * rstd * g1[3] + b1[3]);
        ob.x = cvt2(v[8] * rstd * g2[0] + b2[0], v[9] * rstd * g2[1] + b2[1]); ob.y = cvt2(v[10] * rstd * g2[2] + b2[2], v[11] * rstd * g2[3] + b2[3]);
        ob.z = cvt2(v[12] * rstd * g3[0] + b3[0], v[13] * rstd * g3[1] + b3[1]); ob.w = cvt2(v[14] * rstd * g3[2] + b3[2], v[15] * rstd * g3[3] + b3[3]);
        *(u32x4*)p = oa; *(u32x4*)(p + 512) = ob;
    }
}

constexpr int ATT_KP = 528, ATT_VP = 576;
DI void attn_phase(LAS unsigned char* lds, bf16* QO, const bf16* Kc, const bf16* Vc, int G, int bx, int tid) {
    using namespace cfg;
    const int wave = tid >> 6;
    constexpr int NU = (NTOK / 256) * MEM_HEADS;
    for (int u = bx; u < NU; u += G) {
        int lane = tid & 63; asm volatile("" : "+v"(lane));
        const int q = lane & 31, h = lane >> 5;
        const int bh = u / (SEQ / 256), qb = u % (SEQ / 256), b = bh / MEM_HEADS, hd = bh % MEM_HEADS;
        const bf16* Kg = Kc + (size_t)(b * MEM_LEN) * D_MODEL + hd * MEM_HEAD_DIM;
        const bf16* Vg = Vc + (size_t)(b * MEM_LEN) * D_MODEL + hd * MEM_HEAD_DIM;
        bf16* Qg = QO + ((size_t)b * SEQ + (size_t)qb * 256 + wave * 32 + q) * D_MODEL + hd * MEM_HEAD_DIM;
        WG_SYNC();
#pragma unroll 4
        for (int p = 0; p < 16; ++p) { const int key = p * 16 + (tid >> 5), ch = tid & 31;
            const u32x4 v = *(const u32x4*)(Kg + (size_t)key * D_MODEL + ch * 8); *(LAS u32x4*)(lds + key * ATT_KP + ch * 16) = v; }
        bf16x8 qf[16];
#pragma unroll
        for (int s = 0; s < 16; ++s) qf[s] = *(const bf16x8*)(Qg + 16 * s + 8 * h);
        WG_SYNC();
        f32x16 sc[8];
#pragma unroll
        for (int kt = 0; kt < 8; ++kt) {
#pragma unroll
            for (int i = 0; i < 16; ++i) sc[kt][i] = 0.f;
#pragma unroll
            for (int s = 0; s < 16; ++s) { const bf16x8 kf = *(const LAS bf16x8*)(lds + (kt * 32 + q) * ATT_KP + (16 * s + 8 * h) * 2); sc[kt] = MFMA32(kf, qf[s], sc[kt]); }
        }
        float m = sc[0][0];
#pragma unroll
        for (int kt = 0; kt < 8; ++kt)
#pragma unroll
            for (int i = 0; i < 16; ++i) m = fmaxf(m, sc[kt][i]);
        m = fmaxf(m, __shfl_xor(m, 32));
        const float c = 0.0625f * 1.44269504088896f; float l = 0.f; const float mc = m * c;
        bf16x8 pf[8][2];
#pragma unroll
        for (int kt = 0; kt < 8; ++kt) {
            float e[16];
#pragma unroll
            for (int i = 0; i < 16; ++i) { e[i] = __builtin_amdgcn_exp2f(sc[kt][i] * c - mc); l += e[i]; }
#pragma unroll
            for (int s = 0; s < 2; ++s) { u32x4 w; w.x = cvt2(e[8 * s], e[8 * s + 1]); w.y = cvt2(e[8 * s + 2], e[8 * s + 3]); w.z = cvt2(e[8 * s + 4], e[8 * s + 5]); w.w = cvt2(e[8 * s + 6], e[8 * s + 7]); pf[kt][s] = __builtin_bit_cast(bf16x8, w); }
        }
        l += __shfl_xor(l, 32);
        const float inv = 1.0f / l;
        WG_SYNC();
#pragma unroll 4
        for (int p = 0; p < 16; ++p) { const int key = p * 16 + (tid >> 5), ch = tid & 31;
            const u32x4 v = *(const u32x4*)(Vg + (size_t)key * D_MODEL + ch * 8); *(LAS u32x4*)(lds + key * ATT_VP + ch * 16) = v; }
        WG_SYNC();
        const int gi = (lane >> 4) & 1, i16 = lane & 15;
        const LAS unsigned char* vb = lds + (4 * h + (i16 >> 2)) * ATT_VP + (16 * gi + 4 * (i16 & 3)) * 2;
#pragma unroll
        for (int et = 0; et < 8; ++et) {
            f32x16 o;
#pragma unroll
            for (int i = 0; i < 16; ++i) o[i] = 0.f;
#pragma unroll
            for (int kt = 0; kt < 8; ++kt)
#pragma unroll
                for (int s = 0; s < 2; ++s) { const LAS unsigned char* a = vb + (kt * 32 + 16 * s) * ATT_VP + et * 64;
                    const bf16x8 vf = cat8(tr_read(a), tr_read(a + 8 * ATT_VP)); o = MFMA32(vf, pf[kt][s], o); }
#pragma unroll
            for (int r4 = 0; r4 < 4; ++r4) { u32x2 w; w.x = cvt2(o[4 * r4] * inv, o[4 * r4 + 1] * inv); w.y = cvt2(o[4 * r4 + 2] * inv, o[4 * r4 + 3] * inv);
                *(u32x2*)(Qg + et * 32 + 8 * r4 + 4 * h) = w; }
        }
    }
    WG_SYNC();
}

DI int f2key(float s) { int k = __float_as_int(s); return k ^ ((k >> 31) & 0x7fffffff); }
DI float key2f(int k) { return __int_as_float(k ^ ((k >> 31) & 0x7fffffff)); }
#define CE_DESC(a, b) do { const int _hi = max((a), (b)), _lo = min((a), (b)); (a) = _hi; (b) = _lo; } while (0)
DI void sort16_desc(int (&t)[16]) {
#pragma unroll
    for (int k = 2; k <= 16; k <<= 1)
#pragma unroll
        for (int j = k >> 1; j > 0; j >>= 1)
#pragma unroll
            for (int i = 0; i < 16; ++i) { const int l = i ^ j; if (l > i) { if ((i & k) == 0) CE_DESC(t[i], t[l]); else CE_DESC(t[l], t[i]); } }
}
DI void merge16_desc(int (&a)[16], const int (&b)[16]) {
#pragma unroll
    for (int i = 0; i < 16; ++i) a[i] = max(a[i], b[15 - i]);
#pragma unroll
    for (int j = 8; j > 0; j >>= 1)
#pragma unroll
        for (int i = 0; i < 16; ++i) { const int l = i ^ j; if (l > i) CE_DESC(a[i], a[l]); }
}
constexpr int TK_KP = 144;
DI void topk_phase(LAS unsigned char* lds, const bf16* PQ, const float* keys, unsigned* picks, bf16* eid16, int G, int bx, int tid) {
    using namespace cfg;
    const int lane = tid & 63, wave = tid >> 6, q = lane & 31, h = lane >> 5;
    for (int i = tid; i < 2 * PEER_N_KEYS * PEER_HALF / 2; i += NTHR) { const int row = i / (PEER_HALF / 2), c2 = i % (PEER_HALF / 2);
        const float a = keys[row * PEER_HALF + 2 * c2], b = keys[row * PEER_HALF + 2 * c2 + 1]; *(LAS unsigned*)(lds + row * TK_KP + c2 * 4) = cvt2(a, b); }
    LAS unsigned* lut = (LAS unsigned*)(lds + 40960) + (wave * 64 + lane) * 33;
    WG_SYNC();
    constexpr int NTASK = (NTOK / 32) * PEER_HEADS;
    for (int task = bx * NWAVES + wave; task < NTASK; task += G * NWAVES) {
        const int tb = task / PEER_HEADS, hd = task % PEER_HEADS;
        const bf16* qg = PQ + (size_t)(tb * 32 + q) * D_MODEL + hd * PEER_KEY_DIM;
        int top[2][16];
#pragma unroll
        for (int p = 0; p < 2; ++p) {
            bf16x8 qf[4];
#pragma unroll
            for (int s = 0; s < 4; ++s) qf[s] = *(const bf16x8*)(qg + p * PEER_HALF + 16 * s + 8 * h);
            int grp[4][16];
#pragma unroll
            for (int kt = 0; kt < 4; ++kt) {
                f32x16 sc;
#pragma unroll
                for (int i = 0; i < 16; ++i) sc[i] = 0.f;
#pragma unroll
                for (int s = 0; s < 4; ++s) { const bf16x8 kf = *(const LAS bf16x8*)(lds + (p * PEER_N_KEYS + kt * 32 + q) * TK_KP + (16 * s + 8 * h) * 2); sc = MFMA32(kf, qf[s], sc); }
#pragma unroll
                for (int i = 0; i < 16; ++i) { const int idx = kt * 32 + (i & 3) + 8 * (i >> 2) + 4 * h; grp[kt][i] = (f2key(sc[i]) & ~127) | (127 - idx); }
                sort16_desc(grp[kt]);
            }
            merge16_desc(grp[0], grp[1]); merge16_desc(grp[2], grp[3]); merge16_desc(grp[0], grp[2]);
            int other[16];
#pragma unroll
            for (int i = 0; i < 16; ++i) other[i] = __shfl_xor(grp[0][i], 32);
            merge16_desc(grp[0], other);
#pragma unroll
            for (int i = 0; i < 16; ++i) top[p][i] = grp[0][i];
        }
        float s1[16], s2[16];
#pragma unroll
        for (int i = 0; i < 16; ++i) { s1[i] = key2f(top[0][i] & ~127); s2[i] = key2f(top[1][i] & ~127); lut[i] = 127 - (top[0][i] & 127); lut[16 + i] = 127 - (top[1][i] & 127); }
        int L[16];
#pragma unroll
        for (int j = 0; j < 16; ++j) L[j] = (f2key(s1[0] + s2[j]) & ~255) | (255 - j);
#pragma unroll
        for (int i = 1; i < 16; ++i)
#pragma unroll
            for (int j = 0; j < 16; ++j) if ((i + 1) * (j + 1) <= 16) {
                int x = (f2key(s1[i] + s2[j]) & ~255) | (255 - (16 * i + j));
#pragma unroll
                for (int pz = (i + 1) * (j + 1) - 1; pz < 16; ++pz) CE_DESC(L[pz], x);
            }
        const float best0 = key2f(L[0] & ~255); float ge[16], gs = 0.f;
#pragma unroll
        for (int n = 0; n < 16; ++n) { ge[n] = __expf(key2f(L[n] & ~255) - best0); gs += ge[n]; }
        const float ginv = 1.0f / gs;
        asm volatile("s_waitcnt lgkmcnt(0)" ::: "memory");
        unsigned* pk = picks + ((size_t)(tb * 32 + q) * PEER_HEADS + hd) * 16 + 8 * h;
        unsigned wv[16];
#pragma unroll
        for (int n = 0; n < 16; ++n) { const int c = 255 - (L[n] & 255); const unsigned e = lut[c >> 4] * PEER_N_KEYS + lut[16 + (c & 15)];
            wv[n] = (e << 16) | (cvt2(ge[n] * ginv, 0.f) & 0xffffu); }
        u32x4 o0, o1;
        o0.x = h ? wv[8] : wv[0]; o0.y = h ? wv[9] : wv[1]; o0.z = h ? wv[10] : wv[2]; o0.w = h ? wv[11] : wv[3];
        o1.x = h ? wv[12] : wv[4]; o1.y = h ? wv[13] : wv[5]; o1.z = h ? wv[14] : wv[6]; o1.w = h ? wv[15] : wv[7];
        *(u32x4*)pk = o0; *(u32x4*)(pk + 4) = o1;
        u32x4 e16; e16.x = (o0.x >> 16) | (o0.y & 0xffff0000u); e16.y = (o0.z >> 16) | (o0.w & 0xffff0000u); e16.z = (o1.x >> 16) | (o1.y & 0xffff0000u); e16.w = (o1.z >> 16) | (o1.w & 0xffff0000u);
        *(u32x4*)(eid16 + ((size_t)(tb * 32 + q) * PEER_HEADS + hd) * 16 + 8 * h) = e16;
    }
    WG_SYNC();
}

DI float gelu_erf(float v) {
    const float av = fabsf(v), t = __builtin_amdgcn_rcpf(av * 0.2316418882f + 1.0f);
    float qv = t * 0.5307027145f - 0.7265760135f; qv = qv * t + 0.7107068705f; qv = qv * t - 0.142248368f; qv = qv * t + 0.127414796f; qv = qv * t;
    const float e = __builtin_amdgcn_exp2f(v * v * -0.72134752044f), mm = v * (qv * e);
    return v < 0.f ? mm : v - mm;
}
typedef __bf16 bf8_t __attribute__((ext_vector_type(8)));
DI float dot8(const u32x4 a, const u32x4 b, float acc) {
    const bf8_t a8 = __builtin_bit_cast(bf8_t, a), b8 = __builtin_bit_cast(bf8_t, b);
    acc = __builtin_amdgcn_fdot2_f32_bf16(a8.s01, b8.s01, acc, false);
    acc = __builtin_amdgcn_fdot2_f32_bf16(a8.s23, b8.s23, acc, false);
    acc = __builtin_amdgcn_fdot2_f32_bf16(a8.s45, b8.s45, acc, false);
    acc = __builtin_amdgcn_fdot2_f32_bf16(a8.s67, b8.s67, acc, false);
    return acc;
}
DI void axpy8(float (&o)[8], float w, const u32x4 v) {
    o[0] += w * bf_lo(v.x); o[1] += w * bf_hi(v.x); o[2] += w * bf_lo(v.y); o[3] += w * bf_hi(v.y); o[4] += w * bf_lo(v.z); o[5] += w * bf_hi(v.z); o[6] += w * bf_lo(v.w); o[7] += w * bf_hi(v.w);
}
template <int XM> DI float swz_xor(float v) { return __int_as_float(__builtin_amdgcn_ds_swizzle(__float_as_int(v), (XM << 10) | 0x1f)); }
template <int D> DI void treduce_stage(float (&p)[16], int lane) {
    const bool up = (lane & D) != 0;
#pragma unroll
    for (int k = 0; k < D; ++k) { const float keep = up ? p[k + D] : p[k], send = up ? p[k] : p[k + D]; p[k] = keep + swz_xor<D>(send); }
}
DI float treduce16(float (&p)[16], int lane) {
    treduce_stage<8>(p, lane); treduce_stage<4>(p, lane); treduce_stage<2>(p, lane); treduce_stage<1>(p, lane);
    float r = p[0]; r += swz_xor<16>(r); r += __shfl_xor(r, 32); return r;
}
DI u32x4 bload(__amdgpu_buffer_rsrc_t r, int voff, int soff) { return __builtin_bit_cast(u32x4, __builtin_amdgcn_raw_buffer_load_b128(r, voff, soff, 0)); }
DI void cvt_fp8_rows(const float* src, unsigned char* dst, float* scales, int rows, int gw, int NGW, int lane) {
    for (int r = gw; r < rows; r += NGW) {
        const float* p = src + (size_t)r * 1024 + lane * 16;
        const f32x4 a = *(const f32x4*)p, b = *(const f32x4*)(p + 4), c = *(const f32x4*)(p + 8), d = *(const f32x4*)(p + 12);
        float m = fmaxf(fmaxf(fmaxf(fabsf(a[0]), fabsf(a[1])), fmaxf(fabsf(a[2]), fabsf(a[3]))), fmaxf(fmaxf(fabsf(b[0]), fabsf(b[1])), fmaxf(fabsf(b[2]), fabsf(b[3]))));
        m = fmaxf(m, fmaxf(fmaxf(fmaxf(fabsf(c[0]), fabsf(c[1])), fmaxf(fabsf(c[2]), fabsf(c[3]))), fmaxf(fmaxf(fabsf(d[0]), fabsf(d[1])), fmaxf(fabsf(d[2]), fabsf(d[3])))));
#pragma unroll
        for (int o = 1; o < 64; o <<= 1) m = fmaxf(m, __shfl_xor(m, o));
        const float sc = m > 0.f ? m * (1.0f / 448.0f) : 1.0f, inv = 1.0f / sc;
        u32x4 o;
        o.x = (unsigned)__builtin_amdgcn_cvt_pk_fp8_f32(a[2] * inv, a[3] * inv, __builtin_amdgcn_cvt_pk_fp8_f32(a[0] * inv, a[1] * inv, 0, false), true);
        o.y = (unsigned)__builtin_amdgcn_cvt_pk_fp8_f32(b[2] * inv, b[3] * inv, __builtin_amdgcn_cvt_pk_fp8_f32(b[0] * inv, b[1] * inv, 0, false), true);
        o.z = (unsigned)__builtin_amdgcn_cvt_pk_fp8_f32(c[2] * inv, c[3] * inv, __builtin_amdgcn_cvt_pk_fp8_f32(c[0] * inv, c[1] * inv, 0, false), true);
        o.w = (unsigned)__builtin_amdgcn_cvt_pk_fp8_f32(d[2] * inv, d[3] * inv, __builtin_amdgcn_cvt_pk_fp8_f32(d[0] * inv, d[1] * inv, 0, false), true);
        *(u32x4*)(dst + (size_t)(lane >> 3) * (2u << 20) + (size_t)r * 128 + (lane & 7) * 16) = o;
        if (lane == 0) scales[r] = sc;
    }
}
DI void unpack_fp8x16(const u32x4 v, float (&f)[16]) {
    const f32x2_t a0 = __builtin_amdgcn_cvt_pk_f32_fp8((int)v.x, false), a1 = __builtin_amdgcn_cvt_pk_f32_fp8((int)v.x, true), b0 = __builtin_amdgcn_cvt_pk_f32_fp8((int)v.y, false), b1 = __builtin_amdgcn_cvt_pk_f32_fp8((int)v.y, true);
    const f32x2_t c0 = __builtin_amdgcn_cvt_pk_f32_fp8((int)v.z, false), c1 = __builtin_amdgcn_cvt_pk_f32_fp8((int)v.z, true), d0 = __builtin_amdgcn_cvt_pk_f32_fp8((int)v.w, false), d1 = __builtin_amdgcn_cvt_pk_f32_fp8((int)v.w, true);
    f[0] = a0.x; f[1] = a0.y; f[2] = a1.x; f[3] = a1.y; f[4] = b0.x; f[5] = b0.y; f[6] = b1.x; f[7] = b1.y; f[8] = c0.x; f[9] = c0.y; f[10] = c1.x; f[11] = c1.y; f[12] = d0.x; f[13] = d0.y; f[14] = d1.x; f[15] = d1.y;
}

constexpr int PEER_BLK = 128, PEER_NBLK = cfg::NTOK / PEER_BLK;
DI bool peer_next_item(volatile LAS unsigned* slot, gu32* cnt, int tid, int& s, int& blk) {
    if (tid == 0) { const int myx = (int)(xb_xcc_id() & 7u); int found = -1; unsigned tk = 0u;
        for (int a = 0; a < 8 && found < 0; ++a) { const int ss = (myx + a) & 7; const unsigned t = __hip_atomic_fetch_add(cnt + ss * 64, 1u, __ATOMIC_RELAXED, __HIP_MEMORY_SCOPE_AGENT); if (t < (unsigned)PEER_NBLK) { found = ss; tk = t; } }
        slot[0] = (unsigned)found; slot[1] = tk; }
    __syncthreads();
    s = __builtin_amdgcn_readfirstlane((int)slot[0]); blk = __builtin_amdgcn_readfirstlane((int)slot[1]);
    __syncthreads();
    return s >= 0;
}
template <int LB> DI float xor_lane(float v) { if constexpr (LB < 32) return __int_as_float(__builtin_amdgcn_ds_swizzle(__float_as_int(v), (LB << 10) | 0x1f)); else return __shfl_xor(v, 32); }
template <int AH, int LB> DI void halve_stage(float (&p)[16], int lane) {
    const bool up = (lane & LB) != 0;
#pragma unroll
    for (int k = 0; k < AH; ++k) { const float keep = up ? p[k + AH] : p[k], send = up ? p[k] : p[k + AH]; p[k] = keep + xor_lane<LB>(send); }
}
DI int peer_voff(const u32x4 (&pk)[2], int i, int sub) { const unsigned p = pk[i >> 3][(i >> 1) & 3]; const unsigned e = (i & 1) ? (p >> 16) : (p & 0xffffu); return (int)(e * 128u) + sub * 16; }
DI void peer_load_pk(u32x4 (&pk)[2], const bf16* arr16, int t, int grp) {
    pk[0] = *(const u32x4*)(arr16 + (size_t)t * 128 + grp * 16); pk[1] = *(const u32x4*)(arr16 + (size_t)t * 128 + grp * 16 + 8);
}
typedef int i32x4_t __attribute__((ext_vector_type(4)));
DI i32x4_t peer_rsrc(const void* base, unsigned bytes) {
    const unsigned long long a = (unsigned long long)base; i32x4_t r;
    r.x = __builtin_amdgcn_readfirstlane((int)(unsigned)a); r.y = __builtin_amdgcn_readfirstlane((int)((unsigned)(a >> 32) & 0xffffu)); r.z = __builtin_amdgcn_readfirstlane((int)bytes); r.w = __builtin_amdgcn_readfirstlane(0x00020000);
    return r;
}
#define PEER_ROW_ISSUE(dst, voff, rs) dst = bload(__builtin_amdgcn_make_buffer_rsrc((void*)(((unsigned long long)(unsigned)rs.x) | ((unsigned long long)(unsigned)rs.y << 32)), 0, 2 << 20, 0x00020000), voff, 0)
#define PEER_ROW_ISSUE_FIRST(dst, voff, rs) PEER_ROW_ISSUE(dst, voff, rs)
#define PEER_G_ISSUE(dst, ptr) dst = *(const u32x4*)(ptr)
template <int N> DI void peer_wait(u32x4& r) { }
template <int N> DI void peer_wait2(u32x4& a, u32x4& b, u32x4& c, u32x4& d) { }
template <int IT> DI void peer_u_token(u32x4 (&r)[16], u32x4 (&eNext)[2], u32x4 (&eLoad)[2], u32x4 (&xCur)[2], u32x4 (&xLoad)[2], const i32x4_t rs, const bf16* eid16, const bf16* xbase, float* abase, int t0, int grp, int sub, int lane) {
    constexpr int NTOP = IT <= 13 ? 4 : IT == 14 ? 2 : 0;
    constexpr int NW = IT <= 14 ? 15 + NTOP : 0;
    if constexpr (IT <= 13) { const bf16* ep = eid16 + (size_t)(t0 + IT + 2) * 128 + grp * 16; PEER_G_ISSUE(eLoad[0], ep); PEER_G_ISSUE(eLoad[1], ep + 8); }
    if constexpr (IT <= 14) { const bf16* xp = xbase + (size_t)(t0 + IT + 1) * cfg::D_MODEL; PEER_G_ISSUE(xLoad[0], xp); PEER_G_ISSUE(xLoad[1], xp + 8); }
    f32x2_t xs[8]; float part[16];
    { const u32x4 xa = xCur[0], xb = xCur[1];
      xs[0] = (f32x2_t){bf_lo(xa.x), bf_hi(xa.x)}; xs[1] = (f32x2_t){bf_lo(xa.y), bf_hi(xa.y)}; xs[2] = (f32x2_t){bf_lo(xa.z), bf_hi(xa.z)}; xs[3] = (f32x2_t){bf_lo(xa.w), bf_hi(xa.w)};
      xs[4] = (f32x2_t){bf_lo(xb.x), bf_hi(xb.x)}; xs[5] = (f32x2_t){bf_lo(xb.y), bf_hi(xb.y)}; xs[6] = (f32x2_t){bf_lo(xb.z), bf_hi(xb.z)}; xs[7] = (f32x2_t){bf_lo(xb.w), bf_hi(xb.w)}; }
#pragma unroll
    for (int i = 0; i < 16; ++i) {
        const u32x4 v = r[i];
        if constexpr (IT <= 14) { const int vo = peer_voff(eNext, i, sub); PEER_ROW_ISSUE(r[i], vo, rs); }
        f32x2_t a = __builtin_amdgcn_cvt_pk_f32_fp8((int)v.x, false) * xs[0], b = __builtin_amdgcn_cvt_pk_f32_fp8((int)v.x, true) * xs[1];
        a += __builtin_amdgcn_cvt_pk_f32_fp8((int)v.y, false) * xs[2]; b += __builtin_amdgcn_cvt_pk_f32_fp8((int)v.y, true) * xs[3];
        a += __builtin_amdgcn_cvt_pk_f32_fp8((int)v.z, false) * xs[4]; b += __builtin_amdgcn_cvt_pk_f32_fp8((int)v.z, true) * xs[5];
        a += __builtin_amdgcn_cvt_pk_f32_fp8((int)v.w, false) * xs[6]; b += __builtin_amdgcn_cvt_pk_f32_fp8((int)v.w, true) * xs[7];
        a += b; part[i] = a.x + a.y;
    }
    halve_stage<8, 4>(part, lane); halve_stage<4, 2>(part, lane); halve_stage<2, 1>(part, lane);
    *(f32x2_t*)(abase + (size_t)(t0 + IT) * 128) = (f32x2_t){part[0], part[1]};
}
DI void peer_u_phase(volatile LAS unsigned* slot, const bf16* H2, const bf16* eid16, const unsigned char* U8S, float* actp, gu32* cnt, int tid) {
    using namespace cfg;
    const int wave = tid >> 6;
    int s, blk;
    while (peer_next_item(slot, cnt, tid, s, blk)) {
        int lane = tid & 63; asm volatile("" : "+v"(lane));
        const int grp = lane >> 3, sub = lane & 7;
        const i32x4_t rs = peer_rsrc(U8S + (size_t)s * (2u << 20), 2u << 20);
        const int t0 = blk * PEER_BLK + wave * 16;
        const bf16* xbase = H2 + (size_t)s * 128 + sub * 16;
        float* abase = actp + ((size_t)s * NTOK) * 128 + grp * 16 + 2 * sub;
        u32x4 eA[2], eB[2], xA[2], xB[2], r[16];
        { const bf16* ep = eid16 + (size_t)t0 * 128 + grp * 16; PEER_G_ISSUE(eA[0], ep); PEER_G_ISSUE(eA[1], ep + 8); PEER_G_ISSUE(eB[0], ep + 128); PEER_G_ISSUE(eB[1], ep + 136);
          const bf16* xp = xbase + (size_t)t0 * D_MODEL; PEER_G_ISSUE(xA[0], xp); PEER_G_ISSUE(xA[1], xp + 8); }
        peer_wait2<4>(eA[0], eA[1], eA[0], eA[1]);
#pragma unroll
        for (int i = 0; i < 16; ++i) { const int vo = peer_voff(eA, i, sub); if (i == 0) PEER_ROW_ISSUE_FIRST(r[i], vo, rs); else PEER_ROW_ISSUE(r[i], vo, rs); }
        peer_u_token<0>(r, eB, eA, xA, xB, rs, eid16, xbase, abase, t0, grp, sub, lane);   peer_u_token<1>(r, eA, eB, xB, xA, rs, eid16, xbase, abase, t0, grp, sub, lane);
        peer_u_token<2>(r, eB, eA, xA, xB, rs, eid16, xbase, abase, t0, grp, sub, lane);   peer_u_token<3>(r, eA, eB, xB, xA, rs, eid16, xbase, abase, t0, grp, sub, lane);
        peer_u_token<4>(r, eB, eA, xA, xB, rs, eid16, xbase, abase, t0, grp, sub, lane);   peer_u_token<5>(r, eA, eB, xB, xA, rs, eid16, xbase, abase, t0, grp, sub, lane);
        peer_u_token<6>(r, eB, eA, xA, xB, rs, eid16, xbase, abase, t0, grp, sub, lane);   peer_u_token<7>(r, eA, eB, xB, xA, rs, eid16, xbase, abase, t0, grp, sub, lane);
        peer_u_token<8>(r, eB, eA, xA, xB, rs, eid16, xbase, abase, t0, grp, sub, lane);   peer_u_token<9>(r, eA, eB, xB, xA, rs, eid16, xbase, abase, t0, grp, sub, lane);
        peer_u_token<10>(r, eB, eA, xA, xB, rs, eid16, xbase, abase, t0, grp, sub, lane);  peer_u_token<11>(r, eA, eB, xB, xA, rs, eid16, xbase, abase, t0, grp, sub, lane);
        peer_u_token<12>(r, eB, eA, xA, xB, rs, eid16, xbase, abase, t0, grp, sub, lane);  peer_u_token<13>(r, eA, eB, xB, xA, rs, eid16, xbase, abase, t0, grp, sub, lane);
        peer_u_token<14>(r, eB, eA, xA, xB, rs, eid16, xbase, abase, t0, grp, sub, lane);  peer_u_token<15>(r, eA, eB, xB, xA, rs, eid16, xbase, abase, t0, grp, sub, lane);
    }
}
DI bf16 f2bf16w(float f) { return (bf16)(cvt2(f, 0.f) & 0xffffu); }
DI void peer_w_pass(const unsigned* picks, const float* actp, const float* su, const float* sv, bf16* wbuf, int gw, int NGW, int lane) {
    using namespace cfg;
    for (int t = gw; t < NTOK; t += NGW) {
#pragma unroll
        for (int hf = 0; hf < 2; ++hf) { const int pos = hf * 64 + lane; const unsigned pk = picks[(size_t)t * 128 + pos]; const int e = (int)(pk >> 16); float a = 0.f;
#pragma unroll
            for (int s = 0; s < 8; ++s) a += actp[((size_t)s * NTOK + t) * 128 + pos];
            wbuf[(size_t)t * 128 + pos] = f2bf16w(__uint_as_float(pk << 16) * gelu_erf(a * su[e]) * sv[e]); }
    }
}
template <int IT> DI void peer_v_token(u32x4 (&r)[16], u32x4 (&eNext)[2], u32x4 (&eLoad)[2], u32x4 (&wCur)[2], u32x4 (&wLoad)[2], const i32x4_t rs, const bf16* eid16, const bf16* wbuf, bf16* fbase, int t0, int grp, int sub, int lane) {
    constexpr int NTOP = IT <= 13 ? 4 : IT == 14 ? 2 : 0;
    constexpr int NW = IT <= 14 ? 15 + NTOP : 0;
    if constexpr (IT <= 13) { const bf16* ep = eid16 + (size_t)(t0 + IT + 2) * 128 + grp * 16; PEER_G_ISSUE(eLoad[0], ep); PEER_G_ISSUE(eLoad[1], ep + 8); }
    if constexpr (IT <= 14) { const bf16* wp = wbuf + (size_t)(t0 + IT + 1) * 128 + grp * 16; PEER_G_ISSUE(wLoad[0], wp); PEER_G_ISSUE(wLoad[1], wp + 8); }
    f32x2_t ac2[8];
#pragma unroll
    for (int k = 0; k < 8; ++k) ac2[k] = (f32x2_t){0.f, 0.f};
#pragma unroll
    for (int i = 0; i < 16; ++i) {
        const u32x4 v = r[i];
        if constexpr (IT <= 14) { const int vo = peer_voff(eNext, i, sub); PEER_ROW_ISSUE(r[i], vo, rs); }
        const unsigned wp = wCur[i >> 3][(i >> 1) & 3]; const float w = (i & 1) ? bf_hi(wp) : bf_lo(wp); const f32x2_t w2 = {w, w};
        ac2[0] += w2 * __builtin_amdgcn_cvt_pk_f32_fp8((int)v.x, false); ac2[1] += w2 * __builtin_amdgcn_cvt_pk_f32_fp8((int)v.x, true);
        ac2[2] += w2 * __builtin_amdgcn_cvt_pk_f32_fp8((int)v.y, false); ac2[3] += w2 * __builtin_amdgcn_cvt_pk_f32_fp8((int)v.y, true);
        ac2[4] += w2 * __builtin_amdgcn_cvt_pk_f32_fp8((int)v.z, false); ac2[5] += w2 * __builtin_amdgcn_cvt_pk_f32_fp8((int)v.z, true);
        ac2[6] += w2 * __builtin_amdgcn_cvt_pk_f32_fp8((int)v.w, false); ac2[7] += w2 * __builtin_amdgcn_cvt_pk_f32_fp8((int)v.w, true);
    }
    float acc[16];
#pragma unroll
    for (int k = 0; k < 8; ++k) { acc[2 * k] = ac2[k].x; acc[2 * k + 1] = ac2[k].y; }
    halve_stage<8, 8>(acc, lane); halve_stage<4, 16>(acc, lane); halve_stage<2, 32>(acc, lane);
    *(unsigned*)(fbase + (size_t)(t0 + IT) * cfg::D_MODEL) = cvt2(acc[0], acc[1]);
}
DI void peer_v_phase(volatile LAS unsigned* slot, const bf16* eid16, const bf16* wbuf, const unsigned char* V8S, bf16* ff, gu32* cnt, int tid) {
    using namespace cfg;
    const int wave = tid >> 6;
    int s, blk;
    while (peer_next_item(slot, cnt, tid, s, blk)) {
        int lane = tid & 63; asm volatile("" : "+v"(lane));
        const int grp = lane >> 3, sub = lane & 7;
        const i32x4_t rs = peer_rsrc(V8S + (size_t)s * (2u << 20), 2u << 20);
        const int t0 = blk * PEER_BLK + wave * 16;
        bf16* fbase = ff + (size_t)s * 128 + sub * 16 + 8 * (grp & 1) + 4 * ((grp >> 1) & 1) + 2 * (grp >> 2);
        u32x4 eA[2], eB[2], wA[2], wB[2], r[16];
        { const bf16* ep = eid16 + (size_t)t0 * 128 + grp * 16; PEER_G_ISSUE(eA[0], ep); PEER_G_ISSUE(eA[1], ep + 8); PEER_G_ISSUE(eB[0], ep + 128); PEER_G_ISSUE(eB[1], ep + 136);
          const bf16* wp = wbuf + (size_t)t0 * 128 + grp * 16; PEER_G_ISSUE(wA[0], wp); PEER_G_ISSUE(wA[1], wp + 8); }
        peer_wait2<4>(eA[0], eA[1], eA[0], eA[1]);
#pragma unroll
        for (int i = 0; i < 16; ++i) { const int vo = peer_voff(eA, i, sub); if (i == 0) PEER_ROW_ISSUE_FIRST(r[i], vo, rs); else PEER_ROW_ISSUE(r[i], vo, rs); }
        peer_v_token<0>(r, eB, eA, wA, wB, rs, eid16, wbuf, fbase, t0, grp, sub, lane);   peer_v_token<1>(r, eA, eB, wB, wA, rs, eid16, wbuf, fbase, t0, grp, sub, lane);
        peer_v_token<2>(r, eB, eA, wA, wB, rs, eid16, wbuf, fbase, t0, grp, sub, lane);   peer_v_token<3>(r, eA, eB, wB, wA, rs, eid16, wbuf, fbase, t0, grp, sub, lane);
        peer_v_token<4>(r, eB, eA, wA, wB, rs, eid16, wbuf, fbase, t0, grp, sub, lane);   peer_v_token<5>(r, eA, eB, wB, wA, rs, eid16, wbuf, fbase, t0, grp, sub, lane);
        peer_v_token<6>(r, eB, eA, wA, wB, rs, eid16, wbuf, fbase, t0, grp, sub, lane);   peer_v_token<7>(r, eA, eB, wB, wA, rs, eid16, wbuf, fbase, t0, grp, sub, lane);
        peer_v_token<8>(r, eB, eA, wA, wB, rs, eid16, wbuf, fbase, t0, grp, sub, lane);   peer_v_token<9>(r, eA, eB, wB, wA, rs, eid16, wbuf, fbase, t0, grp, sub, lane);
        peer_v_token<10>(r, eB, eA, wA, wB, rs, eid16, wbuf, fbase, t0, grp, sub, lane);  peer_v_token<11>(r, eA, eB, wB, wA, rs, eid16, wbuf, fbase, t0, grp, sub, lane);
        peer_v_token<12>(r, eB, eA, wA, wB, rs, eid16, wbuf, fbase, t0, grp, sub, lane);  peer_v_token<13>(r, eA, eB, wB, wA, rs, eid16, wbuf, fbase, t0, grp, sub, lane);
        peer_v_token<14>(r, eB, eA, wA, wB, rs, eid16, wbuf, fbase, t0, grp, sub, lane);  peer_v_token<15>(r, eA, eB, wB, wA, rs, eid16, wbuf, fbase, t0, grp, sub, lane);
    }
}
DI void peer_ln_pass(const bf16* H2, const bf16* ff, const float* g, const float* bt, float* out, int gw, int NGW, int lane) {
    using namespace cfg;
    for (int t = gw; t < NTOK; t += NGW) {
        const bf16* xr = H2 + (size_t)t * D_MODEL + lane * 16; const bf16* fr = ff + (size_t)t * D_MODEL + lane * 16;
        const u32x4 xa = *(const u32x4*)xr, xb = *(const u32x4*)(xr + 8), fa = *(const u32x4*)fr, fb = *(const u32x4*)(fr + 8);
        float z[16] = {ALPHA * bf_lo(xa.x) + bf_lo(fa.x), ALPHA * bf_hi(xa.x) + bf_hi(fa.x), ALPHA * bf_lo(xa.y) + bf_lo(fa.y), ALPHA * bf_hi(xa.y) + bf_hi(fa.y), ALPHA * bf_lo(xa.z) + bf_lo(fa.z), ALPHA * bf_hi(xa.z) + bf_hi(fa.z), ALPHA * bf_lo(xa.w) + bf_lo(fa.w), ALPHA * bf_hi(xa.w) + bf_hi(fa.w),
                       ALPHA * bf_lo(xb.x) + bf_lo(fb.x), ALPHA * bf_hi(xb.x) + bf_hi(fb.x), ALPHA * bf_lo(xb.y) + bf_lo(fb.y), ALPHA * bf_hi(xb.y) + bf_hi(fb.y), ALPHA * bf_lo(xb.z) + bf_lo(fb.z), ALPHA * bf_hi(xb.z) + bf_hi(fb.z), ALPHA * bf_lo(xb.w) + bf_lo(fb.w), ALPHA * bf_hi(xb.w) + bf_hi(fb.w)};
        float s = 0.f;
#pragma unroll
        for (int i = 0; i < 16; ++i) s += z[i];
        const float mean = wave_sum(s) * (1.f / 1024.f); float qv = 0.f;
#pragma unroll
        for (int i = 0; i < 16; ++i) { z[i] -= mean; qv += z[i] * z[i]; }
        const float rstd = 1.0f / sqrtf(wave_sum(qv) * (1.f / 1024.f) + LN_EPS);
        float* op = out + (size_t)t * D_MODEL + lane * 16;
#pragma unroll
        for (int q4 = 0; q4 < 4; ++q4) { const f32x4 g0 = *(const f32x4*)(g + lane * 16 + 4 * q4), b0 = *(const f32x4*)(bt + lane * 16 + 4 * q4); f32x4 o;
#pragma unroll
            for (int i = 0; i < 4; ++i) o[i] = z[4 * q4 + i] * rstd * g0[i] + b0[i];
            *(f32x4*)(op + 4 * q4) = o; }
    }
}
constexpr int PROJ_LD = 5632;
constexpr int PC_Q = 0, PC_K = 512, PC_V = 1024, PC_R = 2048, PC_G = 3072, PC_Z = 3088, PC_XBC = 4112, PC_DT = 5392;
struct MixBufs { const bf16* proj; const float* glow; const float* dtraw; bf16* gS; float* gdec; bf16* sS; float* sdec; bf16* oy; int nbatch; };

DI float log_sigmoid_f(float z) { return fminf(z, 0.f) - __logf(1.0f + __expf(-fabsf(z))); }
DI float silu_f(float x) { return x / (1.0f + __expf(-x)); }
DI float bf2f(bf16 v) { return __uint_as_float((unsigned)v << 16); }
DI bf16 f2bf16(float f) { return (bf16)(cvt2(f, 0.f) & 0xffffu); }

DI void gla_gate(LAS unsigned char* lds, const float* glow_rows, const float* wg2, const float* bg, int h, int tid, float (&b)[16], float& blast) {
    LAS float* gl = (LAS float*)lds; LAS float* tot = (LAS float*)(lds + 4096);
    gl[tid] = glow_rows[tid]; gl[tid + 512] = glow_rows[tid + 512];
    const int d = tid & 127, tb = tid >> 7;
    float wc[16];
#pragma unroll
    for (int r = 0; r < 16; ++r) wc[r] = wg2[r * 512 + h * 128 + d];
    const float bgv = bg[h * 128 + d];
    WG_SYNC();
    float run = 0.f;
#pragma unroll
    for (int i = 0; i < 16; ++i) { const LAS float* g = gl + (tb * 16 + i) * 16; float z = bgv;
#pragma unroll
        for (int r = 0; r < 16; ++r) z += g[r] * wc[r];
        run += log_sigmoid_f(z) * 0.0625f; b[i] = run; }
    tot[tb * 128 + d] = run;
    WG_SYNC();
    const float t0 = tot[d], t1 = tot[128 + d], t2 = tot[256 + d], t3 = tot[384 + d];
    const float off = tb == 0 ? 0.f : tb == 1 ? t0 : tb == 2 ? t0 + t1 : t0 + t1 + t2;
    blast = (t0 + t1) + (t2 + t3);
#pragma unroll
    for (int i = 0; i < 16; ++i) b[i] += off;
}

DI void gla_gate_pre(LAS unsigned char* lds, const float (&wc)[16], float bgv, int tid, float (&b)[16], float& blast) {
    LAS float* gl = (LAS float*)lds; LAS float* tot = (LAS float*)(lds + 4096);
    const int d = tid & 127, tb = tid >> 7;
    float run = 0.f;
#pragma unroll
    for (int i = 0; i < 16; ++i) { const LAS float* g = gl + (tb * 16 + i) * 16; float z = bgv;
#pragma unroll
        for (int r = 0; r < 16; ++r) z += g[r] * wc[r];
        run += log_sigmoid_f(z) * 0.0625f; b[i] = run; }
    tot[tb * 128 + d] = run;
    WG_SYNC();
    const float t0 = tot[d], t1 = tot[128 + d], t2 = tot[256 + d], t3 = tot[384 + d];
    const float off = tb == 0 ? 0.f : tb == 1 ? t0 : tb == 2 ? t0 + t1 : t0 + t1 + t2;
    blast = (t0 + t1) + (t2 + t3);
#pragma unroll
    for (int i = 0; i < 16; ++i) b[i] += off;
}

constexpr int GA_KH = 8192, GA_KHP = 320, GA_V = GA_KH + 64 * GA_KHP, GA_VP = 576, GA_ST = GA_V + 64 * GA_VP, GA_STP = 272;
static_assert(GA_ST + 256 * GA_STP <= 152 * 1024, "GLA-A LDS");
DI void gla_a_phase(LAS unsigned char* lds, const MixBufs& mb, const float* wg2, const float* bg, int G, int bx, int tid) {
    using namespace cfg;
    const int wave = tid >> 6;
    const int nitem = mb.nbatch * GLA_HEADS * (SEQ / 64);
    for (int it = bx; it < nitem; it += G) {
        int lane = tid & 63; asm volatile("" : "+v"(lane));
        const int i16 = lane & 15, gi = (lane >> 4) & 1, hh = lane >> 5;
        const int bh = it / (SEQ / 64), c = it % (SEQ / 64), bl = bh / GLA_HEADS, h = bh % GLA_HEADS;
        const size_t row0 = (size_t)bl * SEQ + (size_t)c * 64;
        const bf16* prow = mb.proj + row0 * PROJ_LD;
        const int d = tid & 127, tb = tid >> 7;
        const float g0 = mb.glow[row0 * 16 + tid], g1 = mb.glow[row0 * 16 + tid + 512];
        float wc[16];
#pragma unroll
        for (int r = 0; r < 16; ++r) wc[r] = wg2[r * 512 + h * 128 + d];
        const float bgv = bg[h * 128 + d];
        u32x4 kraw[2], vraw[4];
#pragma unroll
        for (int j = 0; j < 2; ++j) { const int id = tid + 512 * j, t = id >> 4, ch = id & 15; kraw[j] = *(const u32x4*)(prow + (size_t)t * PROJ_LD + PC_K + h * 128 + ch * 8); }
#pragma unroll
        for (int j = 0; j < 4; ++j) { const int id = tid + 512 * j, t = id >> 5, ch = id & 31; vraw[j] = *(const u32x4*)(prow + (size_t)t * PROJ_LD + PC_V + h * 256 + ch * 8); }
        ((LAS float*)lds)[tid] = g0; ((LAS float*)lds)[tid + 512] = g1;
#pragma unroll
        for (int j = 0; j < 2; ++j) { const int id = tid + 512 * j, t = id >> 4, ch = id & 15; *(LAS u32x4*)(lds + GA_KH + t * GA_KHP + ch * 16) = kraw[j]; }
#pragma unroll
        for (int j = 0; j < 4; ++j) { const int id = tid + 512 * j, t = id >> 5, ch = id & 31; *(LAS u32x4*)(lds + GA_V + t * GA_VP + ch * 16) = vraw[j]; }
        WG_SYNC();
        float b[16], blast;
        gla_gate_pre(lds, wc, bgv, tid, b, blast);
#pragma unroll
        for (int i = 0; i < 16; ++i) { const int t = tb * 16 + i; LAS bf16* kp = (LAS bf16*)(lds + GA_KH + t * GA_KHP + d * 2); *kp = f2bf16(bf2f(*kp) * __expf(blast - b[i])); }
        if (tb == 0) mb.gdec[((size_t)bh * (SEQ / 64) + c) * 128 + d] = __expf(blast);
        WG_SYNC();
        const int dtile = wave & 3, eq = wave >> 2;
        f32x16 acc[4];
#pragma unroll
        for (int j = 0; j < 4; ++j)
#pragma unroll
            for (int i = 0; i < 16; ++i) acc[j][i] = 0.f;
        const LAS unsigned char* ka = lds + GA_KH + (8 * hh + (i16 >> 2)) * GA_KHP + (dtile * 32 + 16 * gi + 4 * (i16 & 3)) * 2;
        const LAS unsigned char* va = lds + GA_V + (8 * hh + (i16 >> 2)) * GA_VP + (eq * 128 + 16 * gi + 4 * (i16 & 3)) * 2;
#pragma unroll
        for (int s = 0; s < 4; ++s) {
            const bf16x8 af = cat8(tr_read(ka + 16 * s * GA_KHP), tr_read(ka + (16 * s + 4) * GA_KHP));
#pragma unroll
            for (int j = 0; j < 4; ++j) { const bf16x8 bfr = cat8(tr_read(va + 16 * s * GA_VP + j * 64), tr_read(va + (16 * s + 4) * GA_VP + j * 64)); acc[j] = MFMA32(af, bfr, acc[j]); }
        }
#pragma unroll
        for (int j = 0; j < 4; ++j)
#pragma unroll
            for (int r4 = 0; r4 < 4; ++r4) { u32x2 w; w.x = cvt2(acc[j][4 * r4], acc[j][4 * r4 + 1]); w.y = cvt2(acc[j][4 * r4 + 2], acc[j][4 * r4 + 3]);
                *(LAS u32x2*)(lds + GA_ST + ((eq * 4 + j) * 32 + (lane & 31)) * GA_STP + (dtile * 32 + 8 * r4 + 4 * hh) * 2) = w; }
        WG_SYNC();
        bf16* so = mb.gS + ((size_t)bh * (SEQ / 64) + c) * (256 * 128);
#pragma unroll
        for (int j = 0; j < 8; ++j) { const int id = tid + 512 * j, e = id >> 4, ch = id & 15;
            *(u32x4*)(so + e * 128 + ch * 8) = *(const LAS u32x4*)(lds + GA_ST + e * GA_STP + ch * 16); }
        WG_SYNC();
    }
}

DI void scan_b_phase(const MixBufs& mb, long gtid, long nthr) {
    using namespace cfg;
    const long ngla = (long)mb.nbatch * GLA_HEADS * 256 * 16, nssd = (long)mb.nbatch * SSD_HEADS * 64 * 8;
    for (long i = gtid; i < ngla + nssd; i += nthr) {
        const bool isg = i < ngla;
        bf16* sp; const float* dp; size_t cstride; int dstride;
        if (isg) { const int dg = (int)(i & 15), e = (int)((i >> 4) & 255), bh = (int)(i >> 12); sp = mb.gS + (size_t)bh * (SEQ / 64) * (256 * 128) + e * 128 + dg * 8; dp = mb.gdec + (size_t)bh * (SEQ / 64) * 128 + dg * 8; cstride = 256 * 128; dstride = 128; }
        else { const long j = i - ngla; const int ng = (int)(j & 7), p = (int)((j >> 3) & 63), bh = (int)(j >> 9); sp = mb.sS + (size_t)bh * (SEQ / 64) * 4096 + p * 64 + ng * 8; dp = mb.sdec + (size_t)bh * (SEQ / 64); cstride = 4096; dstride = 1; }
        float st[8];
#pragma unroll
        for (int k = 0; k < 8; ++k) st[k] = 0.f;
        for (int c0 = 0; c0 < SEQ / 64; c0 += 16) {
            u32x4 kv[16];
#pragma unroll
            for (int u = 0; u < 16; ++u) kv[u] = *(const u32x4*)(sp + (size_t)(c0 + u) * cstride);
#pragma unroll
            for (int u4 = 0; u4 < 16; u4 += 4) {
                f32x4 d0[4], d1[4];
#pragma unroll
                for (int u = 0; u < 4; ++u) { if (isg) { d0[u] = *(const f32x4*)(dp + (c0 + u4 + u) * dstride); d1[u] = *(const f32x4*)(dp + (c0 + u4 + u) * dstride + 4); } else { const float dc = dp[c0 + u4 + u]; d0[u] = (f32x4){dc, dc, dc, dc}; d1[u] = d0[u]; } }
#pragma unroll
                for (int u = 0; u < 4; ++u) { const u32x4 k4 = kv[u4 + u];
                    u32x4 o; o.x = cvt2(st[0], st[1]); o.y = cvt2(st[2], st[3]); o.z = cvt2(st[4], st[5]); o.w = cvt2(st[6], st[7]);
                    *(u32x4*)(sp + (size_t)(c0 + u4 + u) * cstride) = o;
                    st[0] = d0[u][0] * st[0] + bf_lo(k4.x); st[1] = d0[u][1] * st[1] + bf_hi(k4.x); st[2] = d0[u][2] * st[2] + bf_lo(k4.y); st[3] = d0[u][3] * st[3] + bf_hi(k4.y);
                    st[4] = d1[u][0] * st[4] + bf_lo(k4.z); st[5] = d1[u][1] * st[5] + bf_hi(k4.z); st[6] = d1[u][2] * st[6] + bf_lo(k4.w); st[7] = d1[u][3] * st[7] + bf_hi(k4.w); }
            }
        }
    }
}

constexpr int GC_SSQ = 6144, GC_QT = 8192, GC_QKP = 272, GC_KT = GC_QT + 64 * GC_QKP, GC_V = GC_KT + 64 * GC_QKP, GC_VP = 576, GC_P = GC_V + 64 * GC_VP, GC_PP = 144, GC_O = GC_P + 64 * GC_PP, GC_OP = 528;
static_assert(GC_O + 64 * GC_OP <= 152 * 1024, "GLA-C LDS");
DI void gla_c_phase(LAS unsigned char* lds, const MixBufs& mb, const float* wg2, const float* bg, const float* norm_g, int G, int bx, int tid) {
    using namespace cfg;
    const int wave = tid >> 6;
    const int nitem = mb.nbatch * GLA_HEADS * (SEQ / 64);
    for (int it = bx; it < nitem; it += G) {
        int lane = tid & 63; asm volatile("" : "+v"(lane));
        const int i16 = lane & 15, gi = (lane >> 4) & 1, hh = lane >> 5, l31 = lane & 31;
        const int bh = it / (SEQ / 64), c = it % (SEQ / 64), bl = bh / GLA_HEADS, h = bh % GLA_HEADS;
        const size_t row0 = (size_t)bl * SEQ + (size_t)c * 64;
        const bf16* prow = mb.proj + row0 * PROJ_LD;
        const int d = tid & 127, tb = tid >> 7;
        const float g0 = mb.glow[row0 * 16 + tid], g1 = mb.glow[row0 * 16 + tid + 512];
        float wc[16];
#pragma unroll
        for (int r = 0; r < 16; ++r) wc[r] = wg2[r * 512 + h * 128 + d];
        const float bgv = bg[h * 128 + d];
        u32x4 qraw[2], kraw[2], vraw[4], rraw[4]; bf16x8 sfr[8];
#pragma unroll
        for (int j = 0; j < 2; ++j) { const int id = tid + 512 * j, t = id >> 4, ch = id & 15; const bf16* pr = prow + (size_t)t * PROJ_LD + h * 128 + ch * 8; qraw[j] = *(const u32x4*)(pr + PC_Q); kraw[j] = *(const u32x4*)(pr + PC_K); }
#pragma unroll
        for (int j = 0; j < 4; ++j) { const int id = tid + 512 * j, t = id >> 5, ch = id & 31; vraw[j] = *(const u32x4*)(prow + (size_t)t * PROJ_LD + PC_V + h * 256 + ch * 8); }
        { const bf16* sin = mb.gS + (((size_t)bh * (SEQ / 64) + c) * 256 + wave * 32 + l31) * 128 + 8 * hh;
#pragma unroll
          for (int ks = 0; ks < 8; ++ks) sfr[ks] = *(const bf16x8*)(sin + 16 * ks); }
#pragma unroll
        for (int j = 0; j < 4; ++j) { const int id = tid + 512 * j, t = id >> 5, ch = id & 31; rraw[j] = *(const u32x4*)(prow + (size_t)t * PROJ_LD + PC_R + h * 256 + ch * 8); }
        ((LAS float*)lds)[tid] = g0; ((LAS float*)lds)[tid + 512] = g1;
#pragma unroll
        for (int j = 0; j < 2; ++j) { const int id = tid + 512 * j, t = id >> 4, ch = id & 15; *(LAS u32x4*)(lds + GC_QT + t * GC_QKP + ch * 16) = qraw[j]; *(LAS u32x4*)(lds + GC_KT + t * GC_QKP + ch * 16) = kraw[j]; }
#pragma unroll
        for (int j = 0; j < 4; ++j) { const int id = tid + 512 * j, t = id >> 5, ch = id & 31; *(LAS u32x4*)(lds + GC_V + t * GC_VP + ch * 16) = vraw[j]; }
        WG_SYNC();
        float b[16], blast;
        gla_gate_pre(lds, wc, bgv, tid, b, blast);
#pragma unroll
        for (int i = 0; i < 16; ++i) { const int t = tb * 16 + i; LAS bf16* qp = (LAS bf16*)(lds + GC_QT + t * GC_QKP + d * 2); LAS bf16* kp = (LAS bf16*)(lds + GC_KT + t * GC_QKP + d * 2);
            *qp = f2bf16(bf2f(*qp) * 0.08838834764831845f * __expf(b[i])); *kp = f2bf16(bf2f(*kp) * __expf(-b[i])); }
        WG_SYNC();
        if (wave < 3) {
            const int st = wave == 2 ? 1 : 0, tt = wave == 0 ? 0 : 1;
            f32x16 p;
#pragma unroll
            for (int i = 0; i < 16; ++i) p[i] = 0.f;
#pragma unroll
            for (int ks = 0; ks < 8; ++ks) { const bf16x8 af = *(const LAS bf16x8*)(lds + GC_KT + (st * 32 + l31) * GC_QKP + (16 * ks + 8 * hh) * 2);
                const bf16x8 bfr = *(const LAS bf16x8*)(lds + GC_QT + (tt * 32 + l31) * GC_QKP + (16 * ks + 8 * hh) * 2); p = MFMA32(af, bfr, p); }
            const int t = tt * 32 + l31;
#pragma unroll
            for (int r4 = 0; r4 < 4; ++r4) { const int s0 = st * 32 + 8 * r4 + 4 * hh; u32x2 w;
                w.x = cvt2(s0 <= t ? p[4 * r4] : 0.f, s0 + 1 <= t ? p[4 * r4 + 1] : 0.f); w.y = cvt2(s0 + 2 <= t ? p[4 * r4 + 2] : 0.f, s0 + 3 <= t ? p[4 * r4 + 3] : 0.f);
                *(LAS u32x2*)(lds + GC_P + t * GC_PP + s0 * 2) = w; }
        }
        WG_SYNC();
        f32x16 o[2];
#pragma unroll
        for (int tt = 0; tt < 2; ++tt)
#pragma unroll
            for (int i = 0; i < 16; ++i) o[tt][i] = 0.f;
        const LAS unsigned char* va = lds + GC_V + (8 * hh + (i16 >> 2)) * GC_VP + (wave * 32 + 16 * gi + 4 * (i16 & 3)) * 2;
#pragma unroll
        for (int ks = 0; ks < 4; ++ks) {
            const bf16x8 af = cat8(tr_read(va + 16 * ks * GC_VP), tr_read(va + (16 * ks + 4) * GC_VP));
            if (ks < 2) { const bf16x8 b0 = *(const LAS bf16x8*)(lds + GC_P + l31 * GC_PP + (16 * ks + 8 * hh) * 2); o[0] = MFMA32(af, b0, o[0]); }
            const bf16x8 b1 = *(const LAS bf16x8*)(lds + GC_P + (32 + l31) * GC_PP + (16 * ks + 8 * hh) * 2); o[1] = MFMA32(af, b1, o[1]);
        }
#pragma unroll
        for (int ks = 0; ks < 8; ++ks) { const bf16x8 af = sfr[ks];
#pragma unroll
            for (int tt = 0; tt < 2; ++tt) { const bf16x8 bfr = *(const LAS bf16x8*)(lds + GC_QT + (tt * 32 + l31) * GC_QKP + (16 * ks + 8 * hh) * 2); o[tt] = MFMA32(af, bfr, o[tt]); } }
#pragma unroll
        for (int tt = 0; tt < 2; ++tt) { float q = 0.f;
#pragma unroll
            for (int i = 0; i < 16; ++i) q += o[tt][i] * o[tt][i];
            q += __shfl_xor(q, 32);
            if (hh == 0) ((LAS float*)(lds + GC_SSQ))[wave * 64 + tt * 32 + l31] = q;
#pragma unroll
            for (int r4 = 0; r4 < 4; ++r4) { u32x2 w; w.x = cvt2(o[tt][4 * r4], o[tt][4 * r4 + 1]); w.y = cvt2(o[tt][4 * r4 + 2], o[tt][4 * r4 + 3]);
                *(LAS u32x2*)(lds + GC_O + (tt * 32 + l31) * GC_OP + (wave * 32 + 8 * r4 + 4 * hh) * 2) = w; } }
        WG_SYNC();
#pragma unroll
        for (int j = 0; j < 4; ++j) { const int id = tid + 512 * j, t = id >> 5, ch = id & 31;
            const LAS float* sq = (const LAS float*)(lds + GC_SSQ) + t; float ss = 0.f;
#pragma unroll
            for (int w = 0; w < 8; ++w) ss += sq[w * 64];
            const float rs = 1.0f / sqrtf(ss * (1.0f / 256.0f) + RMS_EPS);
            const u32x4 ov = *(const LAS u32x4*)(lds + GC_O + t * GC_OP + ch * 16);
            const u32x4 rv = rraw[j];
            const f32x4 g0 = *(const f32x4*)(norm_g + ch * 8), g1 = *(const f32x4*)(norm_g + ch * 8 + 4);
            u32x4 w;
            w.x = cvt2(bf_lo(ov.x) * rs * g0[0] * silu_f(bf_lo(rv.x)), bf_hi(ov.x) * rs * g0[1] * silu_f(bf_hi(rv.x)));
            w.y = cvt2(bf_lo(ov.y) * rs * g0[2] * silu_f(bf_lo(rv.y)), bf_hi(ov.y) * rs * g0[3] * silu_f(bf_hi(rv.y)));
            w.z = cvt2(bf_lo(ov.z) * rs * g1[0] * silu_f(bf_lo(rv.z)), bf_hi(ov.z) * rs * g1[1] * silu_f(bf_hi(rv.z)));
            w.w = cvt2(bf_lo(ov.w) * rs * g1[2] * silu_f(bf_lo(rv.w)), bf_hi(ov.w) * rs * g1[3] * silu_f(bf_hi(rv.w)));
            *(u32x4*)(mb.oy + (row0 + t) * D_MIX + h * 256 + ch * 8) = w; }
        WG_SYNC();
    }
}

constexpr int SD_DT = 0, SD_AC = 2048, SD_XS = 4096, SD_XP = 1088, SD_BM = SD_XS + 64 * SD_XP, SD_BP_TR = 192, SD_BP = 144, SD_CM = SD_BM + 64 * SD_BP_TR, SD_CW = SD_CM + 64 * SD_BP, SD_YP = 1040, SD_STP = 144;
static_assert(SD_CW + 5 * 640 * 4 <= 159 * 1024 && SD_XS + 64 * SD_YP <= SD_CW && SD_XS + 512 * SD_STP <= SD_CW, "SSD LDS");
DI float ssd_dt_scan(LAS unsigned char* lds, float dtraw_v, const float* dt_bias, const float* a_log, int g, int wave, int lane) {
    const int hd = g * 8 + wave;
    const float x = dtraw_v + dt_bias[hd];
    const float dtv = x > 0.f ? x + __logf(1.0f + __expf(-x)) : __logf(1.0f + __expf(x));
    float a = dtv * -__expf(a_log[hd]);
#pragma unroll
    for (int o = 1; o < 64; o <<= 1) { const float v = __shfl_up(a, o); if (lane >= o) a += v; }
    ((LAS float*)(lds + SD_DT))[lane * 8 + wave] = dtv; ((LAS float*)(lds + SD_AC))[lane * 8 + wave] = a;
    return __shfl(a, 63);
}
DI int ssd_xch(int g, int oc) { return oc < 64 ? g * 512 + oc * 8 : oc < 72 ? 1024 + g * 64 + (oc - 64) * 8 : 1152 + g * 64 + (oc - 72) * 8; }
DI void ssd_stage_cw(LAS unsigned char* lds, const float* cw, const float* cb, int g, int tid) {
    for (int i = tid; i < 5 * 640; i += NTHR) { const int k = i / 640, j = i % 640, xch = ssd_xch(g, j >> 3) + (j & 7);
        ((LAS float*)(lds + SD_CW))[i] = k < 4 ? cw[k * cfg::SSD_CONV_DIM + xch] : cb[xch]; }
}
template <int NT> DI void ssd_conv_load(u32x4 (&xin)[NT + 3], const bf16* prow, int g, int c, int oc, int t0) {
    const int xch = ssd_xch(g, oc);
#pragma unroll
    for (int i = 0; i < NT + 3; ++i) { const int t = t0 - 3 + i; xin[i] = (c == 0 && t < 0) ? (u32x4){0u, 0u, 0u, 0u} : *(const u32x4*)(prow + (long)t * PROJ_LD + PC_XBC + xch); }
}
template <int MODE, int NT> DI void ssd_conv_compute(LAS unsigned char* lds, const u32x4 (&xin)[NT + 3], int oc, int t0) {
    const LAS float* wl = (const LAS float*)(lds + SD_CW) + oc * 8;
    float w[4][8], bias[8];
#pragma unroll
    for (int k = 0; k < 4; ++k) { const f32x4 a = *(const LAS f32x4*)(wl + k * 640), b = *(const LAS f32x4*)(wl + k * 640 + 4);
        w[k][0] = a[0]; w[k][1] = a[1]; w[k][2] = a[2]; w[k][3] = a[3]; w[k][4] = b[0]; w[k][5] = b[1]; w[k][6] = b[2]; w[k][7] = b[3]; }
    { const f32x4 a = *(const LAS f32x4*)(wl + 4 * 640), b = *(const LAS f32x4*)(wl + 4 * 640 + 4); bias[0] = a[0]; bias[1] = a[1]; bias[2] = a[2]; bias[3] = a[3]; bias[4] = b[0]; bias[5] = b[1]; bias[6] = b[2]; bias[7] = b[3]; }
#pragma unroll
    for (int i = 0; i < NT; ++i) {
        float y[8];
#pragma unroll
        for (int j = 0; j < 8; ++j) y[j] = bias[j];
#pragma unroll
        for (int k = 0; k < 4; ++k) { const u32x4 v = xin[i + k];
            y[0] += w[k][0] * bf_lo(v.x); y[1] += w[k][1] * bf_hi(v.x); y[2] += w[k][2] * bf_lo(v.y); y[3] += w[k][3] * bf_hi(v.y);
            y[4] += w[k][4] * bf_lo(v.z); y[5] += w[k][5] * bf_hi(v.z); y[6] += w[k][6] * bf_lo(v.w); y[7] += w[k][7] * bf_hi(v.w); }
        const int t = t0 + i; float sc = 1.f;
        if (MODE == 0 && oc < 64) sc = ((const LAS float*)(lds + SD_DT))[t * 8 + (oc >> 3)];
#pragma unroll
        for (int j = 0; j < 8; ++j) y[j] = silu_f(y[j]) * sc;
        u32x4 o; o.x = cvt2(y[0], y[1]); o.y = cvt2(y[2], y[3]); o.z = cvt2(y[4], y[5]); o.w = cvt2(y[6], y[7]);
        if (oc < 64) *(LAS u32x4*)(lds + SD_XS + t * SD_XP + oc * 16) = o;
        else if (oc < 72) *(LAS u32x4*)(lds + SD_BM + t * (MODE == 0 ? SD_BP_TR : SD_BP) + (oc - 64) * 16) = o;
        else *(LAS u32x4*)(lds + SD_CM + t * SD_BP + (oc - 72) * 16) = o;
    }
}
DI void ssd_a_phase(LAS unsigned char* lds, const MixBufs& mb, const float* cw, const float* cb, const float* dt_bias, const float* a_log, int G, int bx, int tid) {
    using namespace cfg;
    const int wave = tid >> 6;
    const int nitem = mb.nbatch * SSD_GROUPS * (SEQ / 64);
    int gstaged = -1;
    for (int it = bx; it < nitem; it += G) {
        int lane = tid & 63; asm volatile("" : "+v"(lane));
        const int i16 = lane & 15, gi = (lane >> 4) & 1, hh = lane >> 5, l31 = lane & 31;
        const int bg = it / (SEQ / 64), c = it % (SEQ / 64), bl = bg / SSD_GROUPS, g = bg % SSD_GROUPS;
        const size_t row0 = (size_t)bl * SEQ + (size_t)c * 64;
        const bf16* prow = mb.proj + row0 * PROJ_LD;
        const float dtraw_v = mb.dtraw[row0 * 16 + lane * 16 + g * 8 + wave];
        u32x4 xin0[11], xin1[4];
        ssd_conv_load<8>(xin0, prow, g, c, tid & 63, (tid >> 6) * 8);
        ssd_conv_load<1>(xin1, prow, g, c, 64 + (tid & 7), tid >> 3);
        if (g != gstaged) { ssd_stage_cw(lds, cw, cb, g, tid); gstaged = g; }
        const float alast = ssd_dt_scan(lds, dtraw_v, dt_bias, a_log, g, wave, lane);
        { LAS float* dtp = (LAS float*)(lds + SD_DT) + lane * 8 + wave; const float ac = ((LAS float*)(lds + SD_AC))[lane * 8 + wave]; *dtp = *dtp * __expf(alast - ac); }
        if (lane == 0) mb.sdec[((size_t)bl * SSD_HEADS + g * 8 + wave) * (SEQ / 64) + c] = __expf(alast);
        WG_SYNC();
        ssd_conv_compute<0, 8>(lds, xin0, tid & 63, (tid >> 6) * 8);
        ssd_conv_compute<0, 1>(lds, xin1, 64 + (tid & 7), tid >> 3);
        WG_SYNC();
        f32x16 acc[2][2];
#pragma unroll
        for (int a = 0; a < 2; ++a)
#pragma unroll
            for (int b = 0; b < 2; ++b)
#pragma unroll
                for (int i = 0; i < 16; ++i) acc[a][b][i] = 0.f;
        const LAS unsigned char* ba = lds + SD_BM + (8 * hh + (i16 >> 2)) * SD_BP_TR + (16 * gi + 4 * (i16 & 3)) * 2;
        const LAS unsigned char* xa = lds + SD_XS + (8 * hh + (i16 >> 2)) * SD_XP + (wave * 64 + 16 * gi + 4 * (i16 & 3)) * 2;
#pragma unroll
        for (int s = 0; s < 4; ++s) {
            bf16x8 af[2], bfr[2];
#pragma unroll
            for (int nt = 0; nt < 2; ++nt) af[nt] = cat8(tr_read(ba + 16 * s * SD_BP_TR + nt * 64), tr_read(ba + (16 * s + 4) * SD_BP_TR + nt * 64));
#pragma unroll
            for (int pt = 0; pt < 2; ++pt) bfr[pt] = cat8(tr_read(xa + 16 * s * SD_XP + pt * 64), tr_read(xa + (16 * s + 4) * SD_XP + pt * 64));
#pragma unroll
            for (int nt = 0; nt < 2; ++nt)
#pragma unroll
                for (int pt = 0; pt < 2; ++pt) acc[nt][pt] = MFMA32(af[nt], bfr[pt], acc[nt][pt]);
        }
        WG_SYNC();
#pragma unroll
        for (int nt = 0; nt < 2; ++nt)
#pragma unroll
            for (int pt = 0; pt < 2; ++pt)
#pragma unroll
                for (int r4 = 0; r4 < 4; ++r4) { u32x2 w; w.x = cvt2(acc[nt][pt][4 * r4], acc[nt][pt][4 * r4 + 1]); w.y = cvt2(acc[nt][pt][4 * r4 + 2], acc[nt][pt][4 * r4 + 3]);
                    *(LAS u32x2*)(lds + SD_XS + (wave * 64 + pt * 32 + l31) * SD_STP + (nt * 32 + 8 * r4 + 4 * hh) * 2) = w; }
        WG_SYNC();
#pragma unroll
        for (int j = 0; j < 8; ++j) { const int id = tid + 512 * j, hd = id >> 9, p = (id >> 3) & 63, ch = id & 7;
            *(u32x4*)(mb.sS + ((((size_t)bl * SSD_HEADS + g * 8 + hd) * (SEQ / 64) + c) * 64 + p) * 64 + ch * 8) = *(const LAS u32x4*)(lds + SD_XS + (hd * 64 + p) * SD_STP + ch * 16); }
        WG_SYNC();
    }
}
DI void ssd_c_phase(LAS unsigned char* lds, const MixBufs& mb, const float* cw, const float* cb, const float* dt_bias, const float* a_log, const float* dskip, const float* norm_g, int G, int bx, int tid) {
    using namespace cfg;
    const int wave = tid >> 6;
    const int nitem = mb.nbatch * SSD_GROUPS * (SEQ / 64);
    int gstaged = -1;
    for (int it = bx; it < nitem; it += G) {
        int lane = tid & 63; asm volatile("" : "+v"(lane));
        const int i16 = lane & 15, gi = (lane >> 4) & 1, hh = lane >> 5, l31 = lane & 31;
        const int bg = it / (SEQ / 64), c = it % (SEQ / 64), bl = bg / SSD_GROUPS, g = bg % SSD_GROUPS, hd = g * 8 + wave;
        const size_t row0 = (size_t)bl * SEQ + (size_t)c * 64;
        const bf16* prow = mb.proj + row0 * PROJ_LD;
        const float dtraw_v = mb.dtraw[row0 * 16 + lane * 16 + g * 8 + wave];
        u32x4 xin0[11], xin1[4], xin2[4];
        ssd_conv_load<8>(xin0, prow, g, c, tid & 63, (tid >> 6) * 8);
        ssd_conv_load<1>(xin1, prow, g, c, 64 + (tid & 15), tid >> 4);
        ssd_conv_load<1>(xin2, prow, g, c, 64 + (tid & 15), 32 + (tid >> 4));
        if (g != gstaged) { ssd_stage_cw(lds, cw, cb, g, tid); gstaged = g; WG_SYNC(); }
        (void)ssd_dt_scan(lds, dtraw_v, dt_bias, a_log, g, wave, lane);
        ssd_conv_compute<1, 8>(lds, xin0, tid & 63, (tid >> 6) * 8);
        ssd_conv_compute<1, 1>(lds, xin1, 64 + (tid & 15), tid >> 4);
        ssd_conv_compute<1, 1>(lds, xin2, 64 + (tid & 15), 32 + (tid >> 4));
        bf16x8 hfr[2][4];
        { const bf16* hin = mb.sS + ((((size_t)bl * SSD_HEADS + hd) * (SEQ / 64) + c) * 64 + l31) * 64 + 8 * hh;
#pragma unroll
          for (int pt = 0; pt < 2; ++pt)
#pragma unroll
              for (int ks = 0; ks < 4; ++ks) hfr[pt][ks] = *(const bf16x8*)(hin + pt * 32 * 64 + 16 * ks); }
        WG_SYNC();
        const LAS float* dtl = (const LAS float*)(lds + SD_DT); const LAS float* acl = (const LAS float*)(lds + SD_AC);
        f32x16 gt[3];
#pragma unroll
        for (int q = 0; q < 3; ++q) { const int st = q == 2 ? 1 : 0, tt = q == 0 ? 0 : 1;
#pragma unroll
            for (int i = 0; i < 16; ++i) gt[q][i] = 0.f;
#pragma unroll
            for (int ks = 0; ks < 4; ++ks) { const bf16x8 af = *(const LAS bf16x8*)(lds + SD_BM + (st * 32 + l31) * SD_BP + (16 * ks + 8 * hh) * 2);
                const bf16x8 bfr = *(const LAS bf16x8*)(lds + SD_CM + (tt * 32 + l31) * SD_BP + (16 * ks + 8 * hh) * 2); gt[q] = MFMA32(af, bfr, gt[q]); } }
        bf16x8 mf[3][2];
#pragma unroll
        for (int q = 0; q < 3; ++q) { const int st = q == 2 ? 1 : 0, tt = q == 0 ? 0 : 1; const int t = tt * 32 + l31; const float at = acl[t * 8 + wave];
            float e[16];
#pragma unroll
            for (int i = 0; i < 16; ++i) { const int s = st * 32 + (i & 3) + 8 * (i >> 2) + 4 * hh; e[i] = s <= t ? gt[q][i] * __expf(at - acl[s * 8 + wave]) * dtl[s * 8 + wave] : 0.f; }
#pragma unroll
            for (int s2 = 0; s2 < 2; ++s2) { u32x4 w; w.x = cvt2(e[8 * s2], e[8 * s2 + 1]); w.y = cvt2(e[8 * s2 + 2], e[8 * s2 + 3]); w.z = cvt2(e[8 * s2 + 4], e[8 * s2 + 5]); w.w = cvt2(e[8 * s2 + 6], e[8 * s2 + 7]); mf[q][s2] = __builtin_bit_cast(bf16x8, w); } }
        f32x16 yd[2][2];
#pragma unroll
        for (int a = 0; a < 2; ++a)
#pragma unroll
            for (int b = 0; b < 2; ++b)
#pragma unroll
                for (int i = 0; i < 16; ++i) yd[a][b][i] = 0.f;
#pragma unroll
        for (int ks = 0; ks < 4; ++ks) { bf16x8 cf[2];
#pragma unroll
            for (int tt = 0; tt < 2; ++tt) cf[tt] = *(const LAS bf16x8*)(lds + SD_CM + (tt * 32 + l31) * SD_BP + (16 * ks + 8 * hh) * 2);
#pragma unroll
            for (int pt = 0; pt < 2; ++pt)
#pragma unroll
                for (int tt = 0; tt < 2; ++tt) yd[pt][tt] = MFMA32(hfr[pt][ks], cf[tt], yd[pt][tt]); }
#pragma unroll
        for (int tt = 0; tt < 2; ++tt) { const float ea = __expf(acl[(tt * 32 + l31) * 8 + wave]);
#pragma unroll
            for (int pt = 0; pt < 2; ++pt)
#pragma unroll
                for (int i = 0; i < 16; ++i) yd[pt][tt][i] *= ea; }
        const LAS unsigned char* xa = lds + SD_XS + (4 * hh + (i16 >> 2)) * SD_XP + (wave * 64 + 16 * gi + 4 * (i16 & 3)) * 2;
#pragma unroll
        for (int pt = 0; pt < 2; ++pt)
#pragma unroll
            for (int st = 0; st < 2; ++st)
#pragma unroll
                for (int s2 = 0; s2 < 2; ++s2) { const LAS unsigned char* a = xa + (st * 32 + 16 * s2) * SD_XP + pt * 64; const bf16x8 xf = cat8(tr_read(a), tr_read(a + 8 * SD_XP));
                    if (st == 0) { yd[pt][0] = MFMA32(xf, mf[0][s2], yd[pt][0]); yd[pt][1] = MFMA32(xf, mf[1][s2], yd[pt][1]); }
                    else yd[pt][1] = MFMA32(xf, mf[2][s2], yd[pt][1]); }
        const float dsk = dskip[hd];
        u32x2 yw[2][2][4];
#pragma unroll
        for (int tt = 0; tt < 2; ++tt) { const int t = tt * 32 + l31;
#pragma unroll
            for (int pt = 0; pt < 2; ++pt)
#pragma unroll
                for (int r4 = 0; r4 < 4; ++r4) { const int p = pt * 32 + 8 * r4 + 4 * hh; const u32x2 xv = *(const LAS u32x2*)(lds + SD_XS + t * SD_XP + (wave * 64 + p) * 2);
                    const float y0 = yd[pt][tt][4 * r4] + dsk * bf_lo(xv.x), y1 = yd[pt][tt][4 * r4 + 1] + dsk * bf_hi(xv.x);
                    const float y2 = yd[pt][tt][4 * r4 + 2] + dsk * bf_lo(xv.y), y3 = yd[pt][tt][4 * r4 + 3] + dsk * bf_hi(xv.y);
                    yw[tt][pt][r4].x = cvt2(y0, y1); yw[tt][pt][r4].y = cvt2(y2, y3); } }
        u32x4 zraw[8];
#pragma unroll
        for (int j = 0; j < 8; ++j) zraw[j] = *(const u32x4*)(prow + (size_t)(tid >> 3) * PROJ_LD + PC_Z + g * 512 + (8 * j + (tid & 7)) * 8);
        WG_SYNC();
#pragma unroll
        for (int tt = 0; tt < 2; ++tt)
#pragma unroll
            for (int pt = 0; pt < 2; ++pt)
#pragma unroll
                for (int r4 = 0; r4 < 4; ++r4) *(LAS u32x2*)(lds + SD_XS + (tt * 32 + l31) * SD_YP + (wave * 64 + pt * 32 + 8 * r4 + 4 * hh) * 2) = yw[tt][pt][r4];
        WG_SYNC();
        { const int t = tid >> 3, sub = tid & 7; float u[8][8]; float ss = 0.f;
#pragma unroll
            for (int j = 0; j < 8; ++j) { const int ch = 8 * j + sub; const u32x4 yv = *(const LAS u32x4*)(lds + SD_XS + t * SD_YP + ch * 16);
                const u32x4 zv = zraw[j];
                u[j][0] = bf_lo(yv.x) * silu_f(bf_lo(zv.x)); u[j][1] = bf_hi(yv.x) * silu_f(bf_hi(zv.x)); u[j][2] = bf_lo(yv.y) * silu_f(bf_lo(zv.y)); u[j][3] = bf_hi(yv.y) * silu_f(bf_hi(zv.y));
                u[j][4] = bf_lo(yv.z) * silu_f(bf_lo(zv.z)); u[j][5] = bf_hi(yv.z) * silu_f(bf_hi(zv.z)); u[j][6] = bf_lo(yv.w) * silu_f(bf_lo(zv.w)); u[j][7] = bf_hi(yv.w) * silu_f(bf_hi(zv.w));
#pragma unroll
                for (int k = 0; k < 8; ++k) ss += u[j][k] * u[j][k]; }
            ss += __shfl_xor(ss, 1); ss += __shfl_xor(ss, 2); ss += __shfl_xor(ss, 4);
            const float rs = 1.0f / sqrtf(ss * (1.0f / 512.0f) + RMS_EPS);
#pragma unroll
            for (int j = 0; j < 8; ++j) { const int ch = 8 * j + sub; const float* ng = norm_g + g * 512 + ch * 8; const f32x4 g0 = *(const f32x4*)ng, g1 = *(const f32x4*)(ng + 4);
                u32x4 w; w.x = cvt2(u[j][0] * rs * g0[0], u[j][1] * rs * g0[1]); w.y = cvt2(u[j][2] * rs * g0[2], u[j][3] * rs * g0[3]);
                w.z = cvt2(u[j][4] * rs * g1[0], u[j][5] * rs * g1[1]); w.w = cvt2(u[j][6] * rs * g1[2], u[j][7] * rs * g1[3]);
                *(u32x4*)(mb.oy + (row0 + t) * D_MIX + GLA_DV + g * 512 + ch * 8) = w; } }
        WG_SYNC();
    }
}

using namespace cfg;
constexpr int RING_OFF = 0, LDSCTL_OFF = 159 * 1024, MISC_OFF = LDSCTL_OFF + 320, LDS_BYTES = 160 * 1024;
constexpr size_t MiB = 1u << 20;
constexpr size_t WS_CTL = 0, CTL_ZERO_BYTES = 1 * MiB;
constexpr int CW_BAR = 4096;
constexpr int HB = 2, MH = HB * SEQ;
constexpr size_t WS_PROJ = 1 * MiB;
constexpr size_t WS_GS = 177 * MiB, WS_GDEC = 241 * MiB, WS_SS = 242 * MiB, WS_SDEC = 274 * MiB, WS_GLOW = 275 * MiB, WS_DTRAW = 276 * MiB;
constexpr size_t WS_H1 = 1 * MiB, WS_QA = 65 * MiB, WS_H2 = 129 * MiB, WS_PICKS = 193 * MiB;
constexpr size_t WS_ACTP = 209 * MiB, WS_WBUF = 337 * MiB, WS_EID = 345 * MiB;
constexpr int CW_PEER = 8192;
constexpr size_t WS_XB = 309 * MiB;
constexpr size_t WS_W = 376 * MiB;
constexpr int N1P = 5632;
constexpr size_t OW_IN = 0, OW_OUT = OW_IN + (size_t)N1P * 1024 * 2, OW_Q = OW_OUT + (size_t)1024 * 2048 * 2, OW_K = OW_Q + 2 * MiB, OW_V = OW_K + 2 * MiB, OW_O = OW_V + 2 * MiB, OW_PQ = OW_O + 2 * MiB, OW_END = OW_PQ + 2 * MiB;
static_assert(OW_END <= 28 * MiB, "weights region");
constexpr size_t WS_U = 404 * MiB, WS_V = 420 * MiB, WS_SU = 436 * MiB, WS_SV = 437 * MiB,
                  WS_MEMB = 468 * MiB, WS_KC = 470 * MiB, WS_VC = 472 * MiB, WS_END = 474 * MiB;

__device__ __forceinline__ void p0_transpose_item(const float* W, int K, int N, bf16* WT, LAS float* scr, int item, int lane) {
    const int nblk = N / 32, kb = item / nblk, nb = item % nblk, k0 = 64 * kb, n0 = 32 * nb;
#pragma unroll 8
    for (int i = 0; i < 32; ++i) { const int kk = 2 * i + (lane >> 5); scr[kk * 33 + (lane & 31)] = W[(size_t)(k0 + kk) * N + n0 + (lane & 31)]; }
    LDS_WAIT(); asm volatile("" ::: "memory");
    const int c = lane & 7;
#pragma unroll
    for (int j = 0; j < 4; ++j) { const int n = (lane >> 3) + 8 * j; const LAS float* s = scr + (8 * c) * 33 + n;
        v4u o; o.x = pk2(s[0 * 33], s[1 * 33]); o.y = pk2(s[2 * 33], s[3 * 33]); o.z = pk2(s[4 * 33], s[5 * 33]); o.w = pk2(s[6 * 33], s[7 * 33]);
        *(GAS v4u*)(WT + (size_t)(n0 + n) * K + k0 + 8 * c) = o; }
    LDS_WAIT(); asm volatile("" ::: "memory");
}
__device__ __forceinline__ void cvt_rows(const float* src, bf16* dst, long n, long gtid, long nthr) {
    for (long i = gtid * 8; i < n; i += nthr * 8) { const f32x4 a = *(const f32x4*)(src + i), b = *(const f32x4*)(src + i + 4);
        v4u o; o.x = cvt2(a.x, a.y); o.y = cvt2(a.z, a.w); o.z = cvt2(b.x, b.y); o.w = cvt2(b.z, b.w); *(v4u*)(dst + i) = o; }
}
__device__ __forceinline__ void cvt_rows_ld(const float* src, bf16* dst, long n, long gtid, long nthr) { cvt_rows(src, dst, n, gtid, nthr); }

struct In27 { const float* p[27]; };
struct Args { In27 in; float* out; unsigned char* ws; };

__global__ void __launch_bounds__(NTHR, 2) mega(Args args) {
    extern __shared__ __attribute__((aligned(16))) unsigned char lds_raw[];
    LAS unsigned char* lds = (LAS unsigned char*)lds_raw;
    volatile LAS unsigned* MISC = (volatile LAS unsigned*)(lds + MISC_OFF);
    const int tid = threadIdx.x, lane = tid & 63, wave = __builtin_amdgcn_readfirstlane(tid >> 6);
    const int G = gridDim.x; const int bx = blockIdx.x; const int vcu = (G % 8 == 0) ? (bx % 8) * (G / 8) + bx / 8 : bx;
    unsigned char* ws = args.ws;
    gu32* ctl = (gu32*)(ws + WS_CTL);
    for (int u = tid; u < (LDS_BYTES - LDSCTL_OFF) / 4; u += NTHR) ((LAS unsigned*)(lds + LDSCTL_OFF))[u] = 0u;
    __syncthreads();
    XcdBarrier bar = xcd_barrier_post((unsigned*)(ctl + CW_BAR), MISC + 8);
    const long nthr = (long)G * NTHR;
    const int gw = vcu * NWAVES + wave, NGW = G * NWAVES;
#define GRID_BAR() xcd_barrier(bar)
    {
        unsigned char* ws = args.ws; asm volatile("" : "+s"(ws));
        unsigned char* wbase = ws + WS_W;
        bf16* w_in_t = (bf16*)(wbase + OW_IN); bf16* w_out_t = (bf16*)(wbase + OW_OUT); bf16* wq_t = (bf16*)(wbase + OW_Q); bf16* wk_t = (bf16*)(wbase + OW_K);
        bf16* wv_t = (bf16*)(wbase + OW_V); bf16* wo_t = (bf16*)(wbase + OW_O); bf16* pwq_t = (bf16*)(wbase + OW_PQ);
        bf16* x_bf = (bf16*)(ws + WS_XB); unsigned char* u8 = ws + WS_U; unsigned char* v8 = ws + WS_V; float* su = (float*)(ws + WS_SU); float* sv = (float*)(ws + WS_SV); bf16* mem_bf = (bf16*)(ws + WS_MEMB);
        bf16* kc = (bf16*)(ws + WS_KC); bf16* vc = (bf16*)(ws + WS_VC);
        bf16* h1 = (bf16*)(ws + WS_H1); bf16* qa = (bf16*)(ws + WS_QA); bf16* h2 = (bf16*)(ws + WS_H2); unsigned* picks = (unsigned*)(ws + WS_PICKS);
        bf16* oy_all = (bf16*)args.out;
        bf16* projb = (bf16*)(ws + WS_PROJ);
        const long gtid = (long)bx * NTHR + tid;
        LAS float* scr = (LAS float*)(lds + RING_OFF + wave * 16384);
        constexpr int I_IN = (D_MODEL / 64) * (D_IN_PROJ / 32), I_OUT = (D_MIX / 64) * (D_MODEL / 32), I_SQ = (D_MODEL / 64) * (D_MODEL / 32);
        constexpr int NITEMS = I_IN + I_OUT + 5 * I_SQ;
        for (int it = gw; it < NITEMS; it += NGW) {
            int r = it; const float* W; int K = D_MODEL, N = D_MODEL; bf16* WT;
            if (r < I_IN) { W = args.in.p[2]; N = D_IN_PROJ; WT = w_in_t; }
            else if ((r -= I_IN) < I_OUT) { W = args.in.p[12]; K = D_MIX; WT = w_out_t; }
            else { r -= I_OUT; const int which = r / I_SQ; r -= which * I_SQ; const int idx = which == 0 ? 15 : which == 1 ? 16 : which == 2 ? 17 : which == 3 ? 18 : 21; W = args.in.p[idx]; WT = wq_t + (size_t)which * D_MODEL * D_MODEL; }
            p0_transpose_item(W, K, N, WT, scr, r, lane);
        }
        for (long i = gtid * 8; i < (long)(N1P - D_IN_PROJ) * D_MODEL; i += nthr * 8) *(v4u*)(w_in_t + (size_t)D_IN_PROJ * D_MODEL + i) = (v4u){0u, 0u, 0u, 0u};
        cvt_fp8_rows(args.in.p[23], u8, su, PEER_EXPERTS, gw, NGW, lane);
        cvt_fp8_rows(args.in.p[24], v8, sv, PEER_EXPERTS, gw, NGW, lane);
        cvt_rows(args.in.p[1], mem_bf, (long)BATCH * MEM_LEN * D_MODEL, gtid, nthr);
        cvt_rows(args.in.p[0], x_bf, (long)NTOK * D_MODEL, gtid, nthr);
        GRID_BAR();
    }
#ifndef REPG
#define REPG 0
#endif
    constexpr int PROG0[] = {0, 1, 2, 3, 4, 5, 6, 7, 8, 9, 10, 11, 12, 13, 14, 15, 16, 17, 18, 19, 20, 21};
    constexpr int PROG1[] = {0, 1, 2, 3, 4, 5, 6, 7, 8, 9, 10, 11, 12, 13, 14, 15, 16, 17, 18, 19, 20, 21, 21};
    constexpr int PROG2[] = {0, 0, 1, 2, 3, 4, 4, 5, 6, 7, 8, 9, 10, 11, 12, 13, 14, 15, 16, 17, 18, 19, 20, 21};
    constexpr int PROG3[] = {0, 1, 2, 3, 103, 4, 5, 6, 7, 107, 8, 9, 10, 11, 12, 13, 14, 15, 16, 17, 18, 19, 20, 21};
    constexpr int PROG4[] = {0, 1, 2, 3, 203, 4, 5, 6, 7, 207, 8, 9, 10, 11, 12, 13, 14, 15, 16, 17, 18, 19, 20, 21};
    constexpr int PROG5[] = {0, 1, 2, 1, 2, 3, 4, 5, 6, 5, 6, 7, 8, 9, 10, 11, 12, 13, 14, 15, 16, 17, 18, 19, 20, 21};
    constexpr int PROG6[] = {0, 1, 2, 3, 4, 5, 6, 7, 8, 9, 8, 9, 10, 11, 12, 13, 14, 15, 14, 15, 16, 17, 18, 19, 20, 21};
    constexpr int PROG7[] = {0, 1, 2, 3, 4, 5, 6, 7, 8, 9, 10, 11, 12, 13, 10, 11, 12, 13, 14, 15, 16, 17, 18, 19, 20, 21};
    constexpr int PROG8[] = {0, 1, 2, 3, 4, 5, 6, 7, 8, 9, 10, 11, 12, 13, 14, 15, 16, 17, 16, 17, 18, 19, 20, 21};
    constexpr int PROG9[] = {0, 1, 2, 3, 4, 5, 6, 7, 8, 9, 10, 11, 12, 13, 14, 15, 16, 17, 17, 18, 19, 19, 20, 21};
    constexpr int PROGN = REPG == 0 ? 22 : REPG == 1 ? 23 : REPG == 2 ? 24 : REPG == 3 ? 24 : REPG == 4 ? 24 : REPG == 5 ? 26 : REPG == 6 ? 26 : REPG == 7 ? 26 : REPG == 8 ? 24 : 24;
    for (int pi = 0; pi < PROGN; ++pi) {
        const int st_raw = REPG == 0 ? PROG0[pi] : REPG == 1 ? PROG1[pi] : REPG == 2 ? PROG2[pi] : REPG == 3 ? PROG3[pi] : REPG == 4 ? PROG4[pi] : REPG == 5 ? PROG5[pi] : REPG == 6 ? PROG6[pi] : REPG == 7 ? PROG7[pi] : REPG == 8 ? PROG8[pi] : PROG9[pi];
        const int st = st_raw % 100, variant = st_raw / 100;
        unsigned char* ws = args.ws; asm volatile("" : "+s"(ws));
        unsigned char* wbase = ws + WS_W;
        bf16* w_in_t = (bf16*)(wbase + OW_IN); bf16* w_out_t = (bf16*)(wbase + OW_OUT); bf16* wq_t = (bf16*)(wbase + OW_Q); bf16* wk_t = (bf16*)(wbase + OW_K);
        bf16* wv_t = (bf16*)(wbase + OW_V); bf16* wo_t = (bf16*)(wbase + OW_O); bf16* pwq_t = (bf16*)(wbase + OW_PQ);
        bf16* x_bf = (bf16*)(ws + WS_XB); unsigned char* u8 = ws + WS_U; unsigned char* v8 = ws + WS_V; float* su = (float*)(ws + WS_SU); float* sv = (float*)(ws + WS_SV); bf16* mem_bf = (bf16*)(ws + WS_MEMB);
        bf16* kc = (bf16*)(ws + WS_KC); bf16* vc = (bf16*)(ws + WS_VC);
        bf16* h1 = (bf16*)(ws + WS_H1); bf16* qa = (bf16*)(ws + WS_QA); bf16* h2 = (bf16*)(ws + WS_H2); unsigned* picks = (unsigned*)(ws + WS_PICKS);
        bf16* oy_all = (bf16*)args.out;
        bf16* projb = (bf16*)(ws + WS_PROJ);
        int tid_ = threadIdx.x; asm volatile("" : "+v"(tid_));
        const long gtid = (long)bx * NTHR + tid_;
        int gk = -1; const int hf = st >> 2;
        if (st < 8) {
            MixBufs mb{projb, (const float*)(ws + WS_GLOW), (const float*)(ws + WS_DTRAW), (bf16*)(ws + WS_GS), (float*)(ws + WS_GDEC), (bf16*)(ws + WS_SS), (float*)(ws + WS_SDEC), oy_all + (size_t)hf * MH * D_MIX, HB};
            switch (st & 3) {
            case 0: gk = 0; break;
            case 1: ssd_a_phase(lds, mb, args.in.p[6], args.in.p[7], args.in.p[8], args.in.p[9], G, bx, tid_); gla_a_phase(lds, mb, args.in.p[3], args.in.p[4], G, bx, tid_); break;
            case 2: scan_b_phase(mb, gtid, nthr); break;
            default: if (variant != 1) ssd_c_phase(lds, mb, args.in.p[6], args.in.p[7], args.in.p[8], args.in.p[9], args.in.p[10], args.in.p[11], G, bx, tid_);
                     if (variant != 2) gla_c_phase(lds, mb, args.in.p[3], args.in.p[4], args.in.p[5], G, bx, tid_); break;
            }
        } else {
            switch (st) {
            case 8: gk = 1; break;
            case 9: ln_rows_bf16(h1, args.in.p[13], args.in.p[14], NTOK, gw, NGW, tid_ & 63); break;
            case 10: gk = 2; break;
            case 11: gk = 3; break;
            case 12: gk = 4; break;
            case 13: attn_phase(lds, qa, kc, vc, G, bx, tid_); break;
            case 14: gk = 5; break;
            case 15: ln_rows_bf16(h2, args.in.p[19], args.in.p[20], NTOK, gw, NGW, tid_ & 63); break;
            case 16: gk = 6; break;
            case 17: topk_phase(lds, qa, args.in.p[22], picks, (bf16*)(ws + WS_EID), G, bx, tid_); break;
            case 18: peer_u_phase(MISC + 16, h2, (const bf16*)(ws + WS_EID), u8, (float*)(ws + WS_ACTP), ctl + CW_PEER, tid_); break;
            case 19: peer_w_pass(picks, (const float*)(ws + WS_ACTP), su, sv, (bf16*)(ws + WS_WBUF), gw, NGW, tid_ & 63); break;
            case 20: peer_v_phase(MISC + 16, (const bf16*)(ws + WS_EID), (const bf16*)(ws + WS_WBUF), v8, qa, ctl + CW_PEER + 1024, tid_); break;
            default: peer_ln_pass(h2, qa, args.in.p[25], args.in.p[26], args.out, gw, NGW, tid_ & 63); break;
            }
        }
        if (gk >= 0) {
            const bf16* A; const bf16* Bt; int M = NTOK, N = D_MODEL, K = D_MODEL; pg8::EpiGen E{0, nullptr, D_MODEL, nullptr, nullptr, nullptr};
            switch (gk) {
            case 0: A = x_bf + (size_t)hf * MH * D_MODEL; Bt = w_in_t; M = MH; N = N1P; E.out = projb; E.ldc = N1P; E.side0 = (float*)(ws + WS_GLOW); E.side1 = (float*)(ws + WS_DTRAW); break;
            case 1: A = oy_all; Bt = w_out_t; K = D_MIX; E.mode = 1; E.out = h1; E.res = args.in.p[0]; break;
            case 2: A = h1; Bt = wq_t; E.out = qa; break;
            case 3: A = mem_bf; Bt = wk_t; M = BATCH * MEM_LEN; E.out = kc; break;
            case 4: A = mem_bf; Bt = wv_t; M = BATCH * MEM_LEN; E.out = vc; break;
            case 5: A = qa; Bt = wo_t; E.mode = 2; E.out = h2; E.res = h1; break;
            default: A = h2; Bt = pwq_t; E.out = qa; break;
            }
            pg8::Gemm g{(const pg8::bf16_t*)A, (const pg8::bf16_t*)Bt, M, N, K}; pg8::StaticOrder S; S.init(M, N, G, bx);
            pg8::gemm_phase<pg8::EpiGen, pg8::StaticOrder, true, true>(lds + RING_OFF, g, S, E);
        }
        GRID_BAR();
    }
}

extern "C" void kernel_launch(void* const* d_in, const int* in_sizes, int n_in, void* d_out, int out_size, void* d_ws, size_t ws_size, hipStream_t stream) {
    static int grid = 0;
    if (grid == 0) {
        int dev = 0, cus = 0, per_cu = 0;
        if (hipGetDevice(&dev) != hipSuccess || hipDeviceGetAttribute(&cus, hipDeviceAttributeMultiprocessorCount, dev) != hipSuccess) { fprintf(stderr, "kernel_launch: device query failed\n"); grid = -1; return; }
        if (hipFuncSetAttribute((const void*)mega, hipFuncAttributeMaxDynamicSharedMemorySize, LDS_BYTES) != hipSuccess) { fprintf(stderr, "kernel_launch: hipFuncSetAttribute failed\n"); grid = -1; return; }
        if (hipOccupancyMaxActiveBlocksPerMultiprocessor(&per_cu, (const void*)mega, NTHR, LDS_BYTES) != hipSuccess || per_cu < 1) fprintf(stderr, "kernel_launch: occupancy query says %d\n", per_cu);
        (void)hipGetLastError();
        if (ws_size < WS_END) { fprintf(stderr, "kernel_launch: workspace too small: ws %zu need %zu\n", ws_size, (size_t)WS_END); grid = -1; return; }
        grid = cus;
    }
    if (grid < 0) return;
    if (hipMemsetAsync((char*)d_ws + WS_CTL, 0, CTL_ZERO_BYTES, stream) != hipSuccess) { fprintf(stderr, "kernel_launch: memset failed\n"); return; }
    Args a{};
    for (int i = 0; i < 27; ++i) a.in.p[i] = (const float*)d_in[i];
    a.out = (float*)d_out; a.ws = (unsigned char*)d_ws;
    hipLaunchKernelGGL(mega, dim3(grid), dim3(NTHR), LDS_BYTES, stream, a);
}
```

```cpp
#include <hip/hip_runtime.h>
#include <cmath>
#include <cstdio>
#include <cstdint>
#define HD __device__ __forceinline__
namespace cfg {
#ifdef SMALL
constexpr int D_MODEL = 128, BATCH = 2, SEQ = 64, GLA_HEADS = 4, GLA_GATE_RANK = 4, SSD_HEADDIM = 16, SSD_GROUPS = 2, SSD_STATE = 16, SSD_CONV = 4,
              MEM_LEN = 16, MEM_HEADS = 2, PEER_HEADS = 2, PEER_N_KEYS = 16, PEER_KEY_DIM = 16, PEER_TOPK = 4;
#else
constexpr int D_MODEL = 1024, BATCH = 4, SEQ = 8192, GLA_HEADS = 4, GLA_GATE_RANK = 16, SSD_HEADDIM = 64, SSD_GROUPS = 2, SSD_STATE = 64, SSD_CONV = 4,
              MEM_LEN = 256, MEM_HEADS = 4, PEER_HEADS = 8, PEER_N_KEYS = 128, PEER_KEY_DIM = 128, PEER_TOPK = 16;
#endif
constexpr int D_MIX = 2 * D_MODEL, GLA_DV = D_MIX / 2, GLA_DK = GLA_DV / 2, GLA_HEAD_K = GLA_DK / GLA_HEADS, GLA_HEAD_V = GLA_DV / GLA_HEADS;
constexpr float GLA_GATE_TAU = 16.0f;
constexpr int SSD_DINNER = D_MIX - GLA_DV, SSD_HEADS = SSD_DINNER / SSD_HEADDIM, SSD_HPG = SSD_HEADS / SSD_GROUPS, SSD_CONV_DIM = SSD_DINNER + 2 * SSD_GROUPS * SSD_STATE;
constexpr int D_IN_PROJ = GLA_DK * 2 + GLA_DV * 2 + GLA_GATE_RANK + SSD_DINNER + SSD_CONV_DIM + SSD_HEADS;
constexpr int MEM_HEAD_DIM = D_MODEL / MEM_HEADS, PEER_EXPERTS = PEER_N_KEYS * PEER_N_KEYS, PEER_HALF = PEER_KEY_DIM / 2;
constexpr float ALPHA = 1.189207115002721f;
constexpr float LN_EPS = 1e-5f, RMS_EPS = 1e-6f;
constexpr int NTOK = BATCH * SEQ;
}
namespace pg8 {
#define PG8_LAS __attribute__((address_space(3)))
typedef unsigned short bf16_t;
typedef short bf16x8 __attribute__((ext_vector_type(8)));
typedef float f32x4 __attribute__((ext_vector_type(4)));
typedef unsigned u32x4 __attribute__((ext_vector_type(4)));
constexpr int BM = 256, BK = 64, HALF = 128, HTB = HALF * BK * 2  , STAGE_BYTES = 8 * HTB, NXCD = 8, WGM = 8;

__host__ __device__ __forceinline__ int lds_byte(int r, int c) { const int st = (r >> 4) * 2 + (c >> 5), rr = r & 15, cc = c & 31, ob = rr * 64 + cc * 2; return st * 1024 + (ob ^ (((ob >> 9) & 1) << 5)); }
__host__ __device__ __forceinline__ void stage_rc(int b, int& R, int& C) { const int st = b / 1024, sb = b % 1024, swz = sb ^ (((sb >> 9) & 1) << 5); R = (st >> 1) * 16 + swz / 64; C = (st & 1) * 32 + (swz % 64) / 2; }
__host__ __device__ __forceinline__ int perm32(int rho) { const int n = rho >> 4, i = rho & 15; return 8 * (i >> 2) + 4 * n + (i & 3); }

struct Unit { int pm, pn; };
struct Gemm { const bf16_t* A; const bf16_t* Bt; int M, N, K; };

struct StaticOrder {
    int nM, nN, nwg, G, c;
    __host__ __device__ void init(int M, int N, int G_, int c_) { nM = M / BM; nN = N / BM; nwg = nM * nN; G = G_; c = c_; }
    __host__ __device__ bool next(int i, Unit& u) const {
        const long L = (long)i * G + c; if (L >= nwg) return false;
        int wgid = (int)L; { const int q = nwg / NXCD, r = nwg % NXCD, xcd = wgid % NXCD, off = wgid / NXCD; wgid = (xcd < r ? xcd * (q + 1) : r * (q + 1) + (xcd - r) * q) + off; }
        const int nig = WGM * nN, gid = wgid / nig, fm = gid * WGM, gsz = (nM - fm) < WGM ? (nM - fm) : WGM;
        u.pm = fm + ((wgid % nig) % gsz); u.pn = (wgid % nig) / gsz; return true;
    }
    __device__ __forceinline__ void a_ready(const Unit&) const {}
    __device__ __forceinline__ void done(const Unit&) const {}
};

__device__ __forceinline__ unsigned cvt_pk_bf16(float lo, float hi) { unsigned r; asm volatile("v_cvt_pk_bf16_f32 %0, %1, %2" : "=v"(r) : "v"(lo), "v"(hi)); return r; }
typedef float f32x2 __attribute__((ext_vector_type(2)));
struct OneUnit {
    int pm, pn;
    __device__ __forceinline__ bool next(int i, Unit& u) const { if (i != 0) return false; u.pm = pm; u.pn = pn; return true; }
    __device__ __forceinline__ void a_ready(const Unit&) const {}
    __device__ __forceinline__ void done(const Unit&) const {}
};
struct EpiF32 {
    static constexpr bool PERM = false, AFTER_DRAIN = false;
    float* C; int ldc; int ncols;
    __device__ __forceinline__ void operator()(const f32x4 (&acc)[2][2][4][2], const Unit& u, int wr, int wc, int fr, int fq) const {
        const int row0 = u.pm * BM + wr * 64 + fr, col0 = u.pn * BM + wc * 32 + 4 * fq;
#pragma unroll
        for (int ai = 0; ai < 2; ++ai)
#pragma unroll
            for (int m = 0; m < 4; ++m) { float* rowp = C + (size_t)(row0 + ai * HALF + m * 16) * ldc + col0;
#pragma unroll
                for (int bj = 0; bj < 2; ++bj)
#pragma unroll
                    for (int n = 0; n < 2; ++n) if (col0 + bj * HALF + n * 16 < ncols) *(f32x4*)(rowp + bj * HALF + n * 16) = acc[ai][bj][m][n]; }
    }
};
template <class Epi, class Sched, bool ALIGN_EPI = false, bool SP2 = false>
__device__ __forceinline__ void gemm_phase(PG8_LAS unsigned char* lds, const Gemm g, const Sched& S, const Epi& E) {
    int tid_o = threadIdx.x; asm volatile("" : "+v"(tid_o));
    const int tid = tid_o, wid = __builtin_amdgcn_readfirstlane(tid >> 6), lane = tid & 63, wr = wid >> 2, wc = wid & 3, fr = lane & 15, fq = lane >> 4;
    const int K = g.K, nt = K / BK;
    unsigned voffA[2], voffB[2];
#pragma unroll
    for (int i = 0; i < 2; ++i) { int R, C; stage_rc(tid * 16 + i * 8192, R, C); const int Rb = Epi::PERM ? ((R & ~31) + perm32(R & 31)) : R;
        voffA[i] = (unsigned)(R * K + C) * 2u; voffB[i] = (unsigned)(Rb * K + C) * 2u; }
    const size_t kstep = (size_t)(BK * 2);
    const size_t hstep = (size_t)HALF * K * 2;
    const size_t tstep = 2 * hstep;
    const unsigned ldsw = (unsigned)wid * 1024u;
    const int aoff = lds_byte(wr * 64 + fr, fq * 8), boff = lds_byte(wc * 32 + fr, fq * 8);
#define PG8_SA(b, h) (((b) * 2 + (h)) * HTB)
#define PG8_SB(b, h) ((4 + (b) * 2 + (h)) * HTB)
#define PG8_STAGE(bufoff, gbase, voff) do { _Pragma("unroll") for (int _i = 0; _i < 2; ++_i) \
        __builtin_amdgcn_global_load_lds((const unsigned*)((const char*)(gbase) + (voff)[_i]), (PG8_LAS unsigned*)(lds + (bufoff) + ldsw + _i * 8192), 16, 0, 0); } while (0)
#define PG8_LDA(dst, b, h) do { _Pragma("unroll") for (int m = 0; m < 4; ++m) _Pragma("unroll") for (int k = 0; k < 2; ++k) dst[m][k] = *(const PG8_LAS bf16x8*)(lds + PG8_SA(b, h) + aoff + m * 2048 + k * 1024); } while (0)
#define PG8_LDB(dst, b, h) do { _Pragma("unroll") for (int n = 0; n < 2; ++n) _Pragma("unroll") for (int k = 0; k < 2; ++k) dst[n][k] = *(const PG8_LAS bf16x8*)(lds + PG8_SB(b, h) + boff + n * 2048 + k * 1024); } while (0)
#define PG8_MMA(ai, bj, At, Bt) do { __builtin_amdgcn_s_setprio(1); _Pragma("unroll") for (int m = 0; m < 4; ++m) _Pragma("unroll") for (int n = 0; n < 2; ++n) _Pragma("unroll") for (int k = 0; k < 2; ++k) \
        acc[ai][bj][m][n] = __builtin_amdgcn_mfma_f32_16x16x32_bf16(Bt[n][k], At[m][k], acc[ai][bj][m][n], 0, 0, 0); __builtin_amdgcn_s_setprio(0); } while (0)
#define PG8_WAIT_V(n) asm volatile("s_waitcnt vmcnt(" #n ")" ::: "memory")
#define PG8_WAIT_L(n) asm volatile("s_waitcnt lgkmcnt(" #n ")" ::: "memory")
#define PG8_BAR __builtin_amdgcn_s_barrier()
#define PG8_SCHED __builtin_amdgcn_sched_barrier(0)
    Unit cur, nxt; int ui = 0;
    if (!S.next(0, cur)) return;
    f32x4 acc[2][2][4][2];
#pragma unroll
    for (int a = 0; a < 2; ++a)
#pragma unroll
        for (int b = 0; b < 2; ++b)
#pragma unroll
            for (int m = 0; m < 4; ++m)
#pragma unroll
                for (int n = 0; n < 2; ++n) acc[a][b][m][n] = (f32x4){0.f, 0.f, 0.f, 0.f};
    bf16x8 At[4][2], B0[2][2], B1[2][2];
    const char* cA = (const char*)g.A + (size_t)cur.pm * tstep; const char* cB = (const char*)g.Bt + (size_t)cur.pn * tstep;
    S.a_ready(cur);
    if constexpr (SP2) {
        PG8_STAGE(PG8_SB(0, 0), cB, voffB); PG8_STAGE(PG8_SB(0, 1), cB + hstep, voffB); PG8_STAGE(PG8_SA(0, 0), cA, voffA); PG8_STAGE(PG8_SA(0, 1), cA + hstep, voffA);
        if (wr == 1) PG8_BAR;
        PG8_WAIT_V(2); PG8_BAR;
        PG8_STAGE(PG8_SB(1, 0), cB + kstep, voffB); PG8_STAGE(PG8_SA(1, 0), cA + kstep, voffA); PG8_STAGE(PG8_SB(1, 1), cB + hstep + kstep, voffB);
        PG8_WAIT_V(6); PG8_BAR;
    } else {
        PG8_STAGE(PG8_SB(0, 0), cB, voffB); PG8_STAGE(PG8_SA(0, 0), cA, voffA); PG8_STAGE(PG8_SB(0, 1), cB + hstep, voffB); PG8_STAGE(PG8_SA(0, 1), cA + hstep, voffA);
        if (wr == 1) PG8_BAR;
        PG8_WAIT_V(4); PG8_BAR;
        PG8_STAGE(PG8_SB(1, 0), cB + kstep, voffB); PG8_STAGE(PG8_SA(1, 0), cA + kstep, voffA); PG8_STAGE(PG8_SB(1, 1), cB + hstep + kstep, voffB);
        PG8_WAIT_V(6); PG8_BAR;
    }
    for (;;) {
        const bool has_next = S.next(ui + 1, nxt);
        const char* nA = has_next ? (const char*)g.A + (size_t)nxt.pm * tstep : cA; const char* nB = has_next ? (const char*)g.Bt + (size_t)nxt.pn * tstep : cB;
        for (int t = 0; t < nt; t += 2) {
            const bool last = (t == nt - 2);
            const char* a1 = cA + (size_t)(t + 1) * kstep;
            const char* a2 = last ? nA : cA + (size_t)(t + 2) * kstep; const char* b2 = last ? nB : cB + (size_t)(t + 2) * kstep;
            const char* a3 = a2 + kstep; const char* b3 = b2 + kstep;
            if (last && has_next) S.a_ready(nxt);
            if constexpr (SP2) {
            PG8_LDB(B0, 0, 0); PG8_LDB(B1, 0, 1); PG8_SCHED; PG8_LDA(At, 0, 0); PG8_STAGE(PG8_SA(1, 1), a1 + hstep, voffA);
            PG8_WAIT_V(8); PG8_WAIT_L(0); PG8_BAR; PG8_MMA(0, 0, At, B0); PG8_MMA(0, 1, At, B1); PG8_BAR; PG8_SCHED;
            PG8_LDA(At, 0, 1); PG8_STAGE(PG8_SB(0, 0), b2, voffB); PG8_STAGE(PG8_SB(0, 1), b2 + hstep, voffB); PG8_STAGE(PG8_SA(0, 0), a2, voffA);
            PG8_WAIT_V(8); PG8_WAIT_L(0); PG8_BAR; PG8_MMA(1, 0, At, B0); PG8_MMA(1, 1, At, B1); PG8_BAR; PG8_SCHED;
            PG8_LDB(B0, 1, 0); PG8_LDB(B1, 1, 1); PG8_SCHED; PG8_LDA(At, 1, 0); PG8_STAGE(PG8_SA(0, 1), a2 + hstep, voffA);
            PG8_WAIT_V(8); PG8_WAIT_L(0); PG8_BAR; PG8_MMA(0, 0, At, B0); PG8_MMA(0, 1, At, B1); PG8_BAR; PG8_SCHED;
            PG8_LDA(At, 1, 1); PG8_STAGE(PG8_SB(1, 0), b3, voffB); PG8_STAGE(PG8_SB(1, 1), b3 + hstep, voffB); PG8_STAGE(PG8_SA(1, 0), a3, voffA);
            PG8_WAIT_V(8); PG8_WAIT_L(0); PG8_BAR; PG8_MMA(1, 0, At, B0); PG8_MMA(1, 1, At, B1); PG8_BAR; PG8_SCHED;
            } else {
            PG8_LDB(B0, 0, 0); PG8_SCHED; PG8_LDA(At, 0, 0); PG8_STAGE(PG8_SA(1, 1), a1 + hstep, voffA);
            PG8_WAIT_L(8); PG8_BAR; PG8_WAIT_L(0); PG8_MMA(0, 0, At, B0); PG8_BAR; PG8_SCHED;
            PG8_LDB(B1, 0, 1); PG8_STAGE(PG8_SB(0, 0), b2, voffB);
            PG8_BAR; PG8_WAIT_L(0); PG8_MMA(0, 1, At, B1); PG8_BAR;
            PG8_LDA(At, 0, 1); PG8_STAGE(PG8_SA(0, 0), a2, voffA);
            PG8_BAR; PG8_WAIT_L(0); PG8_MMA(1, 0, At, B0); PG8_BAR; PG8_SCHED;
            PG8_STAGE(PG8_SB(0, 1), b2 + hstep, voffB);
            PG8_WAIT_V(6); PG8_BAR; PG8_MMA(1, 1, At, B1); PG8_BAR;
            PG8_LDB(B0, 1, 0); PG8_SCHED; PG8_LDA(At, 1, 0); PG8_STAGE(PG8_SA(0, 1), a2 + hstep, voffA);
            PG8_WAIT_L(8); PG8_BAR; PG8_WAIT_L(0); PG8_MMA(0, 0, At, B0); PG8_BAR; PG8_SCHED;
            PG8_LDB(B1, 1, 1); PG8_STAGE(PG8_SB(1, 0), b3, voffB);
            PG8_BAR; PG8_WAIT_L(0); PG8_MMA(0, 1, At, B1); PG8_BAR;
            PG8_LDA(At, 1, 1); PG8_STAGE(PG8_SA(1, 0), a3, voffA);
            PG8_BAR; PG8_WAIT_L(0); PG8_MMA(1, 0, At, B0); PG8_BAR; PG8_SCHED;
            PG8_STAGE(PG8_SB(1, 1), b3 + hstep, voffB);
            PG8_WAIT_V(6); PG8_BAR; PG8_MMA(1, 1, At, B1); PG8_BAR;
            }
        }
        if constexpr (ALIGN_EPI) { if (wr == 0) PG8_BAR; }
        if constexpr (!Epi::AFTER_DRAIN) { E(acc, cur, wr, wc, fr, fq); S.done(cur); }
        if (!has_next) break;
#pragma unroll
        for (int a = 0; a < 2; ++a)
#pragma unroll
            for (int b = 0; b < 2; ++b)
#pragma unroll
                for (int m = 0; m < 4; ++m)
#pragma unroll
                    for (int n = 0; n < 2; ++n) acc[a][b][m][n] = (f32x4){0.f, 0.f, 0.f, 0.f};
        cur = nxt; cA = nA; cB = nB; ++ui;
        if constexpr (ALIGN_EPI) { if (wr == 1) PG8_BAR; }
    }
    PG8_WAIT_V(0);
    if constexpr (!ALIGN_EPI) { if (wr == 0) PG8_BAR; }
    PG8_BAR;
    if constexpr (Epi::AFTER_DRAIN) { E.fused(acc, cur, wr, wc, fr, fq, lds, wid, lane); S.done(cur); }
#undef PG8_SA
#undef PG8_SB
#undef PG8_STAGE
#undef PG8_LDA
#undef PG8_LDB
#undef PG8_MMA
#undef PG8_WAIT_V
#undef PG8_WAIT_L
#undef PG8_BAR
#undef PG8_SCHED
}
}
#define GAS __attribute__((address_space(1)))
#define LAS __attribute__((address_space(3)))
typedef unsigned short bf16;
typedef unsigned v4u __attribute__((ext_vector_type(4)));
typedef float f32x4 __attribute__((ext_vector_type(4)));
typedef short bf16x8 __attribute__((ext_vector_type(8)));
typedef GAS unsigned gu32;
typedef GAS unsigned long long gu64;
#define RLX_AGENT __ATOMIC_RELAXED, __HIP_MEMORY_SCOPE_AGENT
#define LDS_WAIT() asm volatile("s_waitcnt lgkmcnt(0)" ::: "memory")
#define VM_WAIT() asm volatile("s_waitcnt vmcnt(0)" ::: "memory")
__device__ __forceinline__ unsigned long long rt() { return __builtin_amdgcn_s_memrealtime(); }
__device__ __forceinline__ unsigned f2bf(float f) { unsigned u = __builtin_bit_cast(unsigned, f); return (u + 0x7fffu + ((u >> 16) & 1u)) >> 16; }
__device__ __forceinline__ unsigned pk2(float lo, float hi) { return f2bf(lo) | (f2bf(hi) << 16); }
#define XB_TMO      128
#define XB_XCNT(j)  (256  + 64 * (j))
#define XB_XSUB(j)  (1280 + 64 * (j))
#define XB_XGEN(j)  (2304 + 64 * (j))
#define XB_TOP      3328
#define XB_TOPGEN   3392
#define XCD_BAR_WORDS 3456
#define XB_SPIN_CAP (1u << 27)

__device__ __forceinline__ unsigned xb_ld(unsigned* p)              { return __hip_atomic_load(p, __ATOMIC_RELAXED, __HIP_MEMORY_SCOPE_AGENT); }
__device__ __forceinline__ unsigned xb_add(unsigned* p, unsigned v) { return __hip_atomic_fetch_add(p, v, __ATOMIC_RELAXED, __HIP_MEMORY_SCOPE_AGENT); }
__device__ __forceinline__ unsigned xb_xcc_id() { return (unsigned)__builtin_amdgcn_s_getreg((3 << 11) | 20) & 0xFu; }
#define XB_SPIN(cond, bar) do { unsigned _sp = 0; while (cond) { __builtin_amdgcn_s_sleep(1); \
    if ((++_sp & 255u) == 0u) { if (xb_ld(&(bar)[XB_TMO])) break; if (_sp > XB_SPIN_CAP) { atomicAdd(&(bar)[XB_TMO], 1u); break; } } } } while (0)

struct XcdBarrier {
    unsigned* bar; unsigned x;
    volatile LAS unsigned* st;
};

__device__ __forceinline__ XcdBarrier xcd_barrier_post(unsigned* bar, volatile LAS unsigned* st) {
    XcdBarrier b; b.bar = bar; b.x = xb_xcc_id(); b.st = st;
    if (threadIdx.x == 0) (void)xb_add(&bar[XB_XCNT(b.x)], 1u);
    return b;
}
__device__ __forceinline__ void xcd_barrier_complete(unsigned* bar, unsigned x, unsigned& nloc, unsigned& nx) {
    const unsigned G = gridDim.x * gridDim.y * gridDim.z;
    unsigned sum, cnt, mine, sp = 0u;
    for (;;) {
        sum = 0u; cnt = 0u; mine = 0u;
#pragma unroll
        for (unsigned j = 0; j < 16; ++j) { const unsigned c = xb_ld(&bar[XB_XCNT(j)]); sum += c; cnt += (c > 0u) ? 1u : 0u; mine = (j == x) ? c : mine; }
        if (sum == G) break;
        __builtin_amdgcn_s_sleep(1);
        if ((++sp & 255u) == 0u) { if (xb_ld(&bar[XB_TMO])) break; if (sp > XB_SPIN_CAP) { atomicAdd(&bar[XB_TMO], 1u); break; } }
    }
    nloc = mine > 0u ? mine : 1u; nx = cnt > 0u ? cnt : 1u;
}

__device__ __forceinline__ void xcd_barrier(const XcdBarrier& b) {
    asm volatile("s_waitcnt vmcnt(0)" ::: "memory");
    __syncthreads();
    if (threadIdx.x == 0) {
        unsigned* bar = b.bar; asm volatile("" : "+s"(bar));
        const unsigned bx_ = xb_xcc_id();
        __builtin_amdgcn_s_waitcnt(0);
        unsigned nloc = b.st[0], nx = b.st[1];
        if (nloc == 0u) { xcd_barrier_complete(bar, bx_, nloc, nx); b.st[0] = nloc; b.st[1] = nx; }
        const unsigned old = xb_add(&bar[XB_XSUB(bx_)], 1u);
        const unsigned gen = old / nloc;
        if (old + 1u == (gen + 1u) * nloc) {
            __builtin_amdgcn_fence(__ATOMIC_RELEASE, "agent");
            asm volatile("s_waitcnt vmcnt(0)" ::: "memory");
            const unsigned og = xb_add(&bar[XB_TOP], 1u);
            const unsigned tg = og / nx;
            if (og + 1u == (tg + 1u) * nx) xb_add(&bar[XB_TOPGEN], 1u);
            else XB_SPIN(xb_ld(&bar[XB_TOPGEN]) == tg, bar);
            __builtin_amdgcn_fence(__ATOMIC_ACQUIRE, "agent");
            xb_add(&bar[XB_XGEN(bx_)], 1u);
            asm volatile("s_waitcnt vmcnt(0)" ::: "memory");
        } else {
            XB_SPIN(xb_ld(&bar[XB_XGEN(bx_)]) == gen, bar);
            __builtin_amdgcn_fence(__ATOMIC_ACQUIRE, "agent");
            asm volatile("s_waitcnt vmcnt(0)" ::: "memory");
        }
    }
    __syncthreads();
}
typedef float f32x16 __attribute__((ext_vector_type(16)));
typedef short s16x4 __attribute__((ext_vector_type(4)));
typedef short v4i16_t __attribute__((ext_vector_type(4)));
typedef __bf16 bf2_t __attribute__((ext_vector_type(2)));
typedef float f32x2_t __attribute__((ext_vector_type(2)));
typedef unsigned u32x2 __attribute__((ext_vector_type(2)));
typedef unsigned u32x4 __attribute__((ext_vector_type(4)));
#define DI __device__ __forceinline__
constexpr int NWAVES = 8, NTHR = 512;
DI unsigned cvt2(float a, float b) { f32x2_t v = {a, b}; return __builtin_bit_cast(unsigned, __builtin_convertvector(v, bf2_t)); }
DI float bf_lo(unsigned u) { return __uint_as_float(u << 16); }
DI float bf_hi(unsigned u) { return __uint_as_float(u & 0xffff0000u); }
DI s16x4 tr_read(const LAS unsigned char* p) { return __builtin_bit_cast(s16x4, __builtin_amdgcn_ds_read_tr16_b64_v4i16((LAS v4i16_t*)p)); }
DI bf16x8 cat8(s16x4 a, s16x4 b) { bf16x8 r; r[0] = a[0]; r[1] = a[1]; r[2] = a[2]; r[3] = a[3]; r[4] = b[0]; r[5] = b[1]; r[6] = b[2]; r[7] = b[3]; return r; }
DI float wave_sum(float v) {
#pragma unroll
    for (int o = 1; o < 64; o <<= 1) v += __shfl_xor(v, o);
    return v;
}
#define MFMA32(a, b, c) __builtin_amdgcn_mfma_f32_32x32x16_bf16((a), (b), (c), 0, 0, 0)
#define WG_SYNC() __syncthreads()

namespace pg8 {
struct EpiGen {
    static constexpr bool PERM = true, AFTER_DRAIN = false;
    int mode; bf16_t* out; int ldc; const void* res; float* side0; float* side1;
    __device__ __forceinline__ void operator()(const f32x4 (&acc)[2][2][4][2], const Unit& u, int wr, int wc, int fr, int fq) const {
        const int row0 = u.pm * BM + wr * 64 + fr, col0 = u.pn * BM + wc * 32 + 8 * fq; const float alpha = cfg::ALPHA;
#pragma unroll
        for (int ai = 0; ai < 2; ++ai)
#pragma unroll
            for (int m = 0; m < 4; ++m) { const size_t row = (size_t)(row0 + ai * HALF + m * 16);
#pragma unroll
                for (int bj = 0; bj < 2; ++bj) { const int col = col0 + bj * HALF; f32x4 v0 = acc[ai][bj][m][0], v1 = acc[ai][bj][m][1];
                    if (mode == 1) { const float* r = (const float*)res + row * 1024 + col; const f32x4 r0 = *(const f32x4*)r, r1 = *(const f32x4*)(r + 4); v0 += alpha * r0; v1 += alpha * r1; }
                    else if (mode == 2) { const u32x4 r = *(const u32x4*)((const bf16_t*)res + row * 1024 + col);
                        v0[0] += alpha * bf_lo(r.x); v0[1] += alpha * bf_hi(r.x); v0[2] += alpha * bf_lo(r.y); v0[3] += alpha * bf_hi(r.y);
                        v1[0] += alpha * bf_lo(r.z); v1[1] += alpha * bf_hi(r.z); v1[2] += alpha * bf_lo(r.w); v1[3] += alpha * bf_hi(r.w); }
                    u32x4 w; w.x = cvt2(v0[0], v0[1]); w.y = cvt2(v0[2], v0[3]); w.z = cvt2(v1[0], v1[1]); w.w = cvt2(v1[2], v1[3]);
                    *(u32x4*)(out + row * ldc + col) = w;
                    if (side0 && bj == 0) { if (col == 3072 || col == 3080) { float* p = side0 + row * 16 + (col - 3072); *(f32x4*)p = v0; *(f32x4*)(p + 4) = v1; }
                                            if (col == 5392 || col == 5400) { float* p = side1 + row * 16 + (col - 5392); *(f32x4*)p = v0; *(f32x4*)(p + 4) = v1; } } }
                asm volatile("" ::: "memory"); }
    }
};
}

DI void ln_rows_bf16(bf16* buf, const float* g, const float* bt, int rows, int gw, int NGW, int lane) {
    for (int r = gw; r < rows; r += NGW) {
        bf16* p = buf + (size_t)r * 1024 + lane * 8;
        const u32x4 a = *(const u32x4*)p, b = *(const u32x4*)(p + 512);
        float v[16] = {bf_lo(a.x), bf_hi(a.x), bf_lo(a.y), bf_hi(a.y), bf_lo(a.z), bf_hi(a.z), bf_lo(a.w), bf_hi(a.w), bf_lo(b.x), bf_hi(b.x), bf_lo(b.y), bf_hi(b.y), bf_lo(b.z), bf_hi(b.z), bf_lo(b.w), bf_hi(b.w)};
        float s = 0.f;
#pragma unroll
        for (int i = 0; i < 16; ++i) s += v[i];
        const float mean = wave_sum(s) * (1.f / 1024.f); float q = 0.f;
#pragma unroll
        for (int i = 0; i < 16; ++i) { v[i] -= mean; q += v[i] * v[i]; }
        const float rstd = 1.0f / sqrtf(wave_sum(q) * (1.f / 1024.f) + cfg::LN_EPS);
        const f32x4 g0 = *(const f32x4*)(g + lane * 8), g1 = *(const f32x4*)(g + lane * 8 + 4), g2 = *(const f32x4*)(g + 512 + lane * 8), g3 = *(const f32x4*)(g + 512 + lane * 8 + 4);
        const f32x4 b0 = *(const f32x4*)(bt + lane * 8), b1 = *(const f32x4*)(bt + lane * 8 + 4), b2 = *(const f32x4*)(bt + 512 + lane * 8), b3 = *(const f32x4*)(bt + 512 + lane * 8 + 4);
        u32x4 oa, ob;
        oa.x = cvt2(v[0] * rstd * g0[0] + b0[0], v[1] * rstd * g0[1] + b0[1]); oa.y = cvt2(v[2] * rstd * g0[2] + b0[2], v[3] * rstd * g0[3] + b0[3]);
        oa.z = cvt2(v[4] * rstd * g1[0] + b1[0], v[5] * rstd * g1[1] + b1[1]); oa.w = cvt2(v[6] * rstd * g1[2] + b1[2], v[7] * rstd * g1[3] + b1[3]);
        ob.x = cvt2(v[8] * rstd * g2[0] + b2[0], v[9] * rstd * g2[1] + b2[1]); ob.y = cvt2(v[10] * rstd * g2[2] + b2[2], v[11] * rstd * g2[3] + b2[3]);
        ob.z = cvt2(v[12] * rstd * g3[0] + b3[0], v[13] * rstd * g3[1] + b3[1]); ob.w = cvt2(v[14] * rstd * g3[2] + b3[2], v[15] * rstd * g3[3] + b3[3]);
        *(u32x4*)p = oa; *(u32x4*)(p + 512) = ob;
    }
}

constexpr int ATT_KP = 528, ATT_VP = 576;
DI void attn_phase(LAS unsigned char* lds, bf16* QO, const bf16* Kc, const bf16* Vc, int G, int bx, int tid) {
    using namespace cfg;
    const int wave = tid >> 6;
    constexpr int NU = (NTOK / 256) * MEM_HEADS;
    for (int u = bx; u < NU; u += G) {
        int lane = tid & 63; asm volatile("" : "+v"(lane));
        const int q = lane & 31, h = lane >> 5;
        const int bh = u / (SEQ / 256), qb = u % (SEQ / 256), b = bh / MEM_HEADS, hd = bh % MEM_HEADS;
        const bf16* Kg = Kc + (size_t)(b * MEM_LEN) * D_MODEL + hd * MEM_HEAD_DIM;
        const bf16* Vg = Vc + (size_t)(b * MEM_LEN) * D_MODEL + hd * MEM_HEAD_DIM;
        bf16* Qg = QO + ((size_t)b * SEQ + (size_t)qb * 256 + wave * 32 + q) * D_MODEL + hd * MEM_HEAD_DIM;
        WG_SYNC();
#pragma unroll 4
        for (int p = 0; p < 16; ++p) { const int key = p * 16 + (tid >> 5), ch = tid & 31;
            const u32x4 v = *(const u32x4*)(Kg + (size_t)key * D_MODEL + ch * 8); *(LAS u32x4*)(lds + key * ATT_KP + ch * 16) = v; }
        bf16x8 qf[16];
#pragma unroll
        for (int s = 0; s < 16; ++s) qf[s] = *(const bf16x8*)(Qg + 16 * s + 8 * h);
        WG_SYNC();
        f32x16 sc[8];
#pragma unroll
        for (int kt = 0; kt < 8; ++kt) {
#pragma unroll
            for (int i = 0; i < 16; ++i) sc[kt][i] = 0.f;
#pragma unroll
            for (int s = 0; s < 16; ++s) { const bf16x8 kf = *(const LAS bf16x8*)(lds + (kt * 32 + q) * ATT_KP + (16 * s + 8 * h) * 2); sc[kt] = MFMA32(kf, qf[s], sc[kt]); }
        }
        float m = sc[0][0];
#pragma unroll
        for (int kt = 0; kt < 8; ++kt)
#pragma unroll
            for (int i = 0; i < 16; ++i) m = fmaxf(m, sc[kt][i]);
        m = fmaxf(m, __shfl_xor(m, 32));
        const float c = 0.0625f * 1.44269504088896f; float l = 0.f; const float mc = m * c;
        bf16x8 pf[8][2];
#pragma unroll
        for (int kt = 0; kt < 8; ++kt) {
            float e[16];
#pragma unroll
            for (int i = 0; i < 16; ++i) { e[i] = __builtin_amdgcn_exp2f(sc[kt][i] * c - mc); l += e[i]; }
#pragma unroll
            for (int s = 0; s < 2; ++s) { u32x4 w; w.x = cvt2(e[8 * s], e[8 * s + 1]); w.y = cvt2(e[8 * s + 2], e[8 * s + 3]); w.z = cvt2(e[8 * s + 4], e[8 * s + 5]); w.w = cvt2(e[8 * s + 6], e[8 * s + 7]); pf[kt][s] = __builtin_bit_cast(bf16x8, w); }
        }
        l += __shfl_xor(l, 32);
        const float inv = 1.0f / l;
        WG_SYNC();
#pragma unroll 4
        for (int p = 0; p < 16; ++p) { const int key = p * 16 + (tid >> 5), ch = tid & 31;
            const u32x4 v = *(const u32x4*)(Vg + (size_t)key * D_MODEL + ch * 8); *(LAS u32x4*)(lds + key * ATT_VP + ch * 16) = v; }
        WG_SYNC();
        const int gi = (lane >> 4) & 1, i16 = lane & 15;
        const LAS unsigned char* vb = lds + (4 * h + (i16 >> 2)) * ATT_VP + (16 * gi + 4 * (i16 & 3)) * 2;
#pragma unroll
        for (int et = 0; et < 8; ++et) {
            f32x16 o;
#pragma unroll
            for (int i = 0; i < 16; ++i) o[i] = 0.f;
#pragma unroll
            for (int kt = 0; kt < 8; ++kt)
#pragma unroll
                for (int s = 0; s < 2; ++s) { const LAS unsigned char* a = vb + (kt * 32 + 16 * s) * ATT_VP + et * 64;
                    const bf16x8 vf = cat8(tr_read(a), tr_read(a + 8 * ATT_VP)); o = MFMA32(vf, pf[kt][s], o); }
#pragma unroll
            for (int r4 = 0; r4 < 4; ++r4) { u32x2 w; w.x = cvt2(o[4 * r4] * inv, o[4 * r4 + 1] * inv); w.y = cvt2(o[4 * r4 + 2] * inv, o[4 * r4 + 3] * inv);
                *(u32x2*)(Qg + et * 32 + 8 * r4 + 4 * h) = w; }
        }
    }
    WG_SYNC();
}

DI int f2key(float s) { int k = __float_as_int(s); return k ^ ((k >> 31) & 0x7fffffff); }
DI float key2f(int k) { return __int_as_float(k ^ ((k >> 31) & 0x7fffffff)); }
#define CE_DESC(a, b) do { const int _hi = max((a), (b)), _lo = min((a), (b)); (a) = _hi; (b) = _lo; } while (0)
DI void sort16_desc(int (&t)[16]) {
#pragma unroll
    for (int k = 2; k <= 16; k <<= 1)
#pragma unroll
        for (int j = k >> 1; j > 0; j >>= 1)
#pragma unroll
            for (int i = 0; i < 16; ++i) { const int l = i ^ j; if (l > i) { if ((i & k) == 0) CE_DESC(t[i], t[l]); else CE_DESC(t[l], t[i]); } }
}
DI void merge16_desc(int (&a)[16], const int (&b)[16]) {
#pragma unroll
    for (int i = 0; i < 16; ++i) a[i] = max(a[i], b[15 - i]);
#pragma unroll
    for (int j = 8; j > 0; j >>= 1)
#pragma unroll
        for (int i = 0; i < 16; ++i) { const int l = i ^ j; if (l > i) CE_DESC(a[i], a[l]); }
}
constexpr int TK_KP = 144;
DI void topk_phase(LAS unsigned char* lds, const bf16* PQ, const float* keys, unsigned* picks, bf16* eid16, int G, int bx, int tid) {
    using namespace cfg;
    const int lane = tid & 63, wave = tid >> 6, q = lane & 31, h = lane >> 5;
    for (int i = tid; i < 2 * PEER_N_KEYS * PEER_HALF / 2; i += NTHR) { const int row = i / (PEER_HALF / 2), c2 = i % (PEER_HALF / 2);
        const float a = keys[row * PEER_HALF + 2 * c2], b = keys[row * PEER_HALF + 2 * c2 + 1]; *(LAS unsigned*)(lds + row * TK_KP + c2 * 4) = cvt2(a, b); }
    LAS unsigned* lut = (LAS unsigned*)(lds + 40960) + (wave * 64 + lane) * 33;
    WG_SYNC();
    constexpr int NTASK = (NTOK / 32) * PEER_HEADS;
    for (int task = bx * NWAVES + wave; task < NTASK; task += G * NWAVES) {
        const int tb = task / PEER_HEADS, hd = task % PEER_HEADS;
        const bf16* qg = PQ + (size_t)(tb * 32 + q) * D_MODEL + hd * PEER_KEY_DIM;
        int top[2][16];
#pragma unroll
        for (int p = 0; p < 2; ++p) {
            bf16x8 qf[4];
#pragma unroll
            for (int s = 0; s < 4; ++s) qf[s] = *(const bf16x8*)(qg + p * PEER_HALF + 16 * s + 8 * h);
            int grp[4][16];
#pragma unroll
            for (int kt = 0; kt < 4; ++kt) {
                f32x16 sc;
#pragma unroll
                for (int i = 0; i < 16; ++i) sc[i] = 0.f;
#pragma unroll
                for (int s = 0; s < 4; ++s) { const bf16x8 kf = *(const LAS bf16x8*)(lds + (p * PEER_N_KEYS + kt * 32 + q) * TK_KP + (16 * s + 8 * h) * 2); sc = MFMA32(kf, qf[s], sc); }
#pragma unroll
                for (int i = 0; i < 16; ++i) { const int idx = kt * 32 + (i & 3) + 8 * (i >> 2) + 4 * h; grp[kt][i] = (f2key(sc[i]) & ~127) | (127 - idx); }
                sort16_desc(grp[kt]);
            }
            merge16_desc(grp[0], grp[1]); merge16_desc(grp[2], grp[3]); merge16_desc(grp[0], grp[2]);
            int other[16];
#pragma unroll
            for (int i = 0; i < 16; ++i) other[i] = __shfl_xor(grp[0][i], 32);
            merge16_desc(grp[0], other);
#pragma unroll
            for (int i = 0; i < 16; ++i) top[p][i] = grp[0][i];
        }
        float s1[16], s2[16];
#pragma unroll
        for (int i = 0; i < 16; ++i) { s1[i] = key2f(top[0][i] & ~127); s2[i] = key2f(top[1][i] & ~127); lut[i] = 127 - (top[0][i] & 127); lut[16 + i] = 127 - (top[1][i] & 127); }
        int L[16];
#pragma unroll
        for (int j = 0; j < 16; ++j) L[j] = (f2key(s1[0] + s2[j]) & ~255) | (255 - j);
#pragma unroll
        for (int i = 1; i < 16; ++i)
#pragma unroll
            for (int j = 0; j < 16; ++j) if ((i + 1) * (j + 1) <= 16) {
                int x = (f2key(s1[i] + s2[j]) & ~255) | (255 - (16 * i + j));
#pragma unroll
                for (int pz = (i + 1) * (j + 1) - 1; pz < 16; ++pz) CE_DESC(L[pz], x);
            }
        const float best0 = key2f(L[0] & ~255); float ge[16], gs = 0.f;
#pragma unroll
        for (int n = 0; n < 16; ++n) { ge[n] = __expf(key2f(L[n] & ~255) - best0); gs += ge[n]; }
        const float ginv = 1.0f / gs;
        asm volatile("s_waitcnt lgkmcnt(0)" ::: "memory");
        unsigned* pk = picks + ((size_t)(tb * 32 + q) * PEER_HEADS + hd) * 16 + 8 * h;
        unsigned wv[16];
#pragma unroll
        for (int n = 0; n < 16; ++n) { const int c = 255 - (L[n] & 255); const unsigned e = lut[c >> 4] * PEER_N_KEYS + lut[16 + (c & 15)];
            wv[n] = (e << 16) | (cvt2(ge[n] * ginv, 0.f) & 0xffffu); }
        u32x4 o0, o1;
        o0.x = h ? wv[8] : wv[0]; o0.y = h ? wv[9] : wv[1]; o0.z = h ? wv[10] : wv[2]; o0.w = h ? wv[11] : wv[3];
        o1.x = h ? wv[12] : wv[4]; o1.y = h ? wv[13] : wv[5]; o1.z = h ? wv[14] : wv[6]; o1.w = h ? wv[15] : wv[7];
        *(u32x4*)pk = o0; *(u32x4*)(pk + 4) = o1;
        u32x4 e16; e16.x = (o0.x >> 16) | (o0.y & 0xffff0000u); e16.y = (o0.z >> 16) | (o0.w & 0xffff0000u); e16.z = (o1.x >> 16) | (o1.y & 0xffff0000u); e16.w = (o1.z >> 16) | (o1.w & 0xffff0000u);
        *(u32x4*)(eid16 + ((size_t)(tb * 32 + q) * PEER_HEADS + hd) * 16 + 8 * h) = e16;
    }
    WG_SYNC();
}

DI float gelu_erf(float v) {
    const float av = fabsf(v), t = __builtin_amdgcn_rcpf(av * 0.2316418882f + 1.0f);
    float qv = t * 0.5307027145f - 0.7265760135f; qv = qv * t + 0.7107068705f; qv = qv * t - 0.142248368f; qv = qv * t + 0.127414796f; qv = qv * t;
    const float e = __builtin_amdgcn_exp2f(v * v * -0.72134752044f), mm = v * (qv * e);
    return v < 0.f ? mm : v - mm;
}
typedef __bf16 bf8_t __attribute__((ext_vector_type(8)));
DI float dot8(const u32x4 a, const u32x4 b, float acc) {
    const bf8_t a8 = __builtin_bit_cast(bf8_t, a), b8 = __builtin_bit_cast(bf8_t, b);
    acc = __builtin_amdgcn_fdot2_f32_bf16(a8.s01, b8.s01, acc, false);
    acc = __builtin_amdgcn_fdot2_f32_bf16(a8.s23, b8.s23, acc, false);
    acc = __builtin_amdgcn_fdot2_f32_bf16(a8.s45, b8.s45, acc, false);
    acc = __builtin_amdgcn_fdot2_f32_bf16(a8.s67, b8.s67, acc, false);
    return acc;
}
DI void axpy8(float (&o)[8], float w, const u32x4 v) {
    o[0] += w * bf_lo(v.x); o[1] += w * bf_hi(v.x); o[2] += w * bf_lo(v.y); o[3] += w * bf_hi(v.y); o[4] += w * bf_lo(v.z); o[5] += w * bf_hi(v.z); o[6] += w * bf_lo(v.w); o[7] += w * bf_hi(v.w);
}
template <int XM> DI float swz_xor(float v) { return __int_as_float(__builtin_amdgcn_ds_swizzle(__float_as_int(v), (XM << 10) | 0x1f)); }
template <int D> DI void treduce_stage(float (&p)[16], int lane) {
    const bool up = (lane & D) != 0;
#pragma unroll
    for (int k = 0; k < D; ++k) { const float keep = up ? p[k + D] : p[k], send = up ? p[k] : p[k + D]; p[k] = keep + swz_xor<D>(send); }
}
DI float treduce16(float (&p)[16], int lane) {
    treduce_stage<8>(p, lane); treduce_stage<4>(p, lane); treduce_stage<2>(p, lane); treduce_stage<1>(p, lane);
    float r = p[0]; r += swz_xor<16>(r); r += __shfl_xor(r, 32); return r;
}
DI u32x4 bload(__amdgpu_buffer_rsrc_t r, int voff, int soff) { return __builtin_bit_cast(u32x4, __builtin_amdgcn_raw_buffer_load_b128(r, voff, soff, 0)); }
DI void cvt_fp8_rows(const float* src, unsigned char* dst, float* scales, int rows, int gw, int NGW, int lane) {
    for (int r = gw; r < rows; r += NGW) {
        const float* p = src + (size_t)r * 1024 + lane * 16;
        const f32x4 a = *(const f32x4*)p, b = *(const f32x4*)(p + 4), c = *(const f32x4*)(p + 8), d = *(const f32x4*)(p + 12);
        float m = fmaxf(fmaxf(fmaxf(fabsf(a[0]), fabsf(a[1])), fmaxf(fabsf(a[2]), fabsf(a[3]))), fmaxf(fmaxf(fabsf(b[0]), fabsf(b[1])), fmaxf(fabsf(b[2]), fabsf(b[3]))));
        m = fmaxf(m, fmaxf(fmaxf(fmaxf(fabsf(c[0]), fabsf(c[1])), fmaxf(fabsf(c[2]), fabsf(c[3]))), fmaxf(fmaxf(fabsf(d[0]), fabsf(d[1])), fmaxf(fabsf(d[2]), fabsf(d[3])))));
#pragma unroll
        for (int o = 1; o < 64; o <<= 1) m = fmaxf(m, __shfl_xor(m, o));
        const float sc = m > 0.f ? m * (1.0f / 448.0f) : 1.0f, inv = 1.0f / sc;
        u32x4 o;
        o.x = (unsigned)__builtin_amdgcn_cvt_pk_fp8_f32(a[2] * inv, a[3] * inv, __builtin_amdgcn_cvt_pk_fp8_f32(a[0] * inv, a[1] * inv, 0, false), true);
        o.y = (unsigned)__builtin_amdgcn_cvt_pk_fp8_f32(b[2] * inv, b[3] * inv, __builtin_amdgcn_cvt_pk_fp8_f32(b[0] * inv, b[1] * inv, 0, false), true);
        o.z = (unsigned)__builtin_amdgcn_cvt_pk_fp8_f32(c[2] * inv, c[3] * inv, __builtin_amdgcn_cvt_pk_fp8_f32(c[0] * inv, c[1] * inv, 0, false), true);
        o.w = (unsigned)__builtin_amdgcn_cvt_pk_fp8_f32(d[2] * inv, d[3] * inv, __builtin_amdgcn_cvt_pk_fp8_f32(d[0] * inv, d[1] * inv, 0, false), true);
        *(u32x4*)(dst + (size_t)(lane >> 3) * (2u << 20) + (size_t)r * 128 + (lane & 7) * 16) = o;
        if (lane == 0) scales[r] = sc;
    }
}
DI void unpack_fp8x16(const u32x4 v, float (&f)[16]) {
    const f32x2_t a0 = __builtin_amdgcn_cvt_pk_f32_fp8((int)v.x, false), a1 = __builtin_amdgcn_cvt_pk_f32_fp8((int)v.x, true), b0 = __builtin_amdgcn_cvt_pk_f32_fp8((int)v.y, false), b1 = __builtin_amdgcn_cvt_pk_f32_fp8((int)v.y, true);
    const f32x2_t c0 = __builtin_amdgcn_cvt_pk_f32_fp8((int)v.z, false), c1 = __builtin_amdgcn_cvt_pk_f32_fp8((int)v.z, true), d0 = __builtin_amdgcn_cvt_pk_f32_fp8((int)v.w, false), d1 = __builtin_amdgcn_cvt_pk_f32_fp8((int)v.w, true);
    f[0] = a0.x; f[1] = a0.y; f[2] = a1.x; f[3] = a1.y; f[4] = b0.x; f[5] = b0.y; f[6] = b1.x; f[7] = b1.y; f[8] = c0.x; f[9] = c0.y; f[10] = c1.x; f[11] = c1.y; f[12] = d0.x; f[13] = d0.y; f[14] = d1.x; f[15] = d1.y;
}

constexpr int PEER_BLK = 128, PEER_NBLK = cfg::NTOK / PEER_BLK;
DI bool peer_next_item(volatile LAS unsigned* slot, gu32* cnt, int tid, int& s, int& blk) {
    if (tid == 0) { const int myx = (int)(xb_xcc_id() & 7u); int found = -1; unsigned tk = 0u;
        for (int a = 0; a < 8 && found < 0; ++a) { const int ss = (myx + a) & 7; const unsigned t = __hip_atomic_fetch_add(cnt + ss * 64, 1u, __ATOMIC_RELAXED, __HIP_MEMORY_SCOPE_AGENT); if (t < (unsigned)PEER_NBLK) { found = ss; tk = t; } }
        slot[0] = (unsigned)found; slot[1] = tk; }
    __syncthreads();
    s = __builtin_amdgcn_readfirstlane((int)slot[0]); blk = __builtin_amdgcn_readfirstlane((int)slot[1]);
    __syncthreads();
    return s >= 0;
}
template <int LB> DI float xor_lane(float v) { if constexpr (LB < 32) return __int_as_float(__builtin_amdgcn_ds_swizzle(__float_as_int(v), (LB << 10) | 0x1f)); else return __shfl_xor(v, 32); }
template <int AH, int LB> DI void halve_stage(float (&p)[16], int lane) {
    const bool up = (lane & LB) != 0;
#pragma unroll
    for (int k = 0; k < AH; ++k) { const float keep = up ? p[k + AH] : p[k], send = up ? p[k] : p[k + AH]; p[k] = keep + xor_lane<LB>(send); }
}
DI int peer_voff(const u32x4 (&pk)[2], int i, int sub) { const unsigned p = pk[i >> 3][(i >> 1) & 3]; const unsigned e = (i & 1) ? (p >> 16) : (p & 0xffffu); return (int)(e * 128u) + sub * 16; }
DI void peer_load_pk(u32x4 (&pk)[2], const bf16* arr16, int t, int grp) {
    pk[0] = *(const u32x4*)(arr16 + (size_t)t * 128 + grp * 16); pk[1] = *(const u32x4*)(arr16 + (size_t)t * 128 + grp * 16 + 8);
}
typedef int i32x4_t __attribute__((ext_vector_type(4)));
DI i32x4_t peer_rsrc(const void* base, unsigned bytes) {
    const unsigned long long a = (unsigned long long)base; i32x4_t r;
    r.x = __builtin_amdgcn_readfirstlane((int)(unsigned)a); r.y = __builtin_amdgcn_readfirstlane((int)((unsigned)(a >> 32) & 0xffffu)); r.z = __builtin_amdgcn_readfirstlane((int)bytes); r.w = __builtin_amdgcn_readfirstlane(0x00020000);
    return r;
}
#define PEER_ROW_ISSUE(dst, voff, rs) dst = bload(__builtin_amdgcn_make_buffer_rsrc((void*)(((unsigned long long)(unsigned)rs.x) | ((unsigned long long)(unsigned)rs.y << 32)), 0, 2 << 20, 0x00020000), voff, 0)
#define PEER_ROW_ISSUE_FIRST(dst, voff, rs) PEER_ROW_ISSUE(dst, voff, rs)
#define PEER_G_ISSUE(dst, ptr) dst = *(const u32x4*)(ptr)
template <int N> DI void peer_wait(u32x4& r) { }
template <int N> DI void peer_wait2(u32x4& a, u32x4& b, u32x4& c, u32x4& d) { }
template <int IT> DI void peer_u_token(u32x4 (&r)[16], u32x4 (&eNext)[2], u32x4 (&eLoad)[2], u32x4 (&xCur)[2], u32x4 (&xLoad)[2], const i32x4_t rs, const bf16* eid16, const bf16* xbase, float* abase, int t0, int grp, int sub, int lane) {
    constexpr int NTOP = IT <= 13 ? 4 : IT == 14 ? 2 : 0;
    constexpr int NW = IT <= 14 ? 15 + NTOP : 0;
    if constexpr (IT <= 13) { const bf16* ep = eid16 + (size_t)(t0 + IT + 2) * 128 + grp * 16; PEER_G_ISSUE(eLoad[0], ep); PEER_G_ISSUE(eLoad[1], ep + 8); }
    if constexpr (IT <= 14) { const bf16* xp = xbase + (size_t)(t0 + IT + 1) * cfg::D_MODEL; PEER_G_ISSUE(xLoad[0], xp); PEER_G_ISSUE(xLoad[1], xp + 8); }
    f32x2_t xs[8]; float part[16];
    { const u32x4 xa = xCur[0], xb = xCur[1];
      xs[0] = (f32x2_t){bf_lo(xa.x), bf_hi(xa.x)}; xs[1] = (f32x2_t){bf_lo(xa.y), bf_hi(xa.y)}; xs[2] = (f32x2_t){bf_lo(xa.z), bf_hi(xa.z)}; xs[3] = (f32x2_t){bf_lo(xa.w), bf_hi(xa.w)};
      xs[4] = (f32x2_t){bf_lo(xb.x), bf_hi(xb.x)}; xs[5] = (f32x2_t){bf_lo(xb.y), bf_hi(xb.y)}; xs[6] = (f32x2_t){bf_lo(xb.z), bf_hi(xb.z)}; xs[7] = (f32x2_t){bf_lo(xb.w), bf_hi(xb.w)}; }
#pragma unroll
    for (int i = 0; i < 16; ++i) {
        const u32x4 v = r[i];
        if constexpr (IT <= 14) { const int vo = peer_voff(eNext, i, sub); PEER_ROW_ISSUE(r[i], vo, rs); }
        f32x2_t a = __builtin_amdgcn_cvt_pk_f32_fp8((int)v.x, false) * xs[0], b = __builtin_amdgcn_cvt_pk_f32_fp8((int)v.x, true) * xs[1];
        a += __builtin_amdgcn_cvt_pk_f32_fp8((int)v.y, false) * xs[2]; b += __builtin_amdgcn_cvt_pk_f32_fp8((int)v.y, true) * xs[3];
        a += __builtin_amdgcn_cvt_pk_f32_fp8((int)v.z, false) * xs[4]; b += __builtin_amdgcn_cvt_pk_f32_fp8((int)v.z, true) * xs[5];
        a += __builtin_amdgcn_cvt_pk_f32_fp8((int)v.w, false) * xs[6]; b += __builtin_amdgcn_cvt_pk_f32_fp8((int)v.w, true) * xs[7];
        a += b; part[i] = a.x + a.y;
    }
    halve_stage<8, 4>(part, lane); halve_stage<4, 2>(part, lane); halve_stage<2, 1>(part, lane);
    *(f32x2_t*)(abase + (size_t)(t0 + IT) * 128) = (f32x2_t){part[0], part[1]};
}
DI void peer_u_phase(volatile LAS unsigned* slot, const bf16* H2, const bf16* eid16, const unsigned char* U8S, float* actp, gu32* cnt, int tid) {
    using namespace cfg;
    const int wave = tid >> 6;
    int s, blk;
    while (peer_next_item(slot, cnt, tid, s, blk)) {
        int lane = tid & 63; asm volatile("" : "+v"(lane));
        const int grp = lane >> 3, sub = lane & 7;
        const i32x4_t rs = peer_rsrc(U8S + (size_t)s * (2u << 20), 2u << 20);
        const int t0 = blk * PEER_BLK + wave * 16;
        const bf16* xbase = H2 + (size_t)s * 128 + sub * 16;
        float* abase = actp + ((size_t)s * NTOK) * 128 + grp * 16 + 2 * sub;
        u32x4 eA[2], eB[2], xA[2], xB[2], r[16];
        { const bf16* ep = eid16 + (size_t)t0 * 128 + grp * 16; PEER_G_ISSUE(eA[0], ep); PEER_G_ISSUE(eA[1], ep + 8); PEER_G_ISSUE(eB[0], ep + 128); PEER_G_ISSUE(eB[1], ep + 136);
          const bf16* xp = xbase + (size_t)t0 * D_MODEL; PEER_G_ISSUE(xA[0], xp); PEER_G_ISSUE(xA[1], xp + 8); }
        peer_wait2<4>(eA[0], eA[1], eA[0], eA[1]);
#pragma unroll
        for (int i = 0; i < 16; ++i) { const int vo = peer_voff(eA, i, sub); if (i == 0) PEER_ROW_ISSUE_FIRST(r[i], vo, rs); else PEER_ROW_ISSUE(r[i], vo, rs); }
        peer_u_token<0>(r, eB, eA, xA, xB, rs, eid16, xbase, abase, t0, grp, sub, lane);   peer_u_token<1>(r, eA, eB, xB, xA, rs, eid16, xbase, abase, t0, grp, sub, lane);
        peer_u_token<2>(r, eB, eA, xA, xB, rs, eid16, xbase, abase, t0, grp, sub, lane);   peer_u_token<3>(r, eA, eB, xB, xA, rs, eid16, xbase, abase, t0, grp, sub, lane);
        peer_u_token<4>(r, eB, eA, xA, xB, rs, eid16, xbase, abase, t0, grp, sub, lane);   peer_u_token<5>(r, eA, eB, xB, xA, rs, eid16, xbase, abase, t0, grp, sub, lane);
        peer_u_token<6>(r, eB, eA, xA, xB, rs, eid16, xbase, abase, t0, grp, sub, lane);   peer_u_token<7>(r, eA, eB, xB, xA, rs, eid16, xbase, abase, t0, grp, sub, lane);
        peer_u_token<8>(r, eB, eA, xA, xB, rs, eid16, xbase, abase, t0, grp, sub, lane);   peer_u_token<9>(r, eA, eB, xB, xA, rs, eid16, xbase, abase, t0, grp, sub, lane);
        peer_u_token<10>(r, eB, eA, xA, xB, rs, eid16, xbase, abase, t0, grp, sub, lane);  peer_u_token<11>(r, eA, eB, xB, xA, rs, eid16, xbase, abase, t0, grp, sub, lane);
        peer_u_token<12>(r, eB, eA, xA, xB, rs, eid16, xbase, abase, t0, grp, sub, lane);  peer_u_token<13>(r, eA, eB, xB, xA, rs, eid16, xbase, abase, t0, grp, sub, lane);
        peer_u_token<14>(r, eB, eA, xA, xB, rs, eid16, xbase, abase, t0, grp, sub, lane);  peer_u_token<15>(r, eA, eB, xB, xA, rs, eid16, xbase, abase, t0, grp, sub, lane);
    }
}
DI bf16 f2bf16w(float f) { return (bf16)(cvt2(f, 0.f) & 0xffffu); }
DI void peer_w_pass(const unsigned* picks, const float* actp, const float* su, const float* sv, bf16* wbuf, int gw, int NGW, int lane) {
    using namespace cfg;
    for (int t = gw; t < NTOK; t += NGW) {
#pragma unroll
        for (int hf = 0; hf < 2; ++hf) { const int pos = hf * 64 + lane; const unsigned pk = picks[(size_t)t * 128 + pos]; const int e = (int)(pk >> 16); float a = 0.f;
#pragma unroll
            for (int s = 0; s < 8; ++s) a += actp[((size_t)s * NTOK + t) * 128 + pos];
            wbuf[(size_t)t * 128 + pos] = f2bf16w(__uint_as_float(pk << 16) * gelu_erf(a * su[e]) * sv[e]); }
    }
}
template <int IT> DI void peer_v_token(u32x4 (&r)[16], u32x4 (&eNext)[2], u32x4 (&eLoad)[2], u32x4 (&wCur)[2], u32x4 (&wLoad)[2], const i32x4_t rs, const bf16* eid16, const bf16* wbuf, bf16* fbase, int t0, int grp, int sub, int lane) {
    constexpr int NTOP = IT <= 13 ? 4 : IT == 14 ? 2 : 0;
    constexpr int NW = IT <= 14 ? 15 + NTOP : 0;
    if constexpr (IT <= 13) { const bf16* ep = eid16 + (size_t)(t0 + IT + 2) * 128 + grp * 16; PEER_G_ISSUE(eLoad[0], ep); PEER_G_ISSUE(eLoad[1], ep + 8); }
    if constexpr (IT <= 14) { const bf16* wp = wbuf + (size_t)(t0 + IT + 1) * 128 + grp * 16; PEER_G_ISSUE(wLoad[0], wp); PEER_G_ISSUE(wLoad[1], wp + 8); }
    f32x2_t ac2[8];
#pragma unroll
    for (int k = 0; k < 8; ++k) ac2[k] = (f32x2_t){0.f, 0.f};
#pragma unroll
    for (int i = 0; i < 16; ++i) {
        const u32x4 v = r[i];
        if constexpr (IT <= 14) { const int vo = peer_voff(eNext, i, sub); PEER_ROW_ISSUE(r[i], vo, rs); }
        const unsigned wp = wCur[i >> 3][(i >> 1) & 3]; const float w = (i & 1) ? bf_hi(wp) : bf_lo(wp); const f32x2_t w2 = {w, w};
        ac2[0] += w2 * __builtin_amdgcn_cvt_pk_f32_fp8((int)v.x, false); ac2[1] += w2 * __builtin_amdgcn_cvt_pk_f32_fp8((int)v.x, true);
        ac2[2] += w2 * __builtin_amdgcn_cvt_pk_f32_fp8((int)v.y, false); ac2[3] += w2 * __builtin_amdgcn_cvt_pk_f32_fp8((int)v.y, true);
        ac2[4] += w2 * __builtin_amdgcn_cvt_pk_f32_fp8((int)v.z, false); ac2[5] += w2 * __builtin_amdgcn_cvt_pk_f32_fp8((int)v.z, true);
        ac2[6] += w2 * __builtin_amdgcn_cvt_pk_f32_fp8((int)v.w, false); ac2[7] += w2 * __builtin_amdgcn_cvt_pk_f32_fp8((int)v.w, true);
    }
    float acc[16];
#pragma unroll
    for (int k = 0; k < 8; ++k) { acc[2 * k] = ac2[k].x; acc[2 * k + 1] = ac2[k].y; }
    halve_stage<8, 8>(acc, lane); halve_stage<4, 16>(acc, lane); halve_stage<2, 32>(acc, lane);
    *(unsigned*)(fbase + (size_t)(t0 + IT) * cfg::D_MODEL) = cvt2(acc[0], acc[1]);
}
DI void peer_v_phase(volatile LAS unsigned* slot, const bf16* eid16, const bf16* wbuf, const unsigned char* V8S, bf16* ff, gu32* cnt, int tid) {
    using namespace cfg;
    const int wave = tid >> 6;
    int s, blk;
    while (peer_next_item(slot, cnt, tid, s, blk)) {
        int lane = tid & 63; asm volatile("" : "+v"(lane));
        const int grp = lane >> 3, sub = lane & 7;
        const i32x4_t rs = peer_rsrc(V8S + (size_t)s * (2u << 20), 2u << 20);
        const int t0 = blk * PEER_BLK + wave * 16;
        bf16* fbase = ff + (size_t)s * 128 + sub * 16 + 8 * (grp & 1) + 4 * ((grp >> 1) & 1) + 2 * (grp >> 2);
        u32x4 eA[2], eB[2], wA[2], wB[2], r[16];
        { const bf16* ep = eid16 + (size_t)t0 * 128 + grp * 16; PEER_G_ISSUE(eA[0], ep); PEER_G_ISSUE(eA[1], ep + 8); PEER_G_ISSUE(eB[0], ep + 128); PEER_G_ISSUE(eB[1], ep + 136);
          const bf16* wp = wbuf + (size_t)t0 * 128 + grp * 16; PEER_G_ISSUE(wA[0], wp); PEER_G_ISSUE(wA[1], wp + 8); }
        peer_wait2<4>(eA[0], eA[1], eA[0], eA[1]);
#pragma unroll
        for (int i = 0; i < 16; ++i) { const int vo = peer_voff(eA, i, sub); if (i == 0) PEER_ROW_ISSUE_FIRST(r[i], vo, rs); else PEER_ROW_ISSUE(r[i], vo, rs); }
        peer_v_token<0>(r, eB, eA, wA, wB, rs, eid16, wbuf, fbase, t0, grp, sub, lane);   peer_v_token<1>(r, eA, eB, wB, wA, rs, eid16, wbuf, fbase, t0, grp, sub, lane);
        peer_v_token<2>(r, eB, eA, wA, wB, rs, eid16, wbuf, fbase, t0, grp, sub, lane);   peer_v_token<3>(r, eA, eB, wB, wA, rs, eid16, wbuf, fbase, t0, grp, sub, lane);
        peer_v_token<4>(r, eB, eA, wA, wB, rs, eid16, wbuf, fbase, t0, grp, sub, lane);   peer_v_token<5>(r, eA, eB, wB, wA, rs, eid16, wbuf, fbase, t0, grp, sub, lane);
        peer_v_token<6>(r, eB, eA, wA, wB, rs, eid16, wbuf, fbase, t0, grp, sub, lane);   peer_v_token<7>(r, eA, eB, wB, wA, rs, eid16, wbuf, fbase, t0, grp, sub, lane);
        peer_v_token<8>(r, eB, eA, wA, wB, rs, eid16, wbuf, fbase, t0, grp, sub, lane);   peer_v_token<9>(r, eA, eB, wB, wA, rs, eid16, wbuf, fbase, t0, grp, sub, lane);
        peer_v_token<10>(r, eB, eA, wA, wB, rs, eid16, wbuf, fbase, t0, grp, sub, lane);  peer_v_token<11>(r, eA, eB, wB, wA, rs, eid16, wbuf, fbase, t0, grp, sub, lane);
        peer_v_token<12>(r, eB, eA, wA, wB, rs, eid16, wbuf, fbase, t0, grp, sub, lane);  peer_v_token<13>(r, eA, eB, wB, wA, rs, eid16, wbuf, fbase, t0, grp, sub, lane);
        peer_v_token<14>(r, eB, eA, wA, wB, rs, eid16, wbuf, fbase, t0, grp, sub, lane);  peer_v_token<15>(r, eA, eB, wB, wA, rs, eid16, wbuf, fbase, t0, grp, sub, lane);
    }
}
DI void peer_ln_pass(const bf16* H2, const bf16* ff, const float* g, const float* bt, float* out, int gw, int NGW, int lane) {
    using namespace cfg;
    for (int t = gw; t < NTOK; t += NGW) {
        const bf16* xr = H2 + (size_t)t * D_MODEL + lane * 16; const bf16* fr = ff + (size_t)t * D_MODEL + lane * 16;
        const u32x4 xa = *(const u32x4*)xr, xb = *(const u32x4*)(xr + 8), fa = *(const u32x4*)fr, fb = *(const u32x4*)(fr + 8);
        float z[16] = {ALPHA * bf_lo(xa.x) + bf_lo(fa.x), ALPHA * bf_hi(xa.x) + bf_hi(fa.x), ALPHA * bf_lo(xa.y) + bf_lo(fa.y), ALPHA * bf_hi(xa.y) + bf_hi(fa.y), ALPHA * bf_lo(xa.z) + bf_lo(fa.z), ALPHA * bf_hi(xa.z) + bf_hi(fa.z), ALPHA * bf_lo(xa.w) + bf_lo(fa.w), ALPHA * bf_hi(xa.w) + bf_hi(fa.w),
                       ALPHA * bf_lo(xb.x) + bf_lo(fb.x), ALPHA * bf_hi(xb.x) + bf_hi(fb.x), ALPHA * bf_lo(xb.y) + bf_lo(fb.y), ALPHA * bf_hi(xb.y) + bf_hi(fb.y), ALPHA * bf_lo(xb.z) + bf_lo(fb.z), ALPHA * bf_hi(xb.z) + bf_hi(fb.z), ALPHA * bf_lo(xb.w) + bf_lo(fb.w), ALPHA * bf_hi(xb.w) + bf_hi(fb.w)};
        float s = 0.f;
#pragma unroll
        for (int i = 0; i < 16; ++i) s += z[i];
        const float mean = wave_sum(s) * (1.f / 1024.f); float qv = 0.f;
#pragma unroll
        for (int i = 0; i < 16; ++i) { z[i] -= mean; qv += z[i] * z[i]; }
        const float rstd = 1.0f / sqrtf(wave_sum(qv) * (1.f / 1024.f) + LN_EPS);
        float* op = out + (size_t)t * D_MODEL + lane * 16;
#pragma unroll
        for (int q4 = 0; q4 < 4; ++q4) { const f32x4 g0 = *(const f32x4*)(g + lane * 16 + 4 * q4), b0 = *(const f32x4*)(bt + lane * 16 + 4 * q4); f32x4 o;
#pragma unroll
            for (int i = 0; i < 4; ++i) o[i] = z[4 * q4 + i] * rstd * g0[i] + b0[i];
            *(f32x4*)(op + 4 * q4) = o; }
    }
}
constexpr int PROJ_LD = 5632;
constexpr int PC_Q = 0, PC_K = 512, PC_V = 1024, PC_R = 2048, PC_G = 3072, PC_Z = 3088, PC_XBC = 4112, PC_DT = 5392;
struct MixBufs { const bf16* proj; const float* glow; const float* dtraw; bf16* gS; float* gdec; bf16* sS; float* sdec; bf16* oy; int nbatch; };

DI float log_sigmoid_f(float z) { return fminf(z, 0.f) - __logf(1.0f + __expf(-fabsf(z))); }
DI float silu_f(float x) { return x * __builtin_amdgcn_rcpf(1.0f + __expf(-x)); }
DI float bf2f(bf16 v) { return __uint_as_float((unsigned)v << 16); }
DI bf16 f2bf16(float f) { return (bf16)(cvt2(f, 0.f) & 0xffffu); }

DI void gla_gate(LAS unsigned char* lds, const float* glow_rows, const float* wg2, const float* bg, int h, int tid, float (&b)[16], float& blast) {
    LAS float* gl = (LAS float*)lds; LAS float* tot = (LAS float*)(lds + 4096);
    gl[tid] = glow_rows[tid]; gl[tid + 512] = glow_rows[tid + 512];
    const int d = tid & 127, tb = tid >> 7;
    float wc[16];
#pragma unroll
    for (int r = 0; r < 16; ++r) wc[r] = wg2[r * 512 + h * 128 + d];
    const float bgv = bg[h * 128 + d];
    WG_SYNC();
    float run = 0.f;
#pragma unroll
    for (int i = 0; i < 16; ++i) { const LAS float* g = gl + (tb * 16 + i) * 16; float z = bgv;
#pragma unroll
        for (int r = 0; r < 16; ++r) z += g[r] * wc[r];
        run += log_sigmoid_f(z) * 0.0625f; b[i] = run; }
    tot[tb * 128 + d] = run;
    WG_SYNC();
    const float t0 = tot[d], t1 = tot[128 + d], t2 = tot[256 + d], t3 = tot[384 + d];
    const float off = tb == 0 ? 0.f : tb == 1 ? t0 : tb == 2 ? t0 + t1 : t0 + t1 + t2;
    blast = (t0 + t1) + (t2 + t3);
#pragma unroll
    for (int i = 0; i < 16; ++i) b[i] += off;
}

DI void gla_gate_pre(LAS unsigned char* lds, const float (&wc)[16], float bgv, int tid, float (&b)[16], float& blast) {
    LAS float* gl = (LAS float*)lds; LAS float* tot = (LAS float*)(lds + 4096);
    const int d = tid & 127, tb = tid >> 7;
    float run = 0.f;
#pragma unroll
    for (int i = 0; i < 16; ++i) { const LAS float* g = gl + (tb * 16 + i) * 16; float z = bgv;
#pragma unroll
        for (int r = 0; r < 16; ++r) z += g[r] * wc[r];
        run += log_sigmoid_f(z) * 0.0625f; b[i] = run; }
    tot[tb * 128 + d] = run;
    WG_SYNC();
    const float t0 = tot[d], t1 = tot[128 + d], t2 = tot[256 + d], t3 = tot[384 + d];
    const float off = tb == 0 ? 0.f : tb == 1 ? t0 : tb == 2 ? t0 + t1 : t0 + t1 + t2;
    blast = (t0 + t1) + (t2 + t3);
#pragma unroll
    for (int i = 0; i < 16; ++i) b[i] += off;
}

constexpr int GA_KH = 8192, GA_KHP = 320, GA_V = GA_KH + 64 * GA_KHP, GA_VP = 576, GA_ST = GA_V + 64 * GA_VP, GA_STP = 272;
static_assert(GA_ST + 256 * GA_STP <= 152 * 1024, "GLA-A LDS");
DI void gla_a_phase(LAS unsigned char* lds, const MixBufs& mb, const float* wg2, const float* bg, int G, int bx, int tid) {
    using namespace cfg;
    const int wave = tid >> 6;
    const int nitem = mb.nbatch * GLA_HEADS * (SEQ / 64);
    for (int it = bx; it < nitem; it += G) {
        int lane = tid & 63; asm volatile("" : "+v"(lane));
        const int i16 = lane & 15, gi = (lane >> 4) & 1, hh = lane >> 5;
        const int bh = it / (SEQ / 64), c = it % (SEQ / 64), bl = bh / GLA_HEADS, h = bh % GLA_HEADS;
        const size_t row0 = (size_t)bl * SEQ + (size_t)c * 64;
        const bf16* prow = mb.proj + row0 * PROJ_LD;
        const int d = tid & 127, tb = tid >> 7;
        const float g0 = mb.glow[row0 * 16 + tid], g1 = mb.glow[row0 * 16 + tid + 512];
        float wc[16];
#pragma unroll
        for (int r = 0; r < 16; ++r) wc[r] = wg2[r * 512 + h * 128 + d];
        const float bgv = bg[h * 128 + d];
        u32x4 kraw[2], vraw[4];
#pragma unroll
        for (int j = 0; j < 2; ++j) { const int id = tid + 512 * j, t = id >> 4, ch = id & 15; kraw[j] = *(const u32x4*)(prow + (size_t)t * PROJ_LD + PC_K + h * 128 + ch * 8); }
#pragma unroll
        for (int j = 0; j < 4; ++j) { const int id = tid + 512 * j, t = id >> 5, ch = id & 31; vraw[j] = *(const u32x4*)(prow + (size_t)t * PROJ_LD + PC_V + h * 256 + ch * 8); }
        ((LAS float*)lds)[tid] = g0; ((LAS float*)lds)[tid + 512] = g1;
#pragma unroll
        for (int j = 0; j < 2; ++j) { const int id = tid + 512 * j, t = id >> 4, ch = id & 15; *(LAS u32x4*)(lds + GA_KH + t * GA_KHP + ch * 16) = kraw[j]; }
#pragma unroll
        for (int j = 0; j < 4; ++j) { const int id = tid + 512 * j, t = id >> 5, ch = id & 31; *(LAS u32x4*)(lds + GA_V + t * GA_VP + ch * 16) = vraw[j]; }
        WG_SYNC();
        float b[16], blast;
        gla_gate_pre(lds, wc, bgv, tid, b, blast);
#pragma unroll
        for (int i = 0; i < 16; ++i) { const int t = tb * 16 + i; LAS bf16* kp = (LAS bf16*)(lds + GA_KH + t * GA_KHP + d * 2); *kp = f2bf16(bf2f(*kp) * __expf(blast - b[i])); }
        if (tb == 0) mb.gdec[((size_t)bh * (SEQ / 64) + c) * 128 + d] = __expf(blast);
        WG_SYNC();
        const int dtile = wave & 3, eq = wave >> 2;
        f32x16 acc[4];
#pragma unroll
        for (int j = 0; j < 4; ++j)
#pragma unroll
            for (int i = 0; i < 16; ++i) acc[j][i] = 0.f;
        const LAS unsigned char* ka = lds + GA_KH + (8 * hh + (i16 >> 2)) * GA_KHP + (dtile * 32 + 16 * gi + 4 * (i16 & 3)) * 2;
        const LAS unsigned char* va = lds + GA_V + (8 * hh + (i16 >> 2)) * GA_VP + (eq * 128 + 16 * gi + 4 * (i16 & 3)) * 2;
#pragma unroll
        for (int s = 0; s < 4; ++s) {
            const bf16x8 af = cat8(tr_read(ka + 16 * s * GA_KHP), tr_read(ka + (16 * s + 4) * GA_KHP));
#pragma unroll
            for (int j = 0; j < 4; ++j) { const bf16x8 bfr = cat8(tr_read(va + 16 * s * GA_VP + j * 64), tr_read(va + (16 * s + 4) * GA_VP + j * 64)); acc[j] = MFMA32(af, bfr, acc[j]); }
        }
#pragma unroll
        for (int j = 0; j < 4; ++j)
#pragma unroll
            for (int r4 = 0; r4 < 4; ++r4) { u32x2 w; w.x = cvt2(acc[j][4 * r4], acc[j][4 * r4 + 1]); w.y = cvt2(acc[j][4 * r4 + 2], acc[j][4 * r4 + 3]);
                *(LAS u32x2*)(lds + GA_ST + ((eq * 4 + j) * 32 + (lane & 31)) * GA_STP + (dtile * 32 + 8 * r4 + 4 * hh) * 2) = w; }
        WG_SYNC();
        bf16* so = mb.gS + ((size_t)bh * (SEQ / 64) + c) * (256 * 128);
#pragma unroll
        for (int j = 0; j < 8; ++j) { const int id = tid + 512 * j, e = id >> 4, ch = id & 15;
            *(u32x4*)(so + e * 128 + ch * 8) = *(const LAS u32x4*)(lds + GA_ST + e * GA_STP + ch * 16); }
        WG_SYNC();
    }
}

DI void scan_b_phase(const MixBufs& mb, long gtid, long nthr) {
    using namespace cfg;
    const long ngla = (long)mb.nbatch * GLA_HEADS * 256 * 16, nssd = (long)mb.nbatch * SSD_HEADS * 64 * 8;
    for (long i = gtid; i < ngla + nssd; i += nthr) {
        const bool isg = i < ngla;
        bf16* sp; const float* dp; size_t cstride; int dstride;
        if (isg) { const int dg = (int)(i & 15), e = (int)((i >> 4) & 255), bh = (int)(i >> 12); sp = mb.gS + (size_t)bh * (SEQ / 64) * (256 * 128) + e * 128 + dg * 8; dp = mb.gdec + (size_t)bh * (SEQ / 64) * 128 + dg * 8; cstride = 256 * 128; dstride = 128; }
        else { const long j = i - ngla; const int ng = (int)(j & 7), p = (int)((j >> 3) & 63), bh = (int)(j >> 9); sp = mb.sS + (size_t)bh * (SEQ / 64) * 4096 + p * 64 + ng * 8; dp = mb.sdec + (size_t)bh * (SEQ / 64); cstride = 4096; dstride = 1; }
        float st[8];
#pragma unroll
        for (int k = 0; k < 8; ++k) st[k] = 0.f;
        for (int c0 = 0; c0 < SEQ / 64; c0 += 16) {
            u32x4 kv[16];
#pragma unroll
            for (int u = 0; u < 16; ++u) kv[u] = *(const u32x4*)(sp + (size_t)(c0 + u) * cstride);
#pragma unroll
            for (int u4 = 0; u4 < 16; u4 += 4) {
                f32x4 d0[4], d1[4];
#pragma unroll
                for (int u = 0; u < 4; ++u) { if (isg) { d0[u] = *(const f32x4*)(dp + (c0 + u4 + u) * dstride); d1[u] = *(const f32x4*)(dp + (c0 + u4 + u) * dstride + 4); } else { const float dc = dp[c0 + u4 + u]; d0[u] = (f32x4){dc, dc, dc, dc}; d1[u] = d0[u]; } }
#pragma unroll
                for (int u = 0; u < 4; ++u) { const u32x4 k4 = kv[u4 + u];
                    u32x4 o; o.x = cvt2(st[0], st[1]); o.y = cvt2(st[2], st[3]); o.z = cvt2(st[4], st[5]); o.w = cvt2(st[6], st[7]);
                    *(u32x4*)(sp + (size_t)(c0 + u4 + u) * cstride) = o;
                    st[0] = d0[u][0] * st[0] + bf_lo(k4.x); st[1] = d0[u][1] * st[1] + bf_hi(k4.x); st[2] = d0[u][2] * st[2] + bf_lo(k4.y); st[3] = d0[u][3] * st[3] + bf_hi(k4.y);
                    st[4] = d1[u][0] * st[4] + bf_lo(k4.z); st[5] = d1[u][1] * st[5] + bf_hi(k4.z); st[6] = d1[u][2] * st[6] + bf_lo(k4.w); st[7] = d1[u][3] * st[7] + bf_hi(k4.w); }
            }
        }
    }
}

constexpr int GC_SSQ = 6144, GC_QT = 8192, GC_QKP = 272, GC_KT = GC_QT + 64 * GC_QKP, GC_V = GC_KT + 64 * GC_QKP, GC_VP = 576, GC_P = GC_V + 64 * GC_VP, GC_PP = 144, GC_O = GC_P + 64 * GC_PP, GC_OP = 528;
static_assert(GC_O + 64 * GC_OP <= 152 * 1024, "GLA-C LDS");
DI void gla_c_phase(LAS unsigned char* lds, const MixBufs& mb, const float* wg2, const float* bg, const float* norm_g, int G, int bx, int tid) {
    using namespace cfg;
    const int wave = tid >> 6;
    const int nitem = mb.nbatch * GLA_HEADS * (SEQ / 64);
    for (int it = bx; it < nitem; it += G) {
        int lane = tid & 63; asm volatile("" : "+v"(lane));
        const int i16 = lane & 15, gi = (lane >> 4) & 1, hh = lane >> 5, l31 = lane & 31;
        const int bh = it / (SEQ / 64), c = it % (SEQ / 64), bl = bh / GLA_HEADS, h = bh % GLA_HEADS;
        const size_t row0 = (size_t)bl * SEQ + (size_t)c * 64;
        const bf16* prow = mb.proj + row0 * PROJ_LD;
        const int d = tid & 127, tb = tid >> 7;
        const float g0 = mb.glow[row0 * 16 + tid], g1 = mb.glow[row0 * 16 + tid + 512];
        float wc[16];
#pragma unroll
        for (int r = 0; r < 16; ++r) wc[r] = wg2[r * 512 + h * 128 + d];
        const float bgv = bg[h * 128 + d];
        u32x4 qraw[2], kraw[2], vraw[4], rraw[4]; bf16x8 sfr[8];
#pragma unroll
        for (int j = 0; j < 2; ++j) { const int id = tid + 512 * j, t = id >> 4, ch = id & 15; const bf16* pr = prow + (size_t)t * PROJ_LD + h * 128 + ch * 8; qraw[j] = *(const u32x4*)(pr + PC_Q); kraw[j] = *(const u32x4*)(pr + PC_K); }
#pragma unroll
        for (int j = 0; j < 4; ++j) { const int id = tid + 512 * j, t = id >> 5, ch = id & 31; vraw[j] = *(const u32x4*)(prow + (size_t)t * PROJ_LD + PC_V + h * 256 + ch * 8); }
        { const bf16* sin = mb.gS + (((size_t)bh * (SEQ / 64) + c) * 256 + wave * 32 + l31) * 128 + 8 * hh;
#pragma unroll
          for (int ks = 0; ks < 8; ++ks) sfr[ks] = *(const bf16x8*)(sin + 16 * ks); }
#pragma unroll
        for (int j = 0; j < 4; ++j) { const int id = tid + 512 * j, t = id >> 5, ch = id & 31; rraw[j] = *(const u32x4*)(prow + (size_t)t * PROJ_LD + PC_R + h * 256 + ch * 8); }
        ((LAS float*)lds)[tid] = g0; ((LAS float*)lds)[tid + 512] = g1;
#pragma unroll
        for (int j = 0; j < 2; ++j) { const int id = tid + 512 * j, t = id >> 4, ch = id & 15; *(LAS u32x4*)(lds + GC_QT + t * GC_QKP + ch * 16) = qraw[j]; *(LAS u32x4*)(lds + GC_KT + t * GC_QKP + ch * 16) = kraw[j]; }
#pragma unroll
        for (int j = 0; j < 4; ++j) { const int id = tid + 512 * j, t = id >> 5, ch = id & 31; *(LAS u32x4*)(lds + GC_V + t * GC_VP + ch * 16) = vraw[j]; }
        WG_SYNC();
        float b[16], blast;
        gla_gate_pre(lds, wc, bgv, tid, b, blast);
#pragma unroll
        for (int i = 0; i < 16; ++i) { const int t = tb * 16 + i; LAS bf16* qp = (LAS bf16*)(lds + GC_QT + t * GC_QKP + d * 2); LAS bf16* kp = (LAS bf16*)(lds + GC_KT + t * GC_QKP + d * 2);
            *qp = f2bf16(bf2f(*qp) * 0.08838834764831845f * __expf(b[i])); *kp = f2bf16(bf2f(*kp) * __expf(-b[i])); }
        WG_SYNC();
        if (wave < 3) {
            const int st = wave == 2 ? 1 : 0, tt = wave == 0 ? 0 : 1;
            f32x16 p;
#pragma unroll
            for (int i = 0; i < 16; ++i) p[i] = 0.f;
#pragma unroll
            for (int ks = 0; ks < 8; ++ks) { const bf16x8 af = *(const LAS bf16x8*)(lds + GC_KT + (st * 32 + l31) * GC_QKP + (16 * ks + 8 * hh) * 2);
                const bf16x8 bfr = *(const LAS bf16x8*)(lds + GC_QT + (tt * 32 + l31) * GC_QKP + (16 * ks + 8 * hh) * 2); p = MFMA32(af, bfr, p); }
            const int t = tt * 32 + l31;
#pragma unroll
            for (int r4 = 0; r4 < 4; ++r4) { const int s0 = st * 32 + 8 * r4 + 4 * hh; u32x2 w;
                w.x = cvt2(s0 <= t ? p[4 * r4] : 0.f, s0 + 1 <= t ? p[4 * r4 + 1] : 0.f); w.y = cvt2(s0 + 2 <= t ? p[4 * r4 + 2] : 0.f, s0 + 3 <= t ? p[4 * r4 + 3] : 0.f);
                *(LAS u32x2*)(lds + GC_P + t * GC_PP + s0 * 2) = w; }
        }
        WG_SYNC();
        f32x16 o[2];
#pragma unroll
        for (int tt = 0; tt < 2; ++tt)
#pragma unroll
            for (int i = 0; i < 16; ++i) o[tt][i] = 0.f;
        const LAS unsigned char* va = lds + GC_V + (8 * hh + (i16 >> 2)) * GC_VP + (wave * 32 + 16 * gi + 4 * (i16 & 3)) * 2;
#pragma unroll
        for (int ks = 0; ks < 4; ++ks) {
            const bf16x8 af = cat8(tr_read(va + 16 * ks * GC_VP), tr_read(va + (16 * ks + 4) * GC_VP));
            if (ks < 2) { const bf16x8 b0 = *(const LAS bf16x8*)(lds + GC_P + l31 * GC_PP + (16 * ks + 8 * hh) * 2); o[0] = MFMA32(af, b0, o[0]); }
            const bf16x8 b1 = *(const LAS bf16x8*)(lds + GC_P + (32 + l31) * GC_PP + (16 * ks + 8 * hh) * 2); o[1] = MFMA32(af, b1, o[1]);
        }
#pragma unroll
        for (int ks = 0; ks < 8; ++ks) { const bf16x8 af = sfr[ks];
#pragma unroll
            for (int tt = 0; tt < 2; ++tt) { const bf16x8 bfr = *(const LAS bf16x8*)(lds + GC_QT + (tt * 32 + l31) * GC_QKP + (16 * ks + 8 * hh) * 2); o[tt] = MFMA32(af, bfr, o[tt]); } }
#pragma unroll
        for (int tt = 0; tt < 2; ++tt) { float q = 0.f;
#pragma unroll
            for (int i = 0; i < 16; ++i) q += o[tt][i] * o[tt][i];
            q += __shfl_xor(q, 32);
            if (hh == 0) ((LAS float*)(lds + GC_SSQ))[wave * 64 + tt * 32 + l31] = q;
#pragma unroll
            for (int r4 = 0; r4 < 4; ++r4) { u32x2 w; w.x = cvt2(o[tt][4 * r4], o[tt][4 * r4 + 1]); w.y = cvt2(o[tt][4 * r4 + 2], o[tt][4 * r4 + 3]);
                *(LAS u32x2*)(lds + GC_O + (tt * 32 + l31) * GC_OP + (wave * 32 + 8 * r4 + 4 * hh) * 2) = w; } }
        WG_SYNC();
#pragma unroll
        for (int j = 0; j < 4; ++j) { const int id = tid + 512 * j, t = id >> 5, ch = id & 31;
            const LAS float* sq = (const LAS float*)(lds + GC_SSQ) + t; float ss = 0.f;
#pragma unroll
            for (int w = 0; w < 8; ++w) ss += sq[w * 64];
            const float rs = __builtin_amdgcn_rsqf(ss * (1.0f / 256.0f) + RMS_EPS);
            const u32x4 ov = *(const LAS u32x4*)(lds + GC_O + t * GC_OP + ch * 16);
            const u32x4 rv = rraw[j];
            const f32x4 g0 = *(const f32x4*)(norm_g + ch * 8), g1 = *(const f32x4*)(norm_g + ch * 8 + 4);
            u32x4 w;
            w.x = cvt2(bf_lo(ov.x) * rs * g0[0] * silu_f(bf_lo(rv.x)), bf_hi(ov.x) * rs * g0[1] * silu_f(bf_hi(rv.x)));
            w.y = cvt2(bf_lo(ov.y) * rs * g0[2] * silu_f(bf_lo(rv.y)), bf_hi(ov.y) * rs * g0[3] * silu_f(bf_hi(rv.y)));
            w.z = cvt2(bf_lo(ov.z) * rs * g1[0] * silu_f(bf_lo(rv.z)), bf_hi(ov.z) * rs * g1[1] * silu_f(bf_hi(rv.z)));
            w.w = cvt2(bf_lo(ov.w) * rs * g1[2] * silu_f(bf_lo(rv.w)), bf_hi(ov.w) * rs * g1[3] * silu_f(bf_hi(rv.w)));
            *(u32x4*)(mb.oy + (row0 + t) * D_MIX + h * 256 + ch * 8) = w; }
        WG_SYNC();
    }
}

constexpr int SD_DT = 0, SD_AC = 2048, SD_XS = 4096, SD_XP = 1088, SD_BM = SD_XS + 64 * SD_XP, SD_BP_TR = 192, SD_BP = 144, SD_CM = SD_BM + 64 * SD_BP_TR, SD_CW = SD_CM + 64 * SD_BP, SD_YP = 1040, SD_STP = 144;
static_assert(SD_CW + 5 * 640 * 4 <= 159 * 1024 && SD_XS + 64 * SD_YP <= SD_CW && SD_XS + 512 * SD_STP <= SD_CW, "SSD LDS");
DI float ssd_dt_scan(LAS unsigned char* lds, float dtraw_v, const float* dt_bias, const float* a_log, int g, int wave, int lane) {
    const int hd = g * 8 + wave;
    const float x = dtraw_v + dt_bias[hd];
    const float dtv = x > 0.f ? x + __logf(1.0f + __expf(-x)) : __logf(1.0f + __expf(x));
    float a = dtv * -__expf(a_log[hd]);
#pragma unroll
    for (int o = 1; o < 64; o <<= 1) { const float v = __shfl_up(a, o); if (lane >= o) a += v; }
    ((LAS float*)(lds + SD_DT))[lane * 8 + wave] = dtv; ((LAS float*)(lds + SD_AC))[lane * 8 + wave] = a;
    return __shfl(a, 63);
}
DI int ssd_xch(int g, int oc) { return oc < 64 ? g * 512 + oc * 8 : oc < 72 ? 1024 + g * 64 + (oc - 64) * 8 : 1152 + g * 64 + (oc - 72) * 8; }
DI void ssd_stage_cw(LAS unsigned char* lds, const float* cw, const float* cb, int g, int tid) {
    for (int i = tid; i < 5 * 640; i += NTHR) { const int k = i / 640, j = i % 640, xch = ssd_xch(g, j >> 3) + (j & 7);
        ((LAS float*)(lds + SD_CW))[i] = k < 4 ? cw[k * cfg::SSD_CONV_DIM + xch] : cb[xch]; }
}
template <int NT> DI void ssd_conv_load(u32x4 (&xin)[NT + 3], const bf16* prow, int g, int c, int oc, int t0) {
    const int xch = ssd_xch(g, oc);
#pragma unroll
    for (int i = 0; i < NT + 3; ++i) { const int t = t0 - 3 + i; xin[i] = (c == 0 && t < 0) ? (u32x4){0u, 0u, 0u, 0u} : *(const u32x4*)(prow + (long)t * PROJ_LD + PC_XBC + xch); }
}
template <int MODE, int NT> DI void ssd_conv_compute(LAS unsigned char* lds, const u32x4 (&xin)[NT + 3], int oc, int t0) {
    const LAS float* wl = (const LAS float*)(lds + SD_CW) + oc * 8;
    float w[4][8], bias[8];
#pragma unroll
    for (int k = 0; k < 4; ++k) { const f32x4 a = *(const LAS f32x4*)(wl + k * 640), b = *(const LAS f32x4*)(wl + k * 640 + 4);
        w[k][0] = a[0]; w[k][1] = a[1]; w[k][2] = a[2]; w[k][3] = a[3]; w[k][4] = b[0]; w[k][5] = b[1]; w[k][6] = b[2]; w[k][7] = b[3]; }
    { const f32x4 a = *(const LAS f32x4*)(wl + 4 * 640), b = *(const LAS f32x4*)(wl + 4 * 640 + 4); bias[0] = a[0]; bias[1] = a[1]; bias[2] = a[2]; bias[3] = a[3]; bias[4] = b[0]; bias[5] = b[1]; bias[6] = b[2]; bias[7] = b[3]; }
#pragma unroll
    for (int i = 0; i < NT; ++i) {
        float y[8];
#pragma unroll
        for (int j = 0; j < 8; ++j) y[j] = bias[j];
#pragma unroll
        for (int k = 0; k < 4; ++k) { const u32x4 v = xin[i + k];
            y[0] += w[k][0] * bf_lo(v.x); y[1] += w[k][1] * bf_hi(v.x); y[2] += w[k][2] * bf_lo(v.y); y[3] += w[k][3] * bf_hi(v.y);
            y[4] += w[k][4] * bf_lo(v.z); y[5] += w[k][5] * bf_hi(v.z); y[6] += w[k][6] * bf_lo(v.w); y[7] += w[k][7] * bf_hi(v.w); }
        const int t = t0 + i; float sc = 1.f;
        if (MODE == 0 && oc < 64) sc = ((const LAS float*)(lds + SD_DT))[t * 8 + (oc >> 3)];
#pragma unroll
        for (int j = 0; j < 8; ++j) y[j] = silu_f(y[j]) * sc;
        u32x4 o; o.x = cvt2(y[0], y[1]); o.y = cvt2(y[2], y[3]); o.z = cvt2(y[4], y[5]); o.w = cvt2(y[6], y[7]);
        if (oc < 64) *(LAS u32x4*)(lds + SD_XS + t * SD_XP + oc * 16) = o;
        else if (oc < 72) *(LAS u32x4*)(lds + SD_BM + t * (MODE == 0 ? SD_BP_TR : SD_BP) + (oc - 64) * 16) = o;
        else *(LAS u32x4*)(lds + SD_CM + t * SD_BP + (oc - 72) * 16) = o;
    }
}
DI void ssd_a_phase(LAS unsigned char* lds, const MixBufs& mb, const float* cw, const float* cb, const float* dt_bias, const float* a_log, int G, int bx, int tid) {
    using namespace cfg;
    const int wave = tid >> 6;
    const int nitem = mb.nbatch * SSD_GROUPS * (SEQ / 64);
    int gstaged = -1;
    for (int it = bx; it < nitem; it += G) {
        int lane = tid & 63; asm volatile("" : "+v"(lane));
        const int i16 = lane & 15, gi = (lane >> 4) & 1, hh = lane >> 5, l31 = lane & 31;
        const int bg = it / (SEQ / 64), c = it % (SEQ / 64), bl = bg / SSD_GROUPS, g = bg % SSD_GROUPS;
        const size_t row0 = (size_t)bl * SEQ + (size_t)c * 64;
        const bf16* prow = mb.proj + row0 * PROJ_LD;
        const float dtraw_v = mb.dtraw[row0 * 16 + lane * 16 + g * 8 + wave];
        u32x4 xin0[11], xin1[4];
        ssd_conv_load<8>(xin0, prow, g, c, tid & 63, (tid >> 6) * 8);
        ssd_conv_load<1>(xin1, prow, g, c, 64 + (tid & 7), tid >> 3);
        if (g != gstaged) { ssd_stage_cw(lds, cw, cb, g, tid); gstaged = g; }
        const float alast = ssd_dt_scan(lds, dtraw_v, dt_bias, a_log, g, wave, lane);
        { LAS float* dtp = (LAS float*)(lds + SD_DT) + lane * 8 + wave; const float ac = ((LAS float*)(lds + SD_AC))[lane * 8 + wave]; *dtp = *dtp * __expf(alast - ac); }
        if (lane == 0) mb.sdec[((size_t)bl * SSD_HEADS + g * 8 + wave) * (SEQ / 64) + c] = __expf(alast);
        WG_SYNC();
        ssd_conv_compute<0, 8>(lds, xin0, tid & 63, (tid >> 6) * 8);
        ssd_conv_compute<0, 1>(lds, xin1, 64 + (tid & 7), tid >> 3);
        WG_SYNC();
        f32x16 acc[2][2];
#pragma unroll
        for (int a = 0; a < 2; ++a)
#pragma unroll
            for (int b = 0; b < 2; ++b)
#pragma unroll
                for (int i = 0; i < 16; ++i) acc[a][b][i] = 0.f;
        const LAS unsigned char* ba = lds + SD_BM + (8 * hh + (i16 >> 2)) * SD_BP_TR + (16 * gi + 4 * (i16 & 3)) * 2;
        const LAS unsigned char* xa = lds + SD_XS + (8 * hh + (i16 >> 2)) * SD_XP + (wave * 64 + 16 * gi + 4 * (i16 & 3)) * 2;
#pragma unroll
        for (int s = 0; s < 4; ++s) {
            bf16x8 af[2], bfr[2];
#pragma unroll
            for (int nt = 0; nt < 2; ++nt) af[nt] = cat8(tr_read(ba + 16 * s * SD_BP_TR + nt * 64), tr_read(ba + (16 * s + 4) * SD_BP_TR + nt * 64));
#pragma unroll
            for (int pt = 0; pt < 2; ++pt) bfr[pt] = cat8(tr_read(xa + 16 * s * SD_XP + pt * 64), tr_read(xa + (16 * s + 4) * SD_XP + pt * 64));
#pragma unroll
            for (int nt = 0; nt < 2; ++nt)
#pragma unroll
                for (int pt = 0; pt < 2; ++pt) acc[nt][pt] = MFMA32(af[nt], bfr[pt], acc[nt][pt]);
        }
        WG_SYNC();
#pragma unroll
        for (int nt = 0; nt < 2; ++nt)
#pragma unroll
            for (int pt = 0; pt < 2; ++pt)
#pragma unroll
                for (int r4 = 0; r4 < 4; ++r4) { u32x2 w; w.x = cvt2(acc[nt][pt][4 * r4], acc[nt][pt][4 * r4 + 1]); w.y = cvt2(acc[nt][pt][4 * r4 + 2], acc[nt][pt][4 * r4 + 3]);
                    *(LAS u32x2*)(lds + SD_XS + (wave * 64 + pt * 32 + l31) * SD_STP + (nt * 32 + 8 * r4 + 4 * hh) * 2) = w; }
        WG_SYNC();
#pragma unroll
        for (int j = 0; j < 8; ++j) { const int id = tid + 512 * j, hd = id >> 9, p = (id >> 3) & 63, ch = id & 7;
            *(u32x4*)(mb.sS + ((((size_t)bl * SSD_HEADS + g * 8 + hd) * (SEQ / 64) + c) * 64 + p) * 64 + ch * 8) = *(const LAS u32x4*)(lds + SD_XS + (hd * 64 + p) * SD_STP + ch * 16); }
        WG_SYNC();
    }
}
DI void ssd_c_phase(LAS unsigned char* lds, const MixBufs& mb, const float* cw, const float* cb, const float* dt_bias, const float* a_log, const float* dskip, const float* norm_g, int G, int bx, int tid) {
    using namespace cfg;
    const int wave = tid >> 6;
    const int nitem = mb.nbatch * SSD_GROUPS * (SEQ / 64);
    int gstaged = -1;
    for (int it = bx; it < nitem; it += G) {
        int lane = tid & 63; asm volatile("" : "+v"(lane));
        const int i16 = lane & 15, gi = (lane >> 4) & 1, hh = lane >> 5, l31 = lane & 31;
        const int bg = it / (SEQ / 64), c = it % (SEQ / 64), bl = bg / SSD_GROUPS, g = bg % SSD_GROUPS, hd = g * 8 + wave;
        const size_t row0 = (size_t)bl * SEQ + (size_t)c * 64;
        const bf16* prow = mb.proj + row0 * PROJ_LD;
        const float dtraw_v = mb.dtraw[row0 * 16 + lane * 16 + g * 8 + wave];
        u32x4 xin0[11], xin1[4], xin2[4];
        ssd_conv_load<8>(xin0, prow, g, c, tid & 63, (tid >> 6) * 8);
        ssd_conv_load<1>(xin1, prow, g, c, 64 + (tid & 15), tid >> 4);
        ssd_conv_load<1>(xin2, prow, g, c, 64 + (tid & 15), 32 + (tid >> 4));
        if (g != gstaged) { ssd_stage_cw(lds, cw, cb, g, tid); gstaged = g; WG_SYNC(); }
        (void)ssd_dt_scan(lds, dtraw_v, dt_bias, a_log, g, wave, lane);
#ifndef SUBREP
#define SUBREP 0
#endif
        for (int rep_ = 0; rep_ < (SUBREP == 1 ? 2 : 1); ++rep_) { int tz = tid; asm volatile("" : "+v"(tz) :: "memory");
        ssd_conv_compute<1, 8>(lds, xin0, tz & 63, (tz >> 6) * 8);
        ssd_conv_compute<1, 1>(lds, xin1, 64 + (tz & 15), tz >> 4);
        ssd_conv_compute<1, 1>(lds, xin2, 64 + (tz & 15), 32 + (tz >> 4)); }
        bf16x8 hfr[2][4];
        { const bf16* hin = mb.sS + ((((size_t)bl * SSD_HEADS + hd) * (SEQ / 64) + c) * 64 + l31) * 64 + 8 * hh;
#pragma unroll
          for (int pt = 0; pt < 2; ++pt)
#pragma unroll
              for (int ks = 0; ks < 4; ++ks) hfr[pt][ks] = *(const bf16x8*)(hin + pt * 32 * 64 + 16 * ks); }
        WG_SYNC();
        const LAS float* dtl = (const LAS float*)(lds + SD_DT); const LAS float* acl = (const LAS float*)(lds + SD_AC);
        f32x16 yd[2][2];
        for (int rep_ = 0; rep_ < (SUBREP == 2 ? 2 : 1); ++rep_) { asm volatile("" : "+v"(lane) :: "memory");
        f32x16 gt[3];
#pragma unroll
        for (int q = 0; q < 3; ++q) { const int st = q == 2 ? 1 : 0, tt = q == 0 ? 0 : 1;
#pragma unroll
            for (int i = 0; i < 16; ++i) gt[q][i] = 0.f;
#pragma unroll
            for (int ks = 0; ks < 4; ++ks) { const bf16x8 af = *(const LAS bf16x8*)(lds + SD_BM + (st * 32 + l31) * SD_BP + (16 * ks + 8 * hh) * 2);
                const bf16x8 bfr = *(const LAS bf16x8*)(lds + SD_CM + (tt * 32 + l31) * SD_BP + (16 * ks + 8 * hh) * 2); gt[q] = MFMA32(af, bfr, gt[q]); } }
        bf16x8 mf[3][2];
#pragma unroll
        for (int q = 0; q < 3; ++q) { const int st = q == 2 ? 1 : 0, tt = q == 0 ? 0 : 1; const int t = tt * 32 + l31; const float at = acl[t * 8 + wave];
            float e[16];
#pragma unroll
            for (int i = 0; i < 16; ++i) { const int s = st * 32 + (i & 3) + 8 * (i >> 2) + 4 * hh; e[i] = s <= t ? gt[q][i] * __expf(at - acl[s * 8 + wave]) * dtl[s * 8 + wave] : 0.f; }
#pragma unroll
            for (int s2 = 0; s2 < 2; ++s2) { u32x4 w; w.x = cvt2(e[8 * s2], e[8 * s2 + 1]); w.y = cvt2(e[8 * s2 + 2], e[8 * s2 + 3]); w.z = cvt2(e[8 * s2 + 4], e[8 * s2 + 5]); w.w = cvt2(e[8 * s2 + 6], e[8 * s2 + 7]); mf[q][s2] = __builtin_bit_cast(bf16x8, w); } }
#pragma unroll
        for (int a = 0; a < 2; ++a)
#pragma unroll
            for (int b = 0; b < 2; ++b)
#pragma unroll
                for (int i = 0; i < 16; ++i) yd[a][b][i] = 0.f;
#pragma unroll
        for (int ks = 0; ks < 4; ++ks) { bf16x8 cf[2];
#pragma unroll
            for (int tt = 0; tt < 2; ++tt) cf[tt] = *(const LAS bf16x8*)(lds + SD_CM + (tt * 32 + l31) * SD_BP + (16 * ks + 8 * hh) * 2);
#pragma unroll
            for (int pt = 0; pt < 2; ++pt)
#pragma unroll
                for (int tt = 0; tt < 2; ++tt) yd[pt][tt] = MFMA32(hfr[pt][ks], cf[tt], yd[pt][tt]); }
#pragma unroll
        for (int tt = 0; tt < 2; ++tt) { const float ea = __expf(acl[(tt * 32 + l31) * 8 + wave]);
#pragma unroll
            for (int pt = 0; pt < 2; ++pt)
#pragma unroll
                for (int i = 0; i < 16; ++i) yd[pt][tt][i] *= ea; }
        const LAS unsigned char* xa = lds + SD_XS + (4 * hh + (i16 >> 2)) * SD_XP + (wave * 64 + 16 * gi + 4 * (i16 & 3)) * 2;
#pragma unroll
        for (int pt = 0; pt < 2; ++pt)
#pragma unroll
            for (int st = 0; st < 2; ++st)
#pragma unroll
                for (int s2 = 0; s2 < 2; ++s2) { const LAS unsigned char* a = xa + (st * 32 + 16 * s2) * SD_XP + pt * 64; const bf16x8 xf = cat8(tr_read(a), tr_read(a + 8 * SD_XP));
                    if (st == 0) { yd[pt][0] = MFMA32(xf, mf[0][s2], yd[pt][0]); yd[pt][1] = MFMA32(xf, mf[1][s2], yd[pt][1]); }
                    else yd[pt][1] = MFMA32(xf, mf[2][s2], yd[pt][1]); }
        }
        const float dsk = dskip[hd];
        u32x2 yw[2][2][4];
#pragma unroll
        for (int tt = 0; tt < 2; ++tt) { const int t = tt * 32 + l31;
#pragma unroll
            for (int pt = 0; pt < 2; ++pt)
#pragma unroll
                for (int r4 = 0; r4 < 4; ++r4) { const int p = pt * 32 + 8 * r4 + 4 * hh; const u32x2 xv = *(const LAS u32x2*)(lds + SD_XS + t * SD_XP + (wave * 64 + p) * 2);
                    const float y0 = yd[pt][tt][4 * r4] + dsk * bf_lo(xv.x), y1 = yd[pt][tt][4 * r4 + 1] + dsk * bf_hi(xv.x);
                    const float y2 = yd[pt][tt][4 * r4 + 2] + dsk * bf_lo(xv.y), y3 = yd[pt][tt][4 * r4 + 3] + dsk * bf_hi(xv.y);
                    yw[tt][pt][r4].x = cvt2(y0, y1); yw[tt][pt][r4].y = cvt2(y2, y3); } }
        u32x4 zraw[8];
#pragma unroll
        for (int j = 0; j < 8; ++j) zraw[j] = *(const u32x4*)(prow + (size_t)(tid >> 3) * PROJ_LD + PC_Z + g * 512 + (8 * j + (tid & 7)) * 8);
        WG_SYNC();
#pragma unroll
        for (int tt = 0; tt < 2; ++tt)
#pragma unroll
            for (int pt = 0; pt < 2; ++pt)
#pragma unroll
                for (int r4 = 0; r4 < 4; ++r4) *(LAS u32x2*)(lds + SD_XS + (tt * 32 + l31) * SD_YP + (wave * 64 + pt * 32 + 8 * r4 + 4 * hh) * 2) = yw[tt][pt][r4];
        WG_SYNC();
        for (int rep_ = 0; rep_ < (SUBREP == 3 ? 2 : 1); ++rep_) { int tz = tid; asm volatile("" : "+v"(tz) :: "memory"); const int t = tz >> 3, sub = tz & 7; float u[8][8]; float ss = 0.f;
#pragma unroll
            for (int j = 0; j < 8; ++j) { const int ch = 8 * j + sub; const u32x4 yv = *(const LAS u32x4*)(lds + SD_XS + t * SD_YP + ch * 16);
                const u32x4 zv = zraw[j];
                u[j][0] = bf_lo(yv.x) * silu_f(bf_lo(zv.x)); u[j][1] = bf_hi(yv.x) * silu_f(bf_hi(zv.x)); u[j][2] = bf_lo(yv.y) * silu_f(bf_lo(zv.y)); u[j][3] = bf_hi(yv.y) * silu_f(bf_hi(zv.y));
                u[j][4] = bf_lo(yv.z) * silu_f(bf_lo(zv.z)); u[j][5] = bf_hi(yv.z) * silu_f(bf_hi(zv.z)); u[j][6] = bf_lo(yv.w) * silu_f(bf_lo(zv.w)); u[j][7] = bf_hi(yv.w) * silu_f(bf_hi(zv.w));
#pragma unroll
                for (int k = 0; k < 8; ++k) ss += u[j][k] * u[j][k]; }
            ss += __shfl_xor(ss, 1); ss += __shfl_xor(ss, 2); ss += __shfl_xor(ss, 4);
            const float rs = __builtin_amdgcn_rsqf(ss * (1.0f / 512.0f) + RMS_EPS);
#pragma unroll
            for (int j = 0; j < 8; ++j) { const int ch = 8 * j + sub; const float* ng = norm_g + g * 512 + ch * 8; const f32x4 g0 = *(const f32x4*)ng, g1 = *(const f32x4*)(ng + 4);
                u32x4 w; w.x = cvt2(u[j][0] * rs * g0[0], u[j][1] * rs * g0[1]); w.y = cvt2(u[j][2] * rs * g0[2], u[j][3] * rs * g0[3]);
                w.z = cvt2(u[j][4] * rs * g1[0], u[j][5] * rs * g1[1]); w.w = cvt2(u[j][6] * rs * g1[2], u[j][7] * rs * g1[3]);
                *(u32x4*)(mb.oy + (row0 + t) * D_MIX + GLA_DV + g * 512 + ch * 8) = w; } }
        WG_SYNC();
    }
}

using namespace cfg;
constexpr int RING_OFF = 0, LDSCTL_OFF = 159 * 1024, MISC_OFF = LDSCTL_OFF + 320, LDS_BYTES = 160 * 1024;
constexpr size_t MiB = 1u << 20;
constexpr size_t WS_CTL = 0, CTL_ZERO_BYTES = 1 * MiB;
constexpr int CW_BAR = 4096;
constexpr int HB = 2, MH = HB * SEQ;
constexpr size_t WS_PROJ = 1 * MiB;
constexpr size_t WS_GS = 177 * MiB, WS_GDEC = 241 * MiB, WS_SS = 242 * MiB, WS_SDEC = 274 * MiB, WS_GLOW = 275 * MiB, WS_DTRAW = 276 * MiB;
constexpr size_t WS_H1 = 1 * MiB, WS_QA = 65 * MiB, WS_H2 = 129 * MiB, WS_PICKS = 193 * MiB;
constexpr size_t WS_ACTP = 209 * MiB, WS_WBUF = 337 * MiB, WS_EID = 345 * MiB;
constexpr int CW_PEER = 8192;
constexpr size_t WS_XB = 309 * MiB;
constexpr size_t WS_W = 376 * MiB;
constexpr int N1P = 5632;
constexpr size_t OW_IN = 0, OW_OUT = OW_IN + (size_t)N1P * 1024 * 2, OW_Q = OW_OUT + (size_t)1024 * 2048 * 2, OW_K = OW_Q + 2 * MiB, OW_V = OW_K + 2 * MiB, OW_O = OW_V + 2 * MiB, OW_PQ = OW_O + 2 * MiB, OW_END = OW_PQ + 2 * MiB;
static_assert(OW_END <= 28 * MiB, "weights region");
constexpr size_t WS_U = 404 * MiB, WS_V = 420 * MiB, WS_SU = 436 * MiB, WS_SV = 437 * MiB,
                  WS_MEMB = 468 * MiB, WS_KC = 470 * MiB, WS_VC = 472 * MiB, WS_END = 474 * MiB;

__device__ __forceinline__ void p0_transpose_item(const float* W, int K, int N, bf16* WT, LAS float* scr, int item, int lane) {
    const int nblk = N / 32, kb = item / nblk, nb = item % nblk, k0 = 64 * kb, n0 = 32 * nb;
#pragma unroll 8
    for (int i = 0; i < 32; ++i) { const int kk = 2 * i + (lane >> 5); scr[kk * 33 + (lane & 31)] = W[(size_t)(k0 + kk) * N + n0 + (lane & 31)]; }
    LDS_WAIT(); asm volatile("" ::: "memory");
    const int c = lane & 7;
#pragma unroll
    for (int j = 0; j < 4; ++j) { const int n = (lane >> 3) + 8 * j; const LAS float* s = scr + (8 * c) * 33 + n;
        v4u o; o.x = pk2(s[0 * 33], s[1 * 33]); o.y = pk2(s[2 * 33], s[3 * 33]); o.z = pk2(s[4 * 33], s[5 * 33]); o.w = pk2(s[6 * 33], s[7 * 33]);
        *(GAS v4u*)(WT + (size_t)(n0 + n) * K + k0 + 8 * c) = o; }
    LDS_WAIT(); asm volatile("" ::: "memory");
}
__device__ __forceinline__ void cvt_rows(const float* src, bf16* dst, long n, long gtid, long nthr) {
    for (long i = gtid * 8; i < n; i += nthr * 8) { const f32x4 a = *(const f32x4*)(src + i), b = *(const f32x4*)(src + i + 4);
        v4u o; o.x = cvt2(a.x, a.y); o.y = cvt2(a.z, a.w); o.z = cvt2(b.x, b.y); o.w = cvt2(b.z, b.w); *(v4u*)(dst + i) = o; }
}
__device__ __forceinline__ void cvt_rows_ld(const float* src, bf16* dst, long n, long gtid, long nthr) { cvt_rows(src, dst, n, gtid, nthr); }

struct In27 { const float* p[27]; };
struct Args { In27 in; float* out; unsigned char* ws; };

__global__ void __launch_bounds__(NTHR, 2) mega(Args args) {
    extern __shared__ __attribute__((aligned(16))) unsigned char lds_raw[];
    LAS unsigned char* lds = (LAS unsigned char*)lds_raw;
    volatile LAS unsigned* MISC = (volatile LAS unsigned*)(lds + MISC_OFF);
    const int tid = threadIdx.x, lane = tid & 63, wave = __builtin_amdgcn_readfirstlane(tid >> 6);
    const int G = gridDim.x; const int bx = blockIdx.x; const int vcu = (G % 8 == 0) ? (bx % 8) * (G / 8) + bx / 8 : bx;
    unsigned char* ws = args.ws;
    gu32* ctl = (gu32*)(ws + WS_CTL);
    for (int u = tid; u < (LDS_BYTES - LDSCTL_OFF) / 4; u += NTHR) ((LAS unsigned*)(lds + LDSCTL_OFF))[u] = 0u;
    __syncthreads();
    XcdBarrier bar = xcd_barrier_post((unsigned*)(ctl + CW_BAR), MISC + 8);
    const long nthr = (long)G * NTHR;
    const int gw = vcu * NWAVES + wave, NGW = G * NWAVES;
#define GRID_BAR() xcd_barrier(bar)
    {
        unsigned char* ws = args.ws; asm volatile("" : "+s"(ws));
        unsigned char* wbase = ws + WS_W;
        bf16* w_in_t = (bf16*)(wbase + OW_IN); bf16* w_out_t = (bf16*)(wbase + OW_OUT); bf16* wq_t = (bf16*)(wbase + OW_Q); bf16* wk_t = (bf16*)(wbase + OW_K);
        bf16* wv_t = (bf16*)(wbase + OW_V); bf16* wo_t = (bf16*)(wbase + OW_O); bf16* pwq_t = (bf16*)(wbase + OW_PQ);
        bf16* x_bf = (bf16*)(ws + WS_XB); unsigned char* u8 = ws + WS_U; unsigned char* v8 = ws + WS_V; float* su = (float*)(ws + WS_SU); float* sv = (float*)(ws + WS_SV); bf16* mem_bf = (bf16*)(ws + WS_MEMB);
        bf16* kc = (bf16*)(ws + WS_KC); bf16* vc = (bf16*)(ws + WS_VC);
        bf16* h1 = (bf16*)(ws + WS_H1); bf16* qa = (bf16*)(ws + WS_QA); bf16* h2 = (bf16*)(ws + WS_H2); unsigned* picks = (unsigned*)(ws + WS_PICKS);
        bf16* oy_all = (bf16*)args.out;
        bf16* projb = (bf16*)(ws + WS_PROJ);
        const long gtid = (long)bx * NTHR + tid;
        LAS float* scr = (LAS float*)(lds + RING_OFF + wave * 16384);
        constexpr int I_IN = (D_MODEL / 64) * (D_IN_PROJ / 32), I_OUT = (D_MIX / 64) * (D_MODEL / 32), I_SQ = (D_MODEL / 64) * (D_MODEL / 32);
        constexpr int NITEMS = I_IN + I_OUT + 5 * I_SQ;
        for (int it = gw; it < NITEMS; it += NGW) {
            int r = it; const float* W; int K = D_MODEL, N = D_MODEL; bf16* WT;
            if (r < I_IN) { W = args.in.p[2]; N = D_IN_PROJ; WT = w_in_t; }
            else if ((r -= I_IN) < I_OUT) { W = args.in.p[12]; K = D_MIX; WT = w_out_t; }
            else { r -= I_OUT; const int which = r / I_SQ; r -= which * I_SQ; const int idx = which == 0 ? 15 : which == 1 ? 16 : which == 2 ? 17 : which == 3 ? 18 : 21; W = args.in.p[idx]; WT = wq_t + (size_t)which * D_MODEL * D_MODEL; }
            p0_transpose_item(W, K, N, WT, scr, r, lane);
        }
        for (long i = gtid * 8; i < (long)(N1P - D_IN_PROJ) * D_MODEL; i += nthr * 8) *(v4u*)(w_in_t + (size_t)D_IN_PROJ * D_MODEL + i) = (v4u){0u, 0u, 0u, 0u};
        cvt_rows(args.in.p[1], mem_bf, (long)BATCH * MEM_LEN * D_MODEL, gtid, nthr);
        cvt_rows(args.in.p[0], x_bf, (long)NTOK * D_MODEL, gtid, nthr);
        GRID_BAR();
    }
#ifndef REPG
#define REPG 0
#endif
#define REPN(g) (REPG == (g) ? 2 : 1)
#define STEP_BEGIN { unsigned char* ws = args.ws; asm volatile("" : "+s"(ws));     \
        unsigned char* wbase = ws + WS_W; \
        bf16* w_in_t = (bf16*)(wbase + OW_IN); bf16* w_out_t = (bf16*)(wbase + OW_OUT); bf16* wq_t = (bf16*)(wbase + OW_Q); bf16* wk_t = (bf16*)(wbase + OW_K); \
        bf16* wv_t = (bf16*)(wbase + OW_V); bf16* wo_t = (bf16*)(wbase + OW_O); bf16* pwq_t = (bf16*)(wbase + OW_PQ); \
        bf16* x_bf = (bf16*)(ws + WS_XB); unsigned char* u8 = ws + WS_U; unsigned char* v8 = ws + WS_V; float* su = (float*)(ws + WS_SU); float* sv = (float*)(ws + WS_SV); bf16* mem_bf = (bf16*)(ws + WS_MEMB); \
        bf16* kc = (bf16*)(ws + WS_KC); bf16* vc = (bf16*)(ws + WS_VC); \
        bf16* h1 = (bf16*)(ws + WS_H1); bf16* qa = (bf16*)(ws + WS_QA); bf16* h2 = (bf16*)(ws + WS_H2); unsigned* picks = (unsigned*)(ws + WS_PICKS); bf16* eid16 = (bf16*)(ws + WS_EID); \
        bf16* oy_all = (bf16*)args.out; bf16* projb = (bf16*)(ws + WS_PROJ); \
        int tid_ = threadIdx.x; asm volatile("" : "+v"(tid_)); const long gtid = (long)bx * NTHR + tid_; \
        (void)w_in_t; (void)w_out_t; (void)wq_t; (void)wk_t; (void)wv_t; (void)wo_t; (void)pwq_t; (void)x_bf; (void)u8; (void)v8; (void)su; (void)sv; (void)mem_bf; (void)kc; (void)vc; (void)h1; (void)qa; (void)h2; (void)picks; (void)eid16; (void)oy_all; (void)projb; (void)gtid;
#define STEP_END GRID_BAR(); }
#define GEMM_STEP(SETUP) STEP_BEGIN const bf16* A; const bf16* Bt; int M = NTOK, N = D_MODEL, K = D_MODEL; pg8::EpiGen E{0, nullptr, D_MODEL, nullptr, nullptr, nullptr}; SETUP; \
        pg8::Gemm g{(const pg8::bf16_t*)A, (const pg8::bf16_t*)Bt, M, N, K}; pg8::StaticOrder S; S.init(M, N, G, bx); \
        pg8::gemm_phase<pg8::EpiGen, pg8::StaticOrder, true, true>(lds + RING_OFF, g, S, E); STEP_END
#define MIXBUFS(hf) MixBufs mb{projb, (const float*)(ws + WS_GLOW), (const float*)(ws + WS_DTRAW), (bf16*)(ws + WS_GS), (float*)(ws + WS_GDEC), (bf16*)(ws + WS_SS), (float*)(ws + WS_SDEC), oy_all + (size_t)(hf) * MH * D_MIX, HB}
#define MIX_HALF(hf) \
    for (int r_ = 0; r_ < REPN(2); ++r_) { STEP_BEGIN const bf16* A = x_bf + (size_t)(hf) * MH * D_MODEL; pg8::EpiGen E{0, projb, N1P, nullptr, (float*)(ws + WS_GLOW), (float*)(ws + WS_DTRAW)}; \
        pg8::Gemm g{(const pg8::bf16_t*)A, (const pg8::bf16_t*)w_in_t, MH, N1P, D_MODEL}; pg8::StaticOrder S; S.init(MH, N1P, G, bx); \
        pg8::gemm_phase<pg8::EpiGen, pg8::StaticOrder, true, true>(lds + RING_OFF, g, S, E); \
          \
          \
        { constexpr int NU1 = (MH / 256) * (N1P / 256), NHEAVY = NU1 % 256; static_assert(NHEAVY == 128, "filler split assumes 5.5 units per workgroup on a 256-workgroup grid"); \
          if (G == 256) { if (bx >= NHEAVY) { \
              if ((hf) == 0 && bx < NHEAVY + 32) { const int j = bx - NHEAVY; pg8::EpiGen E2{0, j < 16 ? kc : vc, D_MODEL, nullptr, nullptr, nullptr}; \
                  pg8::Gemm g2{(const pg8::bf16_t*)mem_bf, (const pg8::bf16_t*)(j < 16 ? wk_t : wv_t), BATCH * MEM_LEN, D_MODEL, D_MODEL}; pg8::OneUnit S2{(j & 15) >> 2, j & 3}; \
                  pg8::gemm_phase<pg8::EpiGen, pg8::OneUnit, true, true>(lds + RING_OFF, g2, S2, E2); } \
              else { const int first = (hf) == 0 ? NHEAVY + 32 : NHEAVY; const int wv = (bx - first) * NWAVES + (tid_ >> 6), nwv = (G - first) * NWAVES; \
                  if ((hf) == 0) cvt_fp8_rows(args.in.p[23], u8, su, PEER_EXPERTS, wv, nwv, tid_ & 63); else cvt_fp8_rows(args.in.p[24], v8, sv, PEER_EXPERTS, wv, nwv, tid_ & 63); } } } \
          else { if ((hf) == 0) { cvt_fp8_rows(args.in.p[23], u8, su, PEER_EXPERTS, gw, NGW, tid_ & 63); \
                     for (int kv_ = 0; kv_ < 2; ++kv_) { pg8::EpiGen E2{0, kv_ ? vc : kc, D_MODEL, nullptr, nullptr, nullptr}; pg8::Gemm g2{(const pg8::bf16_t*)mem_bf, (const pg8::bf16_t*)(kv_ ? wv_t : wk_t), BATCH * MEM_LEN, D_MODEL, D_MODEL}; \
                         pg8::StaticOrder S2; S2.init(BATCH * MEM_LEN, D_MODEL, G, bx); pg8::gemm_phase<pg8::EpiGen, pg8::StaticOrder, true, true>(lds + RING_OFF, g2, S2, E2); } } \
                 else cvt_fp8_rows(args.in.p[24], v8, sv, PEER_EXPERTS, gw, NGW, tid_ & 63); } } \
        STEP_END } \
    for (int r5_ = 0; r5_ < REPN(5); ++r5_) { \
    for (int r_ = 0; r_ < REPN(10); ++r_) { STEP_BEGIN MIXBUFS(hf); ssd_a_phase(lds, mb, args.in.p[6], args.in.p[7], args.in.p[8], args.in.p[9], G, bx, tid_); gla_a_phase(lds, mb, args.in.p[3], args.in.p[4], G, bx, tid_); STEP_END } \
    STEP_BEGIN MIXBUFS(hf); scan_b_phase(mb, gtid, nthr); STEP_END } \
    STEP_BEGIN MIXBUFS(hf); ssd_c_phase(lds, mb, args.in.p[6], args.in.p[7], args.in.p[8], args.in.p[9], args.in.p[10], args.in.p[11], G, bx, tid_); \
                            gla_c_phase(lds, mb, args.in.p[3], args.in.p[4], args.in.p[5], G, bx, tid_); STEP_END \
    if (REPG == 3) { STEP_BEGIN MIXBUFS(hf); gla_c_phase(lds, mb, args.in.p[3], args.in.p[4], args.in.p[5], G, bx, tid_); STEP_END } \
    if (REPG == 4) { STEP_BEGIN MIXBUFS(hf); ssd_c_phase(lds, mb, args.in.p[6], args.in.p[7], args.in.p[8], args.in.p[9], args.in.p[10], args.in.p[11], G, bx, tid_); STEP_END }

    MIX_HALF(0)
    MIX_HALF(1)
    for (int r_ = 0; r_ < REPN(6); ++r_) {
        GEMM_STEP(A = oy_all; Bt = w_out_t; K = D_MIX; E.mode = 1; E.out = h1; E.res = args.in.p[0])
        STEP_BEGIN ln_rows_bf16(h1, args.in.p[13], args.in.p[14], NTOK, gw, NGW, tid_ & 63); STEP_END }
    for (int r_ = 0; r_ < REPN(7); ++r_) {
        GEMM_STEP(A = h1; Bt = wq_t; E.out = qa)
        STEP_BEGIN attn_phase(lds, qa, kc, vc, G, bx, tid_); STEP_END }
    for (int r_ = 0; r_ < REPN(6); ++r_) {
        GEMM_STEP(A = qa; Bt = wo_t; E.mode = 2; E.out = h2; E.res = h1)
        STEP_BEGIN ln_rows_bf16(h2, args.in.p[19], args.in.p[20], NTOK, gw, NGW, tid_ & 63); STEP_END }
    for (int r_ = 0; r_ < REPN(8); ++r_) {
        GEMM_STEP(A = h2; Bt = pwq_t; E.out = qa)
        for (int r9_ = 0; r9_ < REPN(9); ++r9_) { STEP_BEGIN topk_phase(lds, qa, args.in.p[22], picks, eid16, G, bx, tid_); STEP_END } }
    for (int r_ = 0; r_ < REPN(11); ++r_) { STEP_BEGIN peer_u_phase(MISC + 16, h2, eid16, u8, (float*)(ws + WS_ACTP), ctl + CW_PEER + 2048 * r_, tid_); STEP_END }
    for (int r_ = 0; r_ < REPN(9); ++r_) { STEP_BEGIN peer_w_pass(picks, (const float*)(ws + WS_ACTP), su, sv, (bf16*)(ws + WS_WBUF), gw, NGW, tid_ & 63); STEP_END }
    for (int r_ = 0; r_ < REPN(12); ++r_) { STEP_BEGIN peer_v_phase(MISC + 16, eid16, (const bf16*)(ws + WS_WBUF), v8, qa, ctl + CW_PEER + 1024 + 2048 * r_, tid_); STEP_END }
    for (int r_ = 0; r_ < REPN(1); ++r_) { STEP_BEGIN peer_ln_pass(h2, qa, args.in.p[25], args.in.p[26], args.out, gw, NGW, tid_ & 63); STEP_END }
}

extern "C" void kernel_launch(void* const* d_in, const int* in_sizes, int n_in, void* d_out, int out_size, void* d_ws, size_t ws_size, hipStream_t stream) {
    static int grid = 0;
    if (grid == 0) {
        int dev = 0, cus = 0, per_cu = 0;
        if (hipGetDevice(&dev) != hipSuccess || hipDeviceGetAttribute(&cus, hipDeviceAttributeMultiprocessorCount, dev) != hipSuccess) { fprintf(stderr, "kernel_launch: device query failed\n"); grid = -1; return; }
        if (hipFuncSetAttribute((const void*)mega, hipFuncAttributeMaxDynamicSharedMemorySize, LDS_BYTES) != hipSuccess) { fprintf(stderr, "kernel_launch: hipFuncSetAttribute failed\n"); grid = -1; return; }
        if (hipOccupancyMaxActiveBlocksPerMultiprocessor(&per_cu, (const void*)mega, NTHR, LDS_BYTES) != hipSuccess || per_cu < 1) fprintf(stderr, "kernel_launch: occupancy query says %d\n", per_cu);
        (void)hipGetLastError();
        if (ws_size < WS_END) { fprintf(stderr, "kernel_launch: workspace too small: ws %zu need %zu\n", ws_size, (size_t)WS_END); grid = -1; return; }
        grid = cus;
    }
    if (grid < 0) return;
    if (hipMemsetAsync((char*)d_ws + WS_CTL, 0, CTL_ZERO_BYTES, stream) != hipSuccess) { fprintf(stderr, "kernel_launch: memset failed\n"); return; }
    Args a{};
    for (int i = 0; i < 27; ++i) a.in.p[i] = (const float*)d_in[i];
    a.out = (float*)d_out; a.ws = (unsigned char*)d_ws;
    hipLaunchKernelGGL(mega, dim3(grid), dim3(NTHR), LDS_BYTES, stream, a);
}
```
